# Optimizing an MI355X kernel written in HIP

```python
import jax, jax.numpy as jnp
from jax import lax
import numpy as np

D_MODEL = 1024
BATCH = 32
SEQ = 256
DEPTH = 2
DEC_BATCH = 4
DEC_SEQ = 2048
PAST_LEN = 256

GRID_W = 64
HEAD_DIM = 128
N_Q_HEADS = 4
N_KV_HEADS = 2
Q_PER_KV = N_Q_HEADS // N_KV_HEADS
ATTN_WIDTH = N_Q_HEADS * HEAD_DIM
KV_WIDTH = N_KV_HEADS * HEAD_DIM
WINDOW = 128
BLOCK = 128
ATTN_SCALE = HEAD_DIM ** -0.5
ROPE_BASE = 10000.0
NEG_INF = -1e30
RNN_WIDTH = 512
RNN_BLOCKS = 8
RNN_BLOCK_W = RNN_WIDTH // RNN_BLOCKS
CONV_W = 4
CONV_PAD_LEFT = 2
LRU_C = 8.0
AB_IN_WIDTH = ATTN_WIDTH + 2 * KV_WIDTH + 2 * RNN_WIDTH
AB_SPLITS = (ATTN_WIDTH, ATTN_WIDTH + KV_WIDTH, ATTN_WIDTH + 2 * KV_WIDTH, ATTN_WIDTH + 2 * KV_WIDTH + RNN_WIDTH)
AB_MIX_WIDTH = ATTN_WIDTH + RNN_WIDTH
CHUNK = 128
SGU_WIDTH = D_MODEL
SGU_GROUPS = 8
SGU_GROUP_W = SGU_WIDTH // SGU_GROUPS
N_EXPERTS = 16
EXPERT_FF = 2048
EC_FACTOR = 2
N_EVEN = (DEPTH + 1) // 2
N_ODD = DEPTH // 2
ALPHA = (2 * DEPTH) ** 0.25
BETA = (8 * DEPTH) ** -0.25
LN_EPS = 1e-6

kernel_name = "hybrid_diffusion_trunk_step"


def layer_norm(x, g, b):
    xf = x.astype(jnp.float32)
    mu = xf.mean(-1, keepdims=True)
    var = jnp.square(xf - mu).mean(-1, keepdims=True)
    return ((xf - mu) * lax.rsqrt(var + LN_EPS)).astype(x.dtype) * g + b


def adaln(cvec, w, b):
    m = jax.nn.silu(cvec) @ w + b
    return jnp.split(m[:, None, :], 6, axis=-1)


def modulate(x, shift, scale):
    return x * (1 + scale) + shift


def axial_rope(x):
    T = x.shape[1]
    rows = T // GRID_W
    row = jnp.repeat(jnp.arange(rows, dtype=jnp.float32), GRID_W)
    col = jnp.tile(jnp.arange(GRID_W, dtype=jnp.float32), rows)
    n_freq = HEAD_DIM // 4
    freqs = ROPE_BASE ** (-jnp.arange(n_freq, dtype=jnp.float32) / n_freq)
    ang = jnp.concatenate([row[:, None] * freqs, col[:, None] * freqs], axis=-1)
    cos = jnp.cos(ang)[None, :, None, :]
    sin = jnp.sin(ang)[None, :, None, :]
    xf = x.astype(jnp.float32)
    x1, x2 = xf[..., 0::2], xf[..., 1::2]
    out = jnp.stack([x1 * cos - x2 * sin, x1 * sin + x2 * cos], axis=-1).reshape(x.shape)
    return out.astype(x.dtype)


def sink_softmax(scores, sink):
    s = jnp.concatenate([scores, jnp.broadcast_to(sink, scores.shape[:-1] + (1,))], axis=-1)
    return jax.nn.softmax(s, axis=-1)[..., :-1]


def ab_project(h, in_w):
    B, T, _ = h.shape
    q, k, v, xr, xg = jnp.split(h @ in_w, AB_SPLITS, axis=-1)
    return (q.reshape(B, T, N_Q_HEADS, HEAD_DIM), k.reshape(B, T, N_KV_HEADS, HEAD_DIM),
            v.reshape(B, T, N_KV_HEADS, HEAD_DIM), xr, xg)


def context_attention(q, k, v, sink):
    B, S = q.shape[:2]
    qg = q.reshape(B, S, N_KV_HEADS, Q_PER_KV, HEAD_DIM)
    s = jnp.einsum('bqkgd,bskd->bkgqs', qg, k).astype(jnp.float32) * ATTN_SCALE
    p = sink_softmax(s, sink.reshape(N_KV_HEADS, Q_PER_KV)[:, :, None, None].astype(jnp.float32))
    o = jnp.einsum('bkgqs,bskd->bqkgd', p.astype(v.dtype), v)
    return o.reshape(B, S, ATTN_WIDTH)


def latent_attention(q, k, v, k_ctx, v_ctx, sink):
    B, T = q.shape[:2]
    P = k_ctx.shape[1]
    nb = T // BLOCK
    qb = q.reshape(B, nb, BLOCK, N_KV_HEADS, Q_PER_KV, HEAD_DIM)

    def bands(t):
        tp = jnp.pad(t, ((0, 0), (BLOCK, BLOCK), (0, 0), (0, 0))).reshape(B, nb + 2, BLOCK, N_KV_HEADS, HEAD_DIM)
        return jnp.concatenate([tp[:, :-2], tp[:, 1:-1], tp[:, 2:]], axis=2)

    kw, vw = bands(k), bands(v)
    blk = jnp.arange(nb)[:, None, None] * BLOCK
    qpos = blk + jnp.arange(BLOCK)[None, :, None]
    kpos = blk - BLOCK + jnp.arange(3 * BLOCK)[None, None, :]
    valid = (jnp.abs(qpos - kpos) <= WINDOW) & (kpos >= 0) & (kpos < T)
    s_win = jnp.einsum('bnqkgd,bnskd->bnkgqs', qb, kw).astype(jnp.float32) * ATTN_SCALE
    s_win = jnp.where(valid[None, :, None, None], s_win, NEG_INF)
    s_ctx = jnp.einsum('bnqkgd,bskd->bnkgqs', qb, k_ctx).astype(jnp.float32) * ATTN_SCALE
    p = sink_softmax(jnp.concatenate([s_ctx, s_win], axis=-1),
                     sink.reshape(N_KV_HEADS, Q_PER_KV)[:, :, None, None].astype(jnp.float32)).astype(v.dtype)
    o = (jnp.einsum('bnkgqs,bskd->bnqkgd', p[..., :P], v_ctx)
         + jnp.einsum('bnkgqs,bnskd->bnqkgd', p[..., P:], vw))
    return o.reshape(B, T, ATTN_WIDTH)


def centred_conv(x, w, b):
    T = x.shape[1]
    xp = jnp.pad(x, ((0, 0), (CONV_PAD_LEFT, CONV_W - 1 - CONV_PAD_LEFT), (0, 0)))
    return sum(xp[:, i:i + T] * w[i] for i in range(CONV_W)) + b


def block_diag(x, w, b):
    B, T, _ = x.shape
    y = jnp.einsum('btnc,ncd->btnd', x.reshape(B, T, RNN_BLOCKS, RNN_BLOCK_W), w)
    return y.reshape(B, T, RNN_WIDTH) + b


def _linrec(e1, e2):
    a1, b1 = e1
    a2, b2 = e2
    return a1 * a2, a2 * b1 + b2


def lru_scan(x, wa, ba, wx, bx, lam, h0):
    r = jax.nn.sigmoid(block_diag(x, wa, ba).astype(jnp.float32))
    i = jax.nn.sigmoid(block_diag(x, wx, bx).astype(jnp.float32))
    log_a = -LRU_C * r * jax.nn.softplus(-lam.astype(jnp.float32))
    a = jnp.exp(log_a)
    u = jnp.sqrt(-jnp.expm1(2.0 * log_a)) * (i * x.astype(jnp.float32))
    u = u.at[:, 0].add(a[:, 0] * h0.astype(jnp.float32))
    _, h = lax.associative_scan(_linrec, (a, u), axis=1)
    return h


def rglru_bidirectional(xr, xg, conv_w, conv_b, wa, ba, wx, bx, lam, h0):
    xc = centred_conv(xr, conv_w, conv_b)
    hf = lru_scan(xc, wa[0], ba[0], wx[0], bx[0], lam[0], h0[:, 0])
    hb = jnp.flip(lru_scan(jnp.flip(xc, axis=1), wa[1], ba[1], wx[1], bx[1], lam[1], h0[:, 1]), axis=1)
    y = (hf + hb).astype(xr.dtype) * jax.nn.gelu(xg)
    return y, hf, hb


def sgu_mixer(h, in_w, in_b, ln_g, ln_b, sp_w, sp_b, out_w):
    B, T, _ = h.shape
    nc = T // CHUNK
    u, v = jnp.split(jax.nn.gelu(h @ in_w + in_b), 2, axis=-1)
    v = layer_norm(v, ln_g, ln_b).reshape(B, nc, CHUNK, SGU_GROUPS, SGU_GROUP_W)
    mixed = jnp.einsum('gpq,bnqgc->bnpgc', sp_w, v) + sp_b.T[None, None, :, :, None]
    return (u * mixed.reshape(B, T, SGU_WIDTH)) @ out_w


def expert_choice_moe(x, router_w, w1, w3, w2):
    B, T, D = x.shape
    cap = EC_FACTOR * T // N_EXPERTS
    aff = jax.nn.softmax((x @ router_w).astype(jnp.float32), axis=-1)
    gate, idx = lax.top_k(jnp.swapaxes(aff, 1, 2), cap)
    xg = jax.vmap(lambda xb, ib: xb[ib])(x, idx)
    hid = jax.nn.silu(jnp.einsum('becd,edf->becf', xg, w1)) * jnp.einsum('becd,edf->becf', xg, w3)
    yg = jnp.einsum('becf,efd->becd', hid, w2) * gate[..., None].astype(x.dtype)
    return jax.vmap(lambda ib, yb: jnp.zeros((T, D), yb.dtype).at[ib.reshape(-1)].add(yb.reshape(-1, D)))(idx, yg)


def setup_inputs(seed: int = 0) -> dict:
    key = jax.random.key(seed)
    ks = iter(jax.random.split(key, 64))
    f32 = jnp.float32

    def nrm(shape, std):
        return jax.random.normal(next(ks), shape, f32) * std

    def gain(shape):
        return 1.0 + nrm(shape, 0.02)

    a_init = jax.random.uniform(next(ks), (N_EVEN, 2, RNN_WIDTH), f32, minval=0.9, maxval=0.999) ** (1.0 / LRU_C)
    return {
        "x_prompt": nrm((BATCH, SEQ, D_MODEL), 1.0),
        "x_sample": nrm((DEC_BATCH, DEC_SEQ, D_MODEL), 1.0),
        "cache_k": nrm((DEC_BATCH, N_EVEN, PAST_LEN, N_KV_HEADS, HEAD_DIM), 1.0),
        "cache_v": nrm((DEC_BATCH, N_EVEN, PAST_LEN, N_KV_HEADS, HEAD_DIM), 1.0),
        "state_rglru": nrm((DEC_BATCH, N_EVEN, 2, RNN_WIDTH), 0.5),
        "c": nrm((DEC_BATCH, D_MODEL), 1.0),
        "c_ctx": nrm((D_MODEL,), 1.0),
        "mod_w": nrm((DEPTH, D_MODEL, 6 * D_MODEL), 0.5 * D_MODEL ** -0.5),
        "mod_b": nrm((DEPTH, 6 * D_MODEL), 0.02),
        "ln_mix_g": gain((DEPTH, D_MODEL)),
        "ln_mix_b": nrm((DEPTH, D_MODEL), 0.02),
        "ln_ffn_g": gain((DEPTH, D_MODEL)),
        "ln_ffn_b": nrm((DEPTH, D_MODEL), 0.02),
        "ab_in_w": nrm((N_EVEN, D_MODEL, AB_IN_WIDTH), D_MODEL ** -0.5),
        "attn_sink": nrm((N_EVEN, N_Q_HEADS), 0.5),
        "rnn_conv_w": nrm((N_EVEN, CONV_W, RNN_WIDTH), CONV_W ** -0.5),
        "rnn_conv_b": nrm((N_EVEN, RNN_WIDTH), 0.02),
        "lru_wa": nrm((N_EVEN, 2, RNN_BLOCKS, RNN_BLOCK_W, RNN_BLOCK_W), RNN_BLOCK_W ** -0.5),
        "lru_ba": nrm((N_EVEN, 2, RNN_WIDTH), 0.05),
        "lru_wx": nrm((N_EVEN, 2, RNN_BLOCKS, RNN_BLOCK_W, RNN_BLOCK_W), RNN_BLOCK_W ** -0.5),
        "lru_bx": nrm((N_EVEN, 2, RNN_WIDTH), 0.05),
        "lru_lambda": jnp.log(a_init) - jnp.log1p(-a_init),
        "ab_out_w": nrm((N_EVEN, AB_MIX_WIDTH, D_MODEL), BETA * AB_MIX_WIDTH ** -0.5),
        "sgu_in_w": nrm((N_ODD, D_MODEL, 2 * SGU_WIDTH), D_MODEL ** -0.5),
        "sgu_in_b": nrm((N_ODD, 2 * SGU_WIDTH), 0.02),
        "sgu_ln_g": gain((N_ODD, SGU_WIDTH)),
        "sgu_ln_b": nrm((N_ODD, SGU_WIDTH), 0.02),
        "sgu_spatial_w": nrm((N_ODD, SGU_GROUPS, CHUNK, CHUNK), 0.5 * CHUNK ** -0.5),
        "sgu_spatial_b": 1.0 + nrm((N_ODD, SGU_GROUPS, CHUNK), 0.1),
        "sgu_out_w": nrm((N_ODD, SGU_WIDTH, D_MODEL), BETA * SGU_WIDTH ** -0.5),
        "router_w": nrm((DEPTH, D_MODEL, N_EXPERTS), D_MODEL ** -0.5),
        "moe_w1": nrm((DEPTH, N_EXPERTS, D_MODEL, EXPERT_FF), D_MODEL ** -0.5),
        "moe_w3": nrm((DEPTH, N_EXPERTS, D_MODEL, EXPERT_FF), D_MODEL ** -0.5),
        "moe_w2": nrm((DEPTH, N_EXPERTS, EXPERT_FF, D_MODEL), BETA * EXPERT_FF ** -0.5),
    }


def reference(x_prompt, x_sample, cache_k, cache_v, state_rglru, c, c_ctx,
              mod_w, mod_b, ln_mix_g, ln_mix_b, ln_ffn_g, ln_ffn_b,
              ab_in_w, attn_sink, rnn_conv_w, rnn_conv_b, lru_wa, lru_ba, lru_wx, lru_bx, lru_lambda, ab_out_w,
              sgu_in_w, sgu_in_b, sgu_ln_g, sgu_ln_b, sgu_spatial_w, sgu_spatial_b, sgu_out_w,
              router_w, moe_w1, moe_w3, moe_w2):
    xp, xs = x_prompt, x_sample
    ctx_keys, ctx_vals, ctx_states = [], [], []
    for l in range(DEPTH):
        mp = adaln(c_ctx[None], mod_w[l], mod_b[l])
        ms = adaln(c, mod_w[l], mod_b[l])
        hp = modulate(xp, mp[0], mp[1])
        hs = modulate(xs, ms[0], ms[1])
        e = l // 2
        if l % 2 == 0:
            q, k, v, xr, xg = ab_project(hp, ab_in_w[e])
            att = context_attention(q, k, v, attn_sink[e])
            h0 = jnp.zeros((xp.shape[0], 2, RNN_WIDTH), xp.dtype)
            rnn, hf, hb = rglru_bidirectional(xr, xg, rnn_conv_w[e], rnn_conv_b[e], lru_wa[e], lru_ba[e],
                                             lru_wx[e], lru_bx[e], lru_lambda[e], h0)
            op = jnp.concatenate([att, rnn], axis=-1) @ ab_out_w[e]
            ctx_keys.append(k)
            ctx_vals.append(v)
            ctx_states.append(jnp.stack([hf[:, -1], hb[:, 0]], axis=1).astype(xp.dtype))
            q, k, v, xr, xg = ab_project(hs, ab_in_w[e])
            att = latent_attention(axial_rope(q), axial_rope(k), v, cache_k[:, e], cache_v[:, e], attn_sink[e])
            rnn, _, _ = rglru_bidirectional(xr, xg, rnn_conv_w[e], rnn_conv_b[e], lru_wa[e], lru_ba[e],
                                           lru_wx[e], lru_bx[e], lru_lambda[e], state_rglru[:, e])
            os_ = jnp.concatenate([att, rnn], axis=-1) @ ab_out_w[e]
        else:
            op = sgu_mixer(hp, sgu_in_w[e], sgu_in_b[e], sgu_ln_g[e], sgu_ln_b[e],
                           sgu_spatial_w[e], sgu_spatial_b[e], sgu_out_w[e])
            os_ = sgu_mixer(hs, sgu_in_w[e], sgu_in_b[e], sgu_ln_g[e], sgu_ln_b[e],
                            sgu_spatial_w[e], sgu_spatial_b[e], sgu_out_w[e])
        xp = layer_norm(ALPHA * xp + mp[2] * op, ln_mix_g[l], ln_mix_b[l])
        xs = layer_norm(ALPHA * xs + ms[2] * os_, ln_mix_g[l], ln_mix_b[l])
        fp = expert_choice_moe(modulate(xp, mp[3], mp[4]), router_w[l], moe_w1[l], moe_w3[l], moe_w2[l])
        fs = expert_choice_moe(modulate(xs, ms[3], ms[4]), router_w[l], moe_w1[l], moe_w3[l], moe_w2[l])
        xp = layer_norm(ALPHA * xp + mp[5] * fp, ln_ffn_g[l], ln_ffn_b[l])
        xs = layer_norm(ALPHA * xs + ms[5] * fs, ln_ffn_g[l], ln_ffn_b[l])
    new_cache_k = jnp.stack(ctx_keys, axis=1)
    new_cache_v = jnp.stack(ctx_vals, axis=1)
    new_state_rglru = jnp.stack(ctx_states, axis=1)
    return (xp, xs, new_cache_k, new_cache_v, new_state_rglru)
```

```cpp
#include <hip/hip_runtime.h>
#include <hip/hip_cooperative_groups.h>
#include <cstdio>
#include <cstdint>
namespace cg = cooperative_groups;

#define LAS __attribute__((address_space(3)))
typedef unsigned short bf16_t;
typedef short bf16x8 __attribute__((ext_vector_type(8)));
typedef short s16x4 __attribute__((ext_vector_type(4)));
typedef float f32x4 __attribute__((ext_vector_type(4)));
typedef float f32x2 __attribute__((ext_vector_type(2)));
typedef unsigned u32x4 __attribute__((ext_vector_type(4)));
typedef unsigned u32x2 __attribute__((ext_vector_type(2)));

#ifndef N_SPLIT
#define N_SPLIT 0
#endif

constexpr int NTOK = 16384, DM = 1024, NPR = 8192;
constexpr float ALPHA_C = 1.41421356237309515f;
constexpr float ATTN_SCALE_C = 0.08838834764831845f;
constexpr float LN_EPS_C = 1e-6f;
constexpr int LDS_BYTES = 147456;
constexpr int NPHASE = 19;

constexpr size_t MB = 1024ull * 1024ull;
constexpr size_t WS_BTUP = 0;
constexpr size_t WS_BTDN = WS_BTUP + 256 * MB;
constexpr size_t WS_ABIN = WS_BTDN + 128 * MB;
constexpr size_t WS_ABOUT = WS_ABIN + 4 * MB;
constexpr size_t WS_SGIN = WS_ABOUT + 2 * MB;
constexpr size_t WS_SGOUT = WS_SGIN + 4 * MB;
constexpr size_t WS_SPW = WS_SGOUT + 2 * MB;
constexpr size_t WS_GW = WS_SPW + 262144;
constexpr size_t WS_MODP = WS_GW + 262144;
constexpr size_t WS_MOD = WS_MODP + 2 * MB;
constexpr size_t WS_SP = WS_MOD + 245760;
constexpr size_t WS_ROPE = WS_MOD + 262144;
constexpr size_t WS_CK = WS_ROPE + 32768;
constexpr size_t WS_CV = WS_CK + 524288;
constexpr size_t WS_AFF = WS_CV + 524288;
constexpr size_t WS_TOKSLOT = WS_AFF + 1 * MB;
constexpr size_t WS_SLOTGATE = WS_TOKSLOT + 1 * MB;
constexpr size_t WS_VSTAT = WS_SLOTGATE + 131072;
constexpr size_t WS_H = WS_VSTAT + 2 * MB;
constexpr size_t WS_HMOE = WS_H + 32 * MB;
constexpr size_t WS_XA = WS_HMOE + 32 * MB;
constexpr size_t WS_QKV = WS_XA + 64 * MB;
constexpr size_t WS_Q = WS_QKV;
constexpr size_t WS_K = WS_QKV + 16 * MB;
constexpr size_t WS_V = WS_QKV + 24 * MB;
constexpr size_t WS_XR = WS_QKV + 32 * MB;
constexpr size_t WS_XG = WS_QKV + 48 * MB;
constexpr size_t WS_U = WS_QKV;
constexpr size_t WS_V2 = WS_QKV + 32 * MB;
constexpr size_t WS_MIX = WS_QKV + 64 * MB;
constexpr size_t WS_BIG = WS_MIX + 32 * MB;
constexpr size_t WS_HLF = WS_BIG, WS_HLB = WS_BIG + 32 * MB, WS_PCF = WS_BIG + 64 * MB, WS_PCB = WS_BIG + 96 * MB;
constexpr size_t WS_HID = WS_BIG;
constexpr size_t WS_XGATH = WS_BIG + 128 * MB;
constexpr size_t WS_Y = WS_XGATH + 64 * MB;
constexpr size_t WS_BAR = WS_Y + 64 * MB;
constexpr size_t WS_END = WS_BAR + 16384;

struct Params { const float* in[34]; float* out; unsigned char* ws; int ph_lo, ph_hi; };

enum { I_XP = 0, I_XS, I_CK, I_CV, I_STATE, I_C, I_CCTX, I_MODW, I_MODB, I_LNMG, I_LNMB, I_LNFG, I_LNFB, I_ABIN, I_SINK, I_CONVW, I_CONVB,
       I_WA, I_BA, I_WX, I_BX, I_LAM, I_ABOUT, I_SGIN, I_SGINB, I_SGLNG, I_SGLNB, I_SPW, I_SPB, I_SGOUT, I_ROUTER, I_W1, I_W3, I_W2 };

__device__ __forceinline__ unsigned cvt_pk_bf16(float lo, float hi) { unsigned r; asm volatile("v_cvt_pk_bf16_f32 %0, %1, %2" : "=v"(r) : "v"(lo), "v"(hi)); return r; }
__device__ __forceinline__ float bf2f(unsigned h) { return __builtin_bit_cast(float, h << 16); }
__device__ __forceinline__ float bflo(unsigned w) { return __builtin_bit_cast(float, w << 16); }
__device__ __forceinline__ float bfhi(unsigned w) { return __builtin_bit_cast(float, w & 0xffff0000u); }
__device__ __forceinline__ float wave_sum(float v) {
#pragma unroll
    for (int o = 1; o < 64; o <<= 1) v += __shfl_xor(v, o);
    return v;
}
__device__ __forceinline__ float sigmoidf_(float x) { return __builtin_amdgcn_rcpf(1.f + __builtin_amdgcn_exp2f(x * -1.4426950408889634f)); }
__device__ __forceinline__ float siluf_(float x) { return x * __builtin_amdgcn_rcpf(1.f + __builtin_amdgcn_exp2f(x * -1.4426950408889634f)); }
__device__ __forceinline__ float geluf_(float x) { const float t = x * (-2.3022082f + -0.10294324f * (x * x)); return x * __builtin_amdgcn_rcpf(1.f + __builtin_amdgcn_exp2f(t)); }
__device__ __forceinline__ float one_minus_exp(float x) {
    const float pl = -x * (1.f + x * (0.5f + x * (0.16666667f + x * (0.041666668f + x * (0.0083333338f + x * 0.0013888889f)))));
    return x > -0.5f ? pl : 1.f - __expf(x);
}
__device__ __forceinline__ int cond_of(int row) { return row < NPR ? 0 : 1 + ((row - NPR) >> 11); }
__device__ __forceinline__ int otid() { int t = threadIdx.x; asm volatile("" : "+v"(t)); return t; }
#define LDS_WAIT() asm volatile("s_waitcnt lgkmcnt(0)" ::: "memory")

#define XB_TMO      128
#define XB_XCNT(j)  (256  + 64 * (j))
#define XB_XSUB(j)  (1280 + 64 * (j))
#define XB_XGEN(j)  (2304 + 64 * (j))
#define XB_TOP      3328
#define XB_TOPGEN   3392
#define XCD_BAR_WORDS 3456
#define XB_SPIN_CAP (1u << 18)

__device__ __forceinline__ unsigned xb_ld(unsigned* p)              { return __hip_atomic_load(p, __ATOMIC_RELAXED, __HIP_MEMORY_SCOPE_AGENT); }
__device__ __forceinline__ unsigned xb_add(unsigned* p, unsigned v) { return __hip_atomic_fetch_add(p, v, __ATOMIC_RELAXED, __HIP_MEMORY_SCOPE_AGENT); }
__device__ __forceinline__ unsigned xb_xcc_id() { return (unsigned)__builtin_amdgcn_s_getreg((3 << 11) | 20) & 0xFu; }
#define XB_SPIN(cond, bar) do { unsigned _sp = 0; while (cond) { __builtin_amdgcn_s_sleep(1); \
    if ((++_sp & 255u) == 0u) { if (xb_ld(&(bar)[XB_TMO])) break; if (_sp > XB_SPIN_CAP) { atomicAdd(&(bar)[XB_TMO], 1u); break; } } } } while (0)

struct XcdBarrier {
    unsigned* bar; unsigned x;
    volatile LAS unsigned* st;
};

__device__ __forceinline__ XcdBarrier xcd_barrier_post(unsigned* bar, volatile LAS unsigned* st) {
    XcdBarrier b; b.bar = bar; b.x = xb_xcc_id(); b.st = st;
    if (threadIdx.x == 0) (void)xb_add(&bar[XB_XCNT(b.x)], 1u);
    return b;
}
__device__ __forceinline__ void xcd_barrier_complete(unsigned* bar, unsigned x, unsigned& nloc, unsigned& nx) {
    const unsigned G = gridDim.x * gridDim.y * gridDim.z;
    unsigned sum, cnt, mine, sp = 0u;
    for (;;) {
        sum = 0u; cnt = 0u; mine = 0u;
#pragma unroll
        for (unsigned j = 0; j < 16; ++j) { const unsigned c = xb_ld(&bar[XB_XCNT(j)]); sum += c; cnt += (c > 0u) ? 1u : 0u; mine = (j == x) ? c : mine; }
        if (sum == G) break;
        __builtin_amdgcn_s_sleep(1);
        if ((++sp & 255u) == 0u) { if (xb_ld(&bar[XB_TMO])) break; if (sp > XB_SPIN_CAP) { atomicAdd(&bar[XB_TMO], 1u); break; } }
    }
    nloc = mine > 0u ? mine : 1u; nx = cnt > 0u ? cnt : 1u;
}

__device__ __forceinline__ void xcd_barrier(const XcdBarrier& b) {
    asm volatile("s_waitcnt vmcnt(0)" ::: "memory");
    __syncthreads();
    if (threadIdx.x == 0) {
        unsigned* bar = b.bar;
        __builtin_amdgcn_s_waitcnt(0);
        unsigned nloc = b.st[0], nx = b.st[1];
        if (nloc == 0u) { xcd_barrier_complete(bar, b.x, nloc, nx); b.st[0] = nloc; b.st[1] = nx; }
        const unsigned old = xb_add(&bar[XB_XSUB(b.x)], 1u);
        const unsigned gen = old / nloc;
        if (old + 1u == (gen + 1u) * nloc) {
            __builtin_amdgcn_fence(__ATOMIC_RELEASE, "agent");
            asm volatile("s_waitcnt vmcnt(0)" ::: "memory");
            const unsigned og = xb_add(&bar[XB_TOP], 1u);
            const unsigned tg = og / nx;
            if (og + 1u == (tg + 1u) * nx) xb_add(&bar[XB_TOPGEN], 1u);
            else XB_SPIN(xb_ld(&bar[XB_TOPGEN]) == tg, bar);
            __builtin_amdgcn_fence(__ATOMIC_ACQUIRE, "agent");
            xb_add(&bar[XB_XGEN(b.x)], 1u);
            asm volatile("s_waitcnt vmcnt(0)" ::: "memory");
        } else {
            XB_SPIN(xb_ld(&bar[XB_XGEN(b.x)]) == gen, bar);
            __builtin_amdgcn_fence(__ATOMIC_ACQUIRE, "agent");
            asm volatile("s_waitcnt vmcnt(0)" ::: "memory");
        }
    }
    __syncthreads();
}

namespace pg8 {
#define PG8_LAS __attribute__((address_space(3)))
constexpr int BM = 256, BK = 64, HALF = 128, HTB = HALF * BK * 2, STAGE_BYTES = 8 * HTB, NXCD = 8, WGM = 8;
__host__ __device__ __forceinline__ int lds_byte(int r, int c) { const int st = (r >> 4) * 2 + (c >> 5), rr = r & 15, cc = c & 31, ob = rr * 64 + cc * 2; return st * 1024 + (ob ^ (((ob >> 9) & 1) << 5)); }
__host__ __device__ __forceinline__ void stage_rc(int b, int& R, int& C) { const int st = b / 1024, sb = b % 1024, swz = sb ^ (((sb >> 9) & 1) << 5); R = (st >> 1) * 16 + swz / 64; C = (st & 1) * 32 + (swz % 64) / 2; }
__host__ __device__ __forceinline__ int perm32(int rho) { const int n = rho >> 4, i = rho & 15; return 8 * (i >> 2) + 4 * n + (i & 3); }
typedef int v4i_t __attribute__((ext_vector_type(4)));
typedef int v8i_t __attribute__((ext_vector_type(8)));
struct Unit { int pm, pn; };
struct Gemm { const bf16_t* A; const bf16_t* Bt; int M, N, K; };
struct StaticOrder {
    int nM, nN, nwg, G, c;
    __host__ __device__ void init(int M, int N, int G_, int c_) { nM = M / BM; nN = N / BM; nwg = nM * nN; G = G_; c = c_; }
    __host__ __device__ bool next(int i, Unit& u) const {
        const long L = (long)i * G + c; if (L >= nwg) return false;
        int wgid = (int)L; { const int q = nwg / NXCD, r = nwg % NXCD, xcd = wgid % NXCD, off = wgid / NXCD; wgid = (xcd < r ? xcd * (q + 1) : r * (q + 1) + (xcd - r) * q) + off; }
        const int nig = WGM * nN, gid = wgid / nig, fm = gid * WGM, gsz = (nM - fm) < WGM ? (nM - fm) : WGM;
        u.pm = fm + ((wgid % nig) % gsz); u.pn = (wgid % nig) / gsz; return true;
    }
    __device__ __forceinline__ void a_ready(const Unit&) const {}
    __device__ __forceinline__ void done(const Unit&) const {}
};
template <int NU, int UPE, int PNE> struct GroupOrder {
    int G, c;
    __device__ __forceinline__ bool next(int i, Unit& u) const {
        const long L = (long)i * G + c; if (L >= NU) return false;
        const int w = ((int)L % NXCD) * (NU / NXCD) + (int)L / NXCD;
        const int e = w / UPE, v = w % UPE;
        u.pm = e * 8 + (v & 7); u.pn = e * PNE + (v >> 3); return true;
    }
    __device__ __forceinline__ void a_ready(const Unit&) const {}
    __device__ __forceinline__ void done(const Unit&) const {}
};
template <class Epi, class Sched, bool ALIGN_EPI = false, bool SP2 = false, bool F8 = false>
__device__ __forceinline__ void gemm_phase(PG8_LAS unsigned char* lds, const Gemm g, const Sched& S, const Epi& E) {
    const int tid = otid(), wid = __builtin_amdgcn_readfirstlane(tid >> 6), lane = tid & 63, wr = wid >> 2, wc = wid & 3, fr = lane & 15, fq = lane >> 4;
    const int K = g.K, nt = K / BK;
    unsigned laneA, uA[2], uB[2];
    { const int sb = lane * 16, swz = sb ^ (((sb >> 9) & 1) << 5), sR = swz / 64, sC = (swz % 64) / 2;
      laneA = (unsigned)(sR * K + sC) * 2u;
#pragma unroll
      for (int i = 0; i < 2; ++i) { const int st = wid + 8 * i;
          uA[i] = (unsigned)(((st >> 1) * 16) * K + (st & 1) * 32) * 2u;
          uB[i] = Epi::PERM ? (unsigned)(((st >> 2) * 32 + 4 * ((st >> 1) & 1)) * K + (st & 1) * 32) * 2u : uA[i]; } }
    const size_t kstep = (size_t)(BK * 2);
    const size_t hstep = (size_t)HALF * K * 2;
    const size_t tstep = 2 * hstep;
    const unsigned ldsw = (unsigned)wid * 1024u;
    const int aoff = lds_byte(wr * 64 + fr, fq * 8), boff = lds_byte(wc * 32 + fr, fq * 8);
#define PG8_SA(b, h) (((b) * 2 + (h)) * HTB)
#define PG8_SB(b, h) ((4 + (b) * 2 + (h)) * HTB)
#define voffA 0
#define voffB 1
#define PG8_STAGE(bufoff, gbase, voff) do { _Pragma("unroll") for (int _i = 0; _i < 2; ++_i) { \
        unsigned vo_ = laneA; asm volatile("" : "+v"(vo_)); if ((voff) == 1 && Epi::PERM) vo_ += (unsigned)((otid() >> 4) & 3) * (unsigned)(8 * K); const unsigned uo_ = ((voff) == 1 ? uB[_i] : uA[_i]); \
        __builtin_amdgcn_global_load_lds((const unsigned*)((const char*)(gbase) + uo_ + vo_), (PG8_LAS unsigned*)(lds + (bufoff) + ldsw + _i * 8192), 16, 0, 0); } } while (0)
#define PG8_LDA(dst, b, h) do { if constexpr (F8) { _Pragma("unroll") for (int m = 0; m < 4; ++m) dst##8[m] = __builtin_shufflevector(*(const PG8_LAS v4i_t*)(lds + PG8_SA(b, h) + aoff + m * 2048), *(const PG8_LAS v4i_t*)(lds + PG8_SA(b, h) + aoff + m * 2048 + 1024), 0, 1, 2, 3, 4, 5, 6, 7); } \
    else { _Pragma("unroll") for (int m = 0; m < 4; ++m) _Pragma("unroll") for (int k = 0; k < 2; ++k) dst[m][k] = *(const PG8_LAS bf16x8*)(lds + PG8_SA(b, h) + aoff + m * 2048 + k * 1024); } } while (0)
#define PG8_LDB(dst, b, h) do { if constexpr (F8) { _Pragma("unroll") for (int n = 0; n < 2; ++n) dst##8[n] = __builtin_shufflevector(*(const PG8_LAS v4i_t*)(lds + PG8_SB(b, h) + boff + n * 2048), *(const PG8_LAS v4i_t*)(lds + PG8_SB(b, h) + boff + n * 2048 + 1024), 0, 1, 2, 3, 4, 5, 6, 7); } \
    else { _Pragma("unroll") for (int n = 0; n < 2; ++n) _Pragma("unroll") for (int k = 0; k < 2; ++k) dst[n][k] = *(const PG8_LAS bf16x8*)(lds + PG8_SB(b, h) + boff + n * 2048 + k * 1024); } } while (0)
#define PG8_MMA(ai, bj, At, Bt) do { __builtin_amdgcn_s_setprio(1); _Pragma("unroll") for (int m = 0; m < 4; ++m) _Pragma("unroll") for (int n = 0; n < 2; ++n) { \
        if constexpr (F8) asm volatile("v_mfma_scale_f32_16x16x128_f8f6f4 %0, %1, %2, %0, %3, %3 op_sel_hi:[0,0,0]" : "+a"(acc[ai][bj][m][n]) : "v"(Bt##8[n]), "v"(At##8[m]), "v"(sc127)); \
        else { _Pragma("unroll") for (int k = 0; k < 2; ++k) asm volatile("v_mfma_f32_16x16x32_bf16 %0, %1, %2, %0" : "+a"(acc[ai][bj][m][n]) : "v"(Bt[n][k]), "v"(At[m][k])); } } \
        __builtin_amdgcn_s_setprio(0); } while (0)
#define PG8_WAIT_V(n) asm volatile("s_waitcnt vmcnt(" #n ")" ::: "memory")
#define PG8_WAIT_L(n) asm volatile("s_waitcnt lgkmcnt(" #n ")" ::: "memory")
#define PG8_BAR __builtin_amdgcn_s_barrier()
#define PG8_SCHED __builtin_amdgcn_sched_barrier(0)
    Unit cur, nxt; int ui = 0;
    if (!S.next(0, cur)) return;
    f32x4 acc[2][2][4][2];
#pragma unroll
    for (int a = 0; a < 2; ++a)
#pragma unroll
        for (int b = 0; b < 2; ++b)
#pragma unroll
            for (int m = 0; m < 4; ++m)
#pragma unroll
                for (int n = 0; n < 2; ++n) acc[a][b][m][n] = (f32x4){0.f, 0.f, 0.f, 0.f};
    bf16x8 At[4][2], B0[2][2], B1[2][2]; v8i_t At8[4], B08[2], B18[2]; const int sc127 = 0x7f7f7f7f;
    const char* cA = (const char*)g.A + (size_t)cur.pm * tstep; const char* cB = (const char*)g.Bt + (size_t)cur.pn * tstep;
    S.a_ready(cur);
    if constexpr (SP2) {
        PG8_STAGE(PG8_SB(0, 0), cB, voffB); PG8_STAGE(PG8_SB(0, 1), cB + hstep, voffB); PG8_STAGE(PG8_SA(0, 0), cA, voffA); PG8_STAGE(PG8_SA(0, 1), cA + hstep, voffA);
        if (wr == 1) PG8_BAR;
        PG8_WAIT_V(2); PG8_BAR;
        PG8_STAGE(PG8_SB(1, 0), cB + kstep, voffB); PG8_STAGE(PG8_SA(1, 0), cA + kstep, voffA); PG8_STAGE(PG8_SB(1, 1), cB + hstep + kstep, voffB);
        PG8_WAIT_V(6); PG8_BAR;
    } else {
        PG8_STAGE(PG8_SB(0, 0), cB, voffB); PG8_STAGE(PG8_SA(0, 0), cA, voffA); PG8_STAGE(PG8_SB(0, 1), cB + hstep, voffB); PG8_STAGE(PG8_SA(0, 1), cA + hstep, voffA);
        if (wr == 1) PG8_BAR;
        PG8_WAIT_V(4); PG8_BAR;
        PG8_STAGE(PG8_SB(1, 0), cB + kstep, voffB); PG8_STAGE(PG8_SA(1, 0), cA + kstep, voffA); PG8_STAGE(PG8_SB(1, 1), cB + hstep + kstep, voffB);
        PG8_WAIT_V(6); PG8_BAR;
    }
    for (;;) {
        const bool has_next = S.next(ui + 1, nxt);
        const char* nA = has_next ? (const char*)g.A + (size_t)nxt.pm * tstep : cA; const char* nB = has_next ? (const char*)g.Bt + (size_t)nxt.pn * tstep : cB;
#pragma nounroll
        for (int t = 0; t < nt; t += 2) {
            const bool last = (t == nt - 2);
            const char* a1 = cA + (size_t)(t + 1) * kstep;
            const char* a2 = last ? nA : cA + (size_t)(t + 2) * kstep; const char* b2 = last ? nB : cB + (size_t)(t + 2) * kstep;
            const char* a3 = a2 + kstep; const char* b3 = b2 + kstep;
            if (last && has_next) S.a_ready(nxt);
            if constexpr (SP2) {
            PG8_LDB(B0, 0, 0); PG8_LDB(B1, 0, 1); PG8_SCHED; PG8_LDA(At, 0, 0); PG8_STAGE(PG8_SA(1, 1), a1 + hstep, voffA);
            PG8_WAIT_V(8); PG8_WAIT_L(0); PG8_BAR; PG8_MMA(0, 0, At, B0); PG8_MMA(0, 1, At, B1); PG8_BAR; PG8_SCHED;
            PG8_LDA(At, 0, 1); PG8_STAGE(PG8_SB(0, 0), b2, voffB); PG8_STAGE(PG8_SB(0, 1), b2 + hstep, voffB); PG8_STAGE(PG8_SA(0, 0), a2, voffA);
            PG8_WAIT_V(8); PG8_WAIT_L(0); PG8_BAR; PG8_MMA(1, 0, At, B0); PG8_MMA(1, 1, At, B1); PG8_BAR; PG8_SCHED;
            PG8_LDB(B0, 1, 0); PG8_LDB(B1, 1, 1); PG8_SCHED; PG8_LDA(At, 1, 0); PG8_STAGE(PG8_SA(0, 1), a2 + hstep, voffA);
            PG8_WAIT_V(8); PG8_WAIT_L(0); PG8_BAR; PG8_MMA(0, 0, At, B0); PG8_MMA(0, 1, At, B1); PG8_BAR; PG8_SCHED;
            PG8_LDA(At, 1, 1); PG8_STAGE(PG8_SB(1, 0), b3, voffB); PG8_STAGE(PG8_SB(1, 1), b3 + hstep, voffB); PG8_STAGE(PG8_SA(1, 0), a3, voffA);
            PG8_WAIT_V(8); PG8_WAIT_L(0); PG8_BAR; PG8_MMA(1, 0, At, B0); PG8_MMA(1, 1, At, B1); PG8_BAR; PG8_SCHED;
            } else {
            PG8_LDB(B0, 0, 0); PG8_SCHED; PG8_LDA(At, 0, 0); PG8_STAGE(PG8_SA(1, 1), a1 + hstep, voffA);
            PG8_WAIT_L(8); PG8_BAR; PG8_WAIT_L(0); PG8_MMA(0, 0, At, B0); PG8_BAR; PG8_SCHED;
            PG8_LDB(B1, 0, 1); PG8_STAGE(PG8_SB(0, 0), b2, voffB);
            PG8_BAR; PG8_WAIT_L(0); PG8_MMA(0, 1, At, B1); PG8_BAR;
            PG8_LDA(At, 0, 1); PG8_STAGE(PG8_SA(0, 0), a2, voffA);
            PG8_BAR; PG8_WAIT_L(0); PG8_MMA(1, 0, At, B0); PG8_BAR; PG8_SCHED;
            PG8_STAGE(PG8_SB(0, 1), b2 + hstep, voffB);
            PG8_WAIT_V(6); PG8_BAR; PG8_MMA(1, 1, At, B1); PG8_BAR;
            PG8_LDB(B0, 1, 0); PG8_SCHED; PG8_LDA(At, 1, 0); PG8_STAGE(PG8_SA(0, 1), a2 + hstep, voffA);
            PG8_WAIT_L(8); PG8_BAR; PG8_WAIT_L(0); PG8_MMA(0, 0, At, B0); PG8_BAR; PG8_SCHED;
            PG8_LDB(B1, 1, 1); PG8_STAGE(PG8_SB(1, 0), b3, voffB);
            PG8_BAR; PG8_WAIT_L(0); PG8_MMA(0, 1, At, B1); PG8_BAR;
            PG8_LDA(At, 1, 1); PG8_STAGE(PG8_SA(1, 0), a3, voffA);
            PG8_BAR; PG8_WAIT_L(0); PG8_MMA(1, 0, At, B0); PG8_BAR; PG8_SCHED;
            PG8_STAGE(PG8_SB(1, 1), b3 + hstep, voffB);
            PG8_WAIT_V(6); PG8_BAR; PG8_MMA(1, 1, At, B1); PG8_BAR;
            }
        }
        asm volatile("s_nop 15\n\ts_nop 15" ::: "memory");
        if constexpr (ALIGN_EPI) { if (wr == 0) PG8_BAR; }
        if constexpr (!Epi::AFTER_DRAIN) { const int t2_ = otid(); int fr_ = t2_ & 15, fq_ = (t2_ >> 4) & 3, wr_ = wr, wc_ = wc; asm volatile("" : "+s"(wr_), "+s"(wc_)); E(acc, cur, wr_, wc_, fr_, fq_); S.done(cur); }
        if (!has_next) break;
#pragma unroll
        for (int a = 0; a < 2; ++a)
#pragma unroll
            for (int b = 0; b < 2; ++b)
#pragma unroll
                for (int m = 0; m < 4; ++m)
#pragma unroll
                    for (int n = 0; n < 2; ++n) acc[a][b][m][n] = (f32x4){0.f, 0.f, 0.f, 0.f};
        cur = nxt; cA = nA; cB = nB; ++ui;
        if constexpr (ALIGN_EPI) { if (wr == 1) PG8_BAR; }
    }
    PG8_WAIT_V(0);
    if constexpr (!ALIGN_EPI) { if (wr == 0) PG8_BAR; }
    PG8_BAR;
    if constexpr (Epi::AFTER_DRAIN) { E.fused(acc, cur, wr, wc, fr, fq, lds, wid, lane); S.done(cur); }
#undef PG8_SA
#undef PG8_SB
#undef PG8_STAGE
#undef voffA
#undef voffB
#undef PG8_LDA
#undef PG8_LDB
#undef PG8_MMA
#undef PG8_WAIT_V
#undef PG8_WAIT_L
#undef PG8_BAR
#undef PG8_SCHED
}
}
using pg8::Unit;
struct EpiIn {
    static constexpr bool PERM = true, AFTER_DRAIN = false;
    bf16_t *Q, *Kb, *Vb, *XR, *XGb; float *outK, *outV; const float* rope;
    __device__ __forceinline__ void operator()(const f32x4 (&acc)[2][2][4][2], const Unit& u, int wr, int wc, int fr, int fq) const {
        const int pn = u.pn; const bool sample = u.pm >= 32;
        bf16_t* dbase; int dstride;
        if (pn <= 1) { dbase = Q + pn * 256; dstride = 512; }
        else if (pn == 2) { dbase = Kb; dstride = 256; }
        else if (pn == 3) { dbase = Vb; dstride = 256; }
        else if (pn <= 5) { dbase = XR + (pn - 4) * 256; dstride = 512; }
        else { dbase = XGb + (pn - 6) * 256; dstride = 512; }
        const bool dorope = sample && pn <= 2;
        float* fout = (!sample && (pn == 2 || pn == 3)) ? (pn == 2 ? outK : outV) : nullptr;
        const int rbase = u.pm * 256 + wr * 64 + fr;
        const float* tcol = rope + ((wc & 1) * 16 + fq * 4) * 2;
#define EPIIN_LD(it_, d0_, d1_) do { const int row_ = rbase + ((it_) >> 2) * 128 + ((it_) & 3) * 16, pos_ = (row_ - NPR) & 2047; \
            const int trow_ = dorope ? ((wc < 2) ? (pos_ >> 6) : (32 + (pos_ & 63))) : 96; const float* tp_ = tcol + (size_t)trow_ * 64; d0_ = *(const f32x4*)tp_; d1_ = *(const f32x4*)(tp_ + 4); } while (0)
        f32x4 cs[2][2];
        EPIIN_LD(0, cs[0][0], cs[0][1]);
#pragma unroll
        for (int it = 0; it < 8; ++it) {
            const int ai = it >> 2, m = it & 3, row = rbase + ai * 128 + m * 16;
            if (it < 7) EPIIN_LD(it + 1, cs[(it + 1) & 1][0], cs[(it + 1) & 1][1]);
            __builtin_amdgcn_sched_barrier(0);
            const f32x4 cs0 = cs[it & 1][0], cs1 = cs[it & 1][1];
#pragma unroll
            for (int bj = 0; bj < 2; ++bj) {
                const f32x4 v0 = acc[ai][bj][m][0], v1 = acc[ai][bj][m][1];
                const int ct = bj * 128 + wc * 32 + fq * 8;
                f32x4 r0, r1;
                r0.x = v0.x * cs0.x - v0.y * cs0.y; r0.y = v0.x * cs0.y + v0.y * cs0.x;
                r0.z = v0.z * cs0.z - v0.w * cs0.w; r0.w = v0.z * cs0.w + v0.w * cs0.z;
                r1.x = v1.x * cs1.x - v1.y * cs1.y; r1.y = v1.x * cs1.y + v1.y * cs1.x;
                r1.z = v1.z * cs1.z - v1.w * cs1.w; r1.w = v1.z * cs1.w + v1.w * cs1.z;
                u32x4 o; o.x = cvt_pk_bf16(r0.x, r0.y); o.y = cvt_pk_bf16(r0.z, r0.w); o.z = cvt_pk_bf16(r1.x, r1.y); o.w = cvt_pk_bf16(r1.z, r1.w);
                *(u32x4*)(dbase + (size_t)row * dstride + ct) = o;
                if (fout) { float* op = fout + (size_t)row * 256 + ct; __builtin_nontemporal_store(r0, (f32x4*)op); __builtin_nontemporal_store(r1, (f32x4*)(op + 4)); }
            }
        }
#undef EPIIN_LD
    }
};
template <bool XB16> struct EpiOut {
    static constexpr bool PERM = false, AFTER_DRAIN = false;
    const float *xin_p, *xin_s; bf16_t* XA; const float* modl;
    __device__ __forceinline__ void operator()(const f32x4 (&acc)[2][2][4][2], const Unit& u, int wr, int wc, int fr, int fq) const {
        const int rbase = u.pm * 256 + wr * 64 + fr, cbase = u.pn * 256 + wc * 32 + fq * 4;
        const float* gp = modl + (size_t)cond_of(u.pm * 256) * 6144 + 2 * 1024 + cbase;
        const float* xb = (u.pm < 32 ? xin_p + (size_t)rbase * DM : xin_s + (size_t)(rbase - NPR) * DM) + cbase;
        const bf16_t* xh = XA + (size_t)rbase * DM + cbase;
        f32x4 gv[2][2];
#pragma unroll
        for (int bj = 0; bj < 2; ++bj)
#pragma unroll
            for (int n = 0; n < 2; ++n) gv[bj][n] = *(const f32x4*)(gp + bj * 128 + n * 16);
#define EPIOUT_LD(it_, d_) do { const size_t ro_ = (size_t)(((it_) >> 2) * 128 + ((it_) & 3) * 16) * DM; \
            if constexpr (XB16) { const bf16_t* xr_ = xh + ro_; const u32x2 w0_ = *(const u32x2*)(xr_), w1_ = *(const u32x2*)(xr_ + 16), w2_ = *(const u32x2*)(xr_ + 128), w3_ = *(const u32x2*)(xr_ + 144); \
                d_[0] = (f32x4){bflo(w0_.x), bfhi(w0_.x), bflo(w0_.y), bfhi(w0_.y)}; d_[1] = (f32x4){bflo(w1_.x), bfhi(w1_.x), bflo(w1_.y), bfhi(w1_.y)}; \
                d_[2] = (f32x4){bflo(w2_.x), bfhi(w2_.x), bflo(w2_.y), bfhi(w2_.y)}; d_[3] = (f32x4){bflo(w3_.x), bfhi(w3_.x), bflo(w3_.y), bfhi(w3_.y)}; } \
            else { const float* xr_ = xb + ro_; d_[0] = *(const f32x4*)(xr_); d_[1] = *(const f32x4*)(xr_ + 16); d_[2] = *(const f32x4*)(xr_ + 128); d_[3] = *(const f32x4*)(xr_ + 144); } } while (0)
        f32x4 xv[2][4];
        EPIOUT_LD(0, xv[0]);
#pragma unroll
        for (int it = 0; it < 8; ++it) {
            const int ai = it >> 2, m = it & 3, row = rbase + ai * 128 + m * 16;
            if (it < 7) EPIOUT_LD(it + 1, xv[(it + 1) & 1]);
            __builtin_amdgcn_sched_barrier(0);
#pragma unroll
            for (int bj = 0; bj < 2; ++bj)
#pragma unroll
                for (int n = 0; n < 2; ++n) {
                    const f32x4 y = xv[it & 1][bj * 2 + n] * ALPHA_C + gv[bj][n] * acc[ai][bj][m][n];
                    u32x2 o; o.x = cvt_pk_bf16(y.x, y.y); o.y = cvt_pk_bf16(y.z, y.w);
                    *(u32x2*)(XA + (size_t)row * DM + cbase + bj * 128 + n * 16) = o;
                }
        }
#undef EPIOUT_LD
    }
};
__device__ __forceinline__ unsigned pk4_fp8(float a, float b, float c, float d) { unsigned w = 0u; asm volatile("v_cvt_pk_fp8_f32 %0, %1, %2" : "+v"(w) : "v"(a), "v"(b)); asm volatile("v_cvt_pk_fp8_f32 %0, %1, %2 op_sel:[0,0,1]" : "+v"(w) : "v"(c), "v"(d)); return w; }
constexpr float W13_SCALE = 32.f, W2_SCALE = 64.f;
struct EpiUp {
    static constexpr bool PERM = true, AFTER_DRAIN = false;
    unsigned char* Hid;
    __device__ __forceinline__ void operator()(const f32x4 (&acc)[2][2][4][2], const Unit& u, int wr, int wc, int fr, int fq) const {
        const int pnl = u.pn & 15; constexpr float ds = 1.f / W13_SCALE;
#pragma unroll
        for (int ai = 0; ai < 2; ++ai)
#pragma unroll
            for (int m = 0; m < 4; ++m) {
                const int row = u.pm * 256 + ai * 128 + wr * 64 + m * 16 + fr;
                __builtin_amdgcn_sched_barrier(0);
                const f32x4 a0 = acc[ai][0][m][0] * ds, a1 = acc[ai][0][m][1] * ds, b0 = acc[ai][1][m][0] * ds, b1 = acc[ai][1][m][1] * ds;
                u32x2 o;
                o.x = pk4_fp8(siluf_(a0.x) * b0.x, siluf_(a0.y) * b0.y, siluf_(a0.z) * b0.z, siluf_(a0.w) * b0.w);
                o.y = pk4_fp8(siluf_(a1.x) * b1.x, siluf_(a1.y) * b1.y, siluf_(a1.z) * b1.z, siluf_(a1.w) * b1.w);
                *(u32x2*)(Hid + (size_t)row * 2048 + pnl * 128 + wc * 32 + fq * 8) = o;
            }
    }
};
struct EpiDn {
    static constexpr bool PERM = true, AFTER_DRAIN = false;
    bf16_t* Y; const float* gate;
    __device__ __forceinline__ void operator()(const f32x4 (&acc)[2][2][4][2], const Unit& u, int wr, int wc, int fr, int fq) const {
        const int pnl = u.pn & 3, rbase = u.pm * 256 + wr * 64 + fr;
        float gg[8];
#pragma unroll
        for (int it = 0; it < 8; ++it) gg[it] = gate[rbase + (it >> 2) * 128 + (it & 3) * 16] * (1.f / W2_SCALE);
#pragma unroll
        for (int it = 0; it < 8; ++it) {
            const int ai = it >> 2, m = it & 3, row = rbase + ai * 128 + m * 16;
            __builtin_amdgcn_sched_barrier(0);
            const float g = gg[it];
#pragma unroll
            for (int bj = 0; bj < 2; ++bj) {
                const f32x4 v0 = acc[ai][bj][m][0] * g, v1 = acc[ai][bj][m][1] * g;
                u32x4 o; o.x = cvt_pk_bf16(v0.x, v0.y); o.y = cvt_pk_bf16(v0.z, v0.w); o.z = cvt_pk_bf16(v1.x, v1.y); o.w = cvt_pk_bf16(v1.z, v1.w);
                *(u32x4*)(Y + (size_t)row * DM + pnl * 256 + bj * 128 + wc * 32 + fq * 8) = o;
            }
        }
    }
};
struct EpiSgu {
    static constexpr bool PERM = true, AFTER_DRAIN = false;
    bf16_t *U, *V2; float* vstat; const float* bias;
    __device__ __forceinline__ void operator()(const f32x4 (&acc)[2][2][4][2], const Unit& u, int wr, int wc, int fr, int fq) const {
        const int pn = u.pn; const bool isv = pn >= 4;
        bf16_t* dbase = (isv ? V2 : U) + (pn & 3) * 256;
        f32x4 bvv[2][2];
#pragma unroll
        for (int bj = 0; bj < 2; ++bj) { const float* bp = bias + pn * 256 + bj * 128 + wc * 32 + fq * 8; bvv[bj][0] = *(const f32x4*)bp; bvv[bj][1] = *(const f32x4*)(bp + 4); }
#pragma unroll
        for (int ai = 0; ai < 2; ++ai)
#pragma unroll
            for (int m = 0; m < 4; ++m) {
                const int row = u.pm * 256 + ai * 128 + wr * 64 + m * 16 + fr;
                __builtin_amdgcn_sched_barrier(0);
                float s1 = 0.f, s2 = 0.f;
#pragma unroll
                for (int bj = 0; bj < 2; ++bj) {
                    const int ct = bj * 128 + wc * 32 + fq * 8, c = pn * 256 + ct;
                    f32x4 v0 = acc[ai][bj][m][0] + bvv[bj][0], v1 = acc[ai][bj][m][1] + bvv[bj][1];
                    v0.x = geluf_(v0.x); v0.y = geluf_(v0.y); v0.z = geluf_(v0.z); v0.w = geluf_(v0.w);
                    v1.x = geluf_(v1.x); v1.y = geluf_(v1.y); v1.z = geluf_(v1.z); v1.w = geluf_(v1.w);
                    u32x4 o; o.x = cvt_pk_bf16(v0.x, v0.y); o.y = cvt_pk_bf16(v0.z, v0.w); o.z = cvt_pk_bf16(v1.x, v1.y); o.w = cvt_pk_bf16(v1.z, v1.w);
                    *(u32x4*)(dbase + (size_t)row * DM + ct) = o;
                    s1 += (v0.x + v0.y) + (v0.z + v0.w) + (v1.x + v1.y) + (v1.z + v1.w);
                    s2 += (v0.x * v0.x + v0.y * v0.y) + (v0.z * v0.z + v0.w * v0.w) + (v1.x * v1.x + v1.y * v1.y) + (v1.z * v1.z + v1.w * v1.w);
                }
                { const int ln = fq * 16 + fr, i16 = (ln ^ 16) << 2, i32 = (ln ^ 32) << 2;
                  s1 += __builtin_bit_cast(float, __builtin_amdgcn_ds_bpermute(i16, __builtin_bit_cast(int, s1))); s2 += __builtin_bit_cast(float, __builtin_amdgcn_ds_bpermute(i16, __builtin_bit_cast(int, s2)));
                  s1 += __builtin_bit_cast(float, __builtin_amdgcn_ds_bpermute(i32, __builtin_bit_cast(int, s1))); s2 += __builtin_bit_cast(float, __builtin_amdgcn_ds_bpermute(i32, __builtin_bit_cast(int, s2))); }
                if (isv && fq == 0) { f32x2 st; st.x = s1; st.y = s2; *(f32x2*)(vstat + ((size_t)row * 16 + (pn - 4) * 4 + wc) * 2) = st; }
            }
    }
};
__device__ __forceinline__ void tr_item(const float* __restrict__ src, int N, bf16_t* dst, int Kd, int k0, int n0, int drow0, LAS float* scr, int lane) {
    f32x4 v[16];
    const float* s = src + (size_t)(k0 + (lane >> 4)) * N + n0 + (lane & 15) * 4;
#pragma unroll
    for (int i = 0; i < 16; ++i) v[i] = *(const f32x4*)(s + (size_t)i * 4 * N);
#pragma unroll
    for (int i = 0; i < 16; ++i) { LAS float* d = scr + (i * 4 + (lane >> 4)) * 65 + (lane & 15) * 4; d[0] = v[i].x; d[1] = v[i].y; d[2] = v[i].z; d[3] = v[i].w; }
    LDS_WAIT(); __builtin_amdgcn_wave_barrier();
    const int c = lane & 7;
#pragma unroll
    for (int j = 0; j < 8; ++j) {
        const int n = (lane >> 3) + 8 * j; const LAS float* r = scr + (8 * c) * 65 + n;
        u32x4 o; o.x = cvt_pk_bf16(r[0], r[65]); o.y = cvt_pk_bf16(r[2 * 65], r[3 * 65]); o.z = cvt_pk_bf16(r[4 * 65], r[5 * 65]); o.w = cvt_pk_bf16(r[6 * 65], r[7 * 65]);
        *(u32x4*)(dst + (size_t)(drow0 + n) * Kd + k0 + 8 * c) = o;
    }
    LDS_WAIT(); __builtin_amdgcn_wave_barrier();
}
__device__ __forceinline__ void tr_item8(const float* __restrict__ src, int N, unsigned char* dst, int Kd, int k0, int n0, int drow0, float sc, LAS float* scr, int lane) {
    f32x4 v[16];
    const float* s = src + (size_t)(k0 + (lane >> 4)) * N + n0 + (lane & 15) * 4;
#pragma unroll
    for (int i = 0; i < 16; ++i) v[i] = *(const f32x4*)(s + (size_t)i * 4 * N);
#pragma unroll
    for (int i = 0; i < 16; ++i) { LAS float* d = scr + (i * 4 + (lane >> 4)) * 65 + (lane & 15) * 4; d[0] = v[i].x * sc; d[1] = v[i].y * sc; d[2] = v[i].z * sc; d[3] = v[i].w * sc; }
    LDS_WAIT(); __builtin_amdgcn_wave_barrier();
    const int c = lane & 3;
#pragma unroll
    for (int j = 0; j < 4; ++j) {
        const int n = (lane >> 2) + 16 * j; const LAS float* r = scr + (16 * c) * 65 + n;
        u32x4 o; o.x = pk4_fp8(r[0], r[65], r[2 * 65], r[3 * 65]); o.y = pk4_fp8(r[4 * 65], r[5 * 65], r[6 * 65], r[7 * 65]);
        o.z = pk4_fp8(r[8 * 65], r[9 * 65], r[10 * 65], r[11 * 65]); o.w = pk4_fp8(r[12 * 65], r[13 * 65], r[14 * 65], r[15 * 65]);
        *(u32x4*)(dst + (size_t)(drow0 + n) * Kd + k0 + 16 * c) = o;
    }
    LDS_WAIT(); __builtin_amdgcn_wave_barrier();
}
__device__ __forceinline__ void cvt_item512(const float* __restrict__ src, bf16_t* dst, int item, int lane) {
    const size_t i = (size_t)item * 512 + lane * 8;
    const f32x4 a = *(const f32x4*)(src + i), b = *(const f32x4*)(src + i + 4);
    u32x4 o; o.x = cvt_pk_bf16(a.x, a.y); o.y = cvt_pk_bf16(a.z, a.w); o.z = cvt_pk_bf16(b.x, b.y); o.w = cvt_pk_bf16(b.z, b.w);
    *(u32x4*)(dst + i) = o;
}
struct MoeItem { const float* s; size_t rowstep; unsigned char* dst; int Kd; float sc; };
__device__ __forceinline__ MoeItem moe_item(const Params& p, int r, int lane) {
    MoeItem m; unsigned char* ws = p.ws;
    if (r < 32768) {
        const int w3 = r >= 16384; const int q = w3 ? r - 16384 : r;
        const int mat = q >> 9, rr = q & 511, n0 = (rr & 31) * 64, k0 = (rr >> 5) * 64;
        m.s = p.in[w3 ? I_W3 : I_W1] + (size_t)mat * 1024 * 2048 + (size_t)(k0 + (lane >> 4)) * 2048 + n0 + (lane & 15) * 4; m.rowstep = (size_t)4 * 2048;
        m.dst = ws + WS_BTUP + (size_t)mat * 4096 * 1024 + (size_t)((n0 >> 7) * 256 + (n0 & 127) + w3 * 128) * 1024 + k0; m.Kd = 1024; m.sc = W13_SCALE;
    } else {
        const int q = r - 32768, mat = q >> 9, rr = q & 511, n0 = (rr & 15) * 64, k0 = (rr >> 4) * 64;
        m.s = p.in[I_W2] + (size_t)mat * 2048 * 1024 + (size_t)(k0 + (lane >> 4)) * 1024 + n0 + (lane & 15) * 4; m.rowstep = (size_t)4 * 1024;
        m.dst = ws + WS_BTDN + (size_t)mat * 1024 * 2048 + (size_t)n0 * 2048 + k0; m.Kd = 2048; m.sc = W2_SCALE;
    }
    return m;
}
__device__ __forceinline__ void phase_p0(const Params& p, LAS unsigned char* lds) {
    const int tid = otid(), lane = tid & 63, wave = tid >> 6;
    LAS float* scr = (LAS float*)(lds + wave * 16640);
    unsigned char* ws = p.ws;
    const int gw = blockIdx.x * 8 + wave, NGW = gridDim.x * 8;
    constexpr int N_MOD = 1536, N_ABIN = 512, N_ABOUT = 256, N_SGIN = 512, N_SGOUT = 256, N_GW = 32, N_CVT = 512, N_CK = 512, N_SPW = 256, N_ROPE = 49, N_SP = 16;
    constexpr int TOTAL = N_MOD + N_ABIN + N_ABOUT + N_SGIN + N_SGOUT + N_GW + N_CVT + N_CK + N_SPW + N_ROPE + N_SP;
    for (int it = gw; it < TOTAL; it += NGW) {
        int r = it;
        if (r < N_MOD) {
            const int l = r / 768, rem = r % 768, cgp = rem >> 3, kp = rem & 7, n = cgp * 64 + lane;
            const float* w = p.in[I_MODW] + ((size_t)l * 1024 + 128 * kp) * 6144 + n;
            const float* cc = p.in[I_C]; const float* cx = p.in[I_CCTX];
            const int ka = 128 * kp + lane;
            const float s0a = siluf_(cx[ka]), s0b = siluf_(cx[ka + 64]), s1a = siluf_(cc[ka]), s1b = siluf_(cc[ka + 64]), s2a = siluf_(cc[1024 + ka]), s2b = siluf_(cc[1024 + ka + 64]);
            const float s3a = siluf_(cc[2048 + ka]), s3b = siluf_(cc[2048 + ka + 64]), s4a = siluf_(cc[3072 + ka]), s4b = siluf_(cc[3072 + ka + 64]);
            float a0 = 0.f, a1 = 0.f, a2 = 0.f, a3 = 0.f, a4 = 0.f;
#pragma unroll 8
            for (int k = 0; k < 64; ++k) {
                const float wa = w[(size_t)k * 6144], wb = w[(size_t)(k + 64) * 6144];
                a0 += __builtin_bit_cast(float, __builtin_amdgcn_readlane(__builtin_bit_cast(int, s0a), k)) * wa + __builtin_bit_cast(float, __builtin_amdgcn_readlane(__builtin_bit_cast(int, s0b), k)) * wb;
                a1 += __builtin_bit_cast(float, __builtin_amdgcn_readlane(__builtin_bit_cast(int, s1a), k)) * wa + __builtin_bit_cast(float, __builtin_amdgcn_readlane(__builtin_bit_cast(int, s1b), k)) * wb;
                a2 += __builtin_bit_cast(float, __builtin_amdgcn_readlane(__builtin_bit_cast(int, s2a), k)) * wa + __builtin_bit_cast(float, __builtin_amdgcn_readlane(__builtin_bit_cast(int, s2b), k)) * wb;
                a3 += __builtin_bit_cast(float, __builtin_amdgcn_readlane(__builtin_bit_cast(int, s3a), k)) * wa + __builtin_bit_cast(float, __builtin_amdgcn_readlane(__builtin_bit_cast(int, s3b), k)) * wb;
                a4 += __builtin_bit_cast(float, __builtin_amdgcn_readlane(__builtin_bit_cast(int, s4a), k)) * wa + __builtin_bit_cast(float, __builtin_amdgcn_readlane(__builtin_bit_cast(int, s4b), k)) * wb;
            }
            float* mp = (float*)(ws + WS_MODP) + (size_t)(kp * 2 + l) * 30720 + n;
            mp[0] = a0; mp[6144] = a1; mp[2 * 6144] = a2; mp[3 * 6144] = a3; mp[4 * 6144] = a4;
            continue;
        }
        r -= N_MOD;
        if (r < N_ABIN) { tr_item(p.in[I_ABIN], 2048, (bf16_t*)(ws + WS_ABIN), 1024, (r >> 5) * 64, (r & 31) * 64, (r & 31) * 64, scr, lane); continue; } r -= N_ABIN;
        if (r < N_ABOUT) { tr_item(p.in[I_ABOUT], 1024, (bf16_t*)(ws + WS_ABOUT), 1024, (r >> 4) * 64, (r & 15) * 64, (r & 15) * 64, scr, lane); continue; } r -= N_ABOUT;
        if (r < N_SGIN) { tr_item(p.in[I_SGIN], 2048, (bf16_t*)(ws + WS_SGIN), 1024, (r >> 5) * 64, (r & 31) * 64, (r & 31) * 64, scr, lane); continue; } r -= N_SGIN;
        if (r < N_SGOUT) { tr_item(p.in[I_SGOUT], 1024, (bf16_t*)(ws + WS_SGOUT), 1024, (r >> 4) * 64, (r & 15) * 64, (r & 15) * 64, scr, lane); continue; } r -= N_SGOUT;
        if (r < N_GW) {
            const int gate = r >> 4, rest = r & 15, dir = rest >> 3, blk = rest & 7;
            tr_item(p.in[gate ? I_WX : I_WA] + (size_t)(dir * 8 + blk) * 4096, 64, (bf16_t*)(ws + WS_GW) + (size_t)((dir * 2 + gate) * 8 + blk) * 4096, 64, 0, 0, 0, scr, lane);
            continue;
        }
        r -= N_GW;
        if (r < N_CVT) { cvt_item512(p.in[I_CV], (bf16_t*)(ws + WS_CV), r, lane); continue; } r -= N_CVT;
        if (r < N_CK) { cvt_item512(p.in[I_CK], (bf16_t*)(ws + WS_CK), r, lane); continue; } r -= N_CK;
        if (r < N_SPW) { cvt_item512(p.in[I_SPW], (bf16_t*)(ws + WS_SPW), r, lane); continue; } r -= N_SPW;
        if (r >= N_ROPE) { const int i = (r - N_ROPE) * 64 + lane; ((float*)(ws + WS_SP))[i] = log1pf(__expf(-p.in[I_LAM][i])); continue; }
        {
            const int idx = r * 64 + lane, pos = idx >> 5, f = idx & 31, pp = pos < 32 ? pos : pos - 32;
            double fr_ = 1.0; for (int i = 0; i < f; ++i) fr_ *= 0.74989420933245582;
            double ang = (double)pp * fr_;
            const double k = __builtin_rint(ang * 0.15915494309189535);
            double x = ang - k * 6.283185307179586; const double x2 = x * x;
            double sn = x, cs = 1.0, ts = x, tc = 1.0;
#pragma unroll
            for (int i = 1; i <= 14; ++i) { tc *= -x2 / (double)((2 * i - 1) * (2 * i)); cs += tc; ts *= -x2 / (double)((2 * i) * (2 * i + 1)); sn += ts; }
            f32x2 o; o.x = (float)cs; o.y = (float)sn;
            if (pos >= 96) { o.x = 1.f; o.y = 0.f; }
            if (idx < 97 * 32) *(f32x2*)((float*)(ws + WS_ROPE) + (size_t)idx * 2) = o;
        }
    }
    constexpr int NMOE = 49152;
    f32x4 va[16], vb[16];
    MoeItem ca, cb;
#define MOE_LOAD(V, C, IT) do { C = moe_item(p, (IT), lane); _Pragma("unroll") for (int i = 0; i < 16; ++i) V[i] = __builtin_nontemporal_load((const f32x4*)(C.s + (size_t)i * C.rowstep)); } while (0)
#define MOE_PROC(V, C, NXT) do { const float sc = C.sc; \
        _Pragma("unroll") for (int i = 0; i < 16; ++i) { LAS float* d = scr + (i * 4 + (lane >> 4)) * 65 + (lane & 15) * 4; d[0] = V[i].x * sc; d[1] = V[i].y * sc; d[2] = V[i].z * sc; d[3] = V[i].w * sc; } \
        unsigned char* cdst = C.dst; const int cKd = C.Kd; \
        if ((NXT) < NMOE) MOE_LOAD(V, C, (NXT)); \
        LDS_WAIT(); __builtin_amdgcn_wave_barrier(); \
        const int c = lane & 3; \
        _Pragma("unroll") for (int j = 0; j < 4; ++j) { const int n = (lane >> 2) + 16 * j; const LAS float* r = scr + (16 * c) * 65 + n; \
            u32x4 o; o.x = pk4_fp8(r[0], r[65], r[2 * 65], r[3 * 65]); o.y = pk4_fp8(r[4 * 65], r[5 * 65], r[6 * 65], r[7 * 65]); \
            o.z = pk4_fp8(r[8 * 65], r[9 * 65], r[10 * 65], r[11 * 65]); o.w = pk4_fp8(r[12 * 65], r[13 * 65], r[14 * 65], r[15 * 65]); \
            __builtin_nontemporal_store(o, (u32x4*)(cdst + (size_t)n * cKd + 16 * c)); } \
        LDS_WAIT(); __builtin_amdgcn_wave_barrier(); } while (0)
    if (gw < NMOE) MOE_LOAD(va, ca, gw);
    if (gw + NGW < NMOE) MOE_LOAD(vb, cb, gw + NGW);
    for (int it = gw; it < NMOE; it += 2 * NGW) {
        MOE_PROC(va, ca, it + 2 * NGW);
        if (it + NGW < NMOE) MOE_PROC(vb, cb, it + 3 * NGW);
    }
#undef MOE_LOAD
#undef MOE_PROC
}
__device__ __forceinline__ void phase_p0b(const Params& p) {
    const int tid = otid(); unsigned char* ws = p.ws;
    const float* modp = (const float*)(ws + WS_MODP);
    float* mod = (float*)(ws + WS_MOD);
    for (int i = blockIdx.x * 512 + tid; i < 61440; i += gridDim.x * 512) {
        const int l = i / 30720, rem = i % 30720;
        float s = p.in[I_MODB][l * 6144 + rem % 6144];
#pragma unroll
        for (int kp = 0; kp < 8; ++kp) s += modp[(size_t)(kp * 2 + l) * 30720 + rem];
        mod[i] = s;
    }
    bf16_t* H = (bf16_t*)(ws + WS_H);
    const int c4 = (tid & 255) * 4, rs = tid >> 8;
    for (int tile = blockIdx.x; tile < 256; tile += gridDim.x) {
        const int row0 = tile * 64, cond = cond_of(row0);
        f32x4 sh = *(const f32x4*)(p.in[I_MODB] + c4), sc = *(const f32x4*)(p.in[I_MODB] + 1024 + c4);
#pragma unroll
        for (int kp = 0; kp < 8; ++kp) {
            const float* b = modp + (size_t)(kp * 2) * 30720 + cond * 6144 + c4;
            sh += *(const f32x4*)b; sc += *(const f32x4*)(b + 1024);
        }
        sc += 1.f;
        const float* xt = (row0 < NPR ? p.in[I_XP] + (size_t)row0 * DM : p.in[I_XS] + (size_t)(row0 - NPR) * DM) + (size_t)rs * DM + c4;
        for (int it0 = 0; it0 < 32; it0 += 8) {
            f32x4 xv[8];
#pragma unroll
            for (int q = 0; q < 8; ++q) xv[q] = __builtin_nontemporal_load((const f32x4*)(xt + (size_t)(it0 + q) * 2 * DM));
#pragma unroll
            for (int q = 0; q < 8; ++q) {
                const f32x4 h = xv[q] * sc + sh;
                u32x2 o; o.x = cvt_pk_bf16(h.x, h.y); o.y = cvt_pk_bf16(h.z, h.w);
                *(u32x2*)(H + (size_t)(row0 + (it0 + q) * 2 + rs) * DM + c4) = o;
            }
        }
    }
}
__device__ __forceinline__ void attn_tile(const Params& p, LAS unsigned char* lds, int a) {
    const int tid = otid(), lane = tid & 63, wave = tid >> 6, fr = lane & 15, fq = lane >> 4;
    unsigned char* ws = p.ws;
    const bool lat = a >= 256;
    int b, kvh, qb, tokbase;
    if (!lat) { b = a >> 3; kvh = (a >> 2) & 1; qb = a & 3; tokbase = b * 256; }
    else { const int a2 = a - 256; b = a2 >> 6; kvh = (a2 >> 5) & 1; qb = a2 & 31; tokbase = NPR + b * 2048; }
    const int q0 = qb * 64, head = kvh * 2 + (wave >> 2);
    const int qloc = q0 + (wave & 3) * 16 + fr, qrow = tokbase + qloc;
    const bf16_t* Q = (const bf16_t*)(ws + WS_Q); const bf16_t* Kb = (const bf16_t*)(ws + WS_K); const bf16_t* Vb = (const bf16_t*)(ws + WS_V);
    const bf16_t* CK = (const bf16_t*)(ws + WS_CK); const bf16_t* CV = (const bf16_t*)(ws + WS_CV);
    bf16x8 qf[4];
#pragma unroll
    for (int ks = 0; ks < 4; ++ks) qf[ks] = *(const bf16x8*)(Q + (size_t)qrow * 512 + head * 128 + ks * 32 + fq * 8);
    float m = p.in[I_SINK][head] * 1.4426950408889634f, l = 1.f;
    f32x4 o[8];
#pragma unroll
    for (int i = 0; i < 8; ++i) o[i] = (f32x4){0.f, 0.f, 0.f, 0.f};
    int jlo = 0, jhi = 4, ntile = 4;
    if (lat) { jlo = q0 >= 128 ? 0 : (q0 == 64 ? 1 : 2); jhi = q0 <= 1856 ? 4 : (q0 == 1920 ? 3 : 2); ntile = 4 + (jhi - jlo + 1); }
    LAS unsigned char* sK = lds; LAS unsigned char* sV = lds + 17408;
    u32x4 rk[2], rv[2];
#define ATT_SRC(ti, kp_, kbase_, krs_, vbase_, vrs_) do { krs_ = 256; vrs_ = 256; \
        if (!lat) { kp_ = -100000; const size_t o_ = (size_t)(tokbase + 64 * (ti)) * 256 + kvh * 128; kbase_ = Kb + o_; vbase_ = Vb + o_; } \
        else if ((ti) < 4) { kp_ = -100000; const size_t o_ = (size_t)(b * 256 + 64 * (ti)) * 256 + kvh * 128; kbase_ = CK + o_; vbase_ = CV + o_; } \
        else { kp_ = q0 - 128 + 64 * (jlo + (ti) - 4); const size_t o_ = (size_t)(tokbase + kp_) * 256 + kvh * 128; kbase_ = Kb + o_; vbase_ = Vb + o_; } } while (0)
#define ATT_LOAD(ti) do { int kp_; const bf16_t* kb_; const bf16_t* vb_; int krs_, vrs_; ATT_SRC(ti, kp_, kb_, krs_, vb_, vrs_); (void)kp_; \
        _Pragma("unroll") for (int i = 0; i < 2; ++i) { const int idx = tid + 512 * i; \
            rk[i] = *(const u32x4*)(kb_ + (size_t)(idx >> 4) * krs_ + (idx & 15) * 8); \
            rv[i] = *(const u32x4*)(vb_ + (size_t)(idx & 63) * vrs_ + (idx >> 6) * 8); } } while (0)
    ATT_LOAD(0);
    for (int t = 0; t < ntile; ++t) {
        __syncthreads();
#pragma unroll
        for (int i = 0; i < 2; ++i) { const int idx = tid + 512 * i;
            *(LAS u32x4*)(sK + (idx >> 4) * 272 + (idx & 15) * 16) = rk[i];
            { LAS unsigned char* vd = sV + ((idx >> 6) * 8) * 144 + (idx & 63) * 2; const u32x4 w = rv[i];
              *(LAS bf16_t*)(vd) = (bf16_t)w.x; *(LAS bf16_t*)(vd + 144) = (bf16_t)(w.x >> 16); *(LAS bf16_t*)(vd + 2 * 144) = (bf16_t)w.y; *(LAS bf16_t*)(vd + 3 * 144) = (bf16_t)(w.y >> 16);
              *(LAS bf16_t*)(vd + 4 * 144) = (bf16_t)w.z; *(LAS bf16_t*)(vd + 5 * 144) = (bf16_t)(w.z >> 16); *(LAS bf16_t*)(vd + 6 * 144) = (bf16_t)w.w; *(LAS bf16_t*)(vd + 7 * 144) = (bf16_t)(w.w >> 16); } }
        __syncthreads();
        int kp0; { const bf16_t* kb_; const bf16_t* vb_; int krs_, vrs_; ATT_SRC(t, kp0, kb_, krs_, vb_, vrs_); (void)kb_; (void)vb_; (void)krs_; (void)vrs_; }
        if (t + 1 < ntile) ATT_LOAD(t + 1);
        f32x4 s[4];
#pragma unroll
        for (int nt = 0; nt < 4; ++nt) s[nt] = (f32x4){0.f, 0.f, 0.f, 0.f};
#pragma unroll
        for (int ks = 0; ks < 4; ++ks)
#pragma unroll
            for (int nt = 0; nt < 4; ++nt) {
                const bf16x8 kf = *(const LAS bf16x8*)(sK + (16 * nt + fr) * 272 + (32 * ks + 8 * fq) * 2);
                s[nt] = __builtin_amdgcn_mfma_f32_16x16x32_bf16(kf, qf[ks], s[nt], 0, 0, 0);
            }
        float mloc = -3.0e38f;
#pragma unroll
        for (int nt = 0; nt < 4; ++nt)
#pragma unroll
            for (int j = 0; j < 4; ++j) {
                float v = s[nt][j] * (ATTN_SCALE_C * 1.4426950408889634f);
                if (kp0 > -50000) { const int df = qloc - (kp0 + 16 * nt + 4 * fq + j); if (df > 128 || df < -128) v = -1e30f; }
                s[nt][j] = v; mloc = fmaxf(mloc, v);
            }
        mloc = fmaxf(mloc, __shfl_xor(mloc, 16)); mloc = fmaxf(mloc, __shfl_xor(mloc, 32));
        const float mn = fmaxf(m, mloc), alpha = __builtin_amdgcn_exp2f(m - mn);
        float ls = 0.f;
#pragma unroll
        for (int nt = 0; nt < 4; ++nt)
#pragma unroll
            for (int j = 0; j < 4; ++j) { const float e = __builtin_amdgcn_exp2f(s[nt][j] - mn); s[nt][j] = e; ls += e; }
        ls += __shfl_xor(ls, 16); ls += __shfl_xor(ls, 32);
        l = l * alpha + ls; m = mn;
#pragma unroll
        for (int i = 0; i < 8; ++i) o[i] *= alpha;
#pragma unroll
        for (int kk = 0; kk < 2; ++kk) {
            u32x4 pw; pw.x = cvt_pk_bf16(s[2 * kk][0], s[2 * kk][1]); pw.y = cvt_pk_bf16(s[2 * kk][2], s[2 * kk][3]);
            pw.z = cvt_pk_bf16(s[2 * kk + 1][0], s[2 * kk + 1][1]); pw.w = cvt_pk_bf16(s[2 * kk + 1][2], s[2 * kk + 1][3]);
            const bf16x8 pf = __builtin_bit_cast(bf16x8, pw);
#pragma unroll
            for (int dt = 0; dt < 8; ++dt) {
                const LAS unsigned char* vp = sV + (16 * dt + fr) * 144 + (32 * kk + 4 * fq) * 2;
                const u32x2 lo = *(const LAS u32x2*)vp, hi = *(const LAS u32x2*)(vp + 32);
                u32x4 vw; vw.x = lo.x; vw.y = lo.y; vw.z = hi.x; vw.w = hi.y;
                o[dt] = __builtin_amdgcn_mfma_f32_16x16x32_bf16(__builtin_bit_cast(bf16x8, vw), pf, o[dt], 0, 0, 0);
            }
        }
    }
    const float inv = 1.f / l;
    bf16_t* MIX = (bf16_t*)(ws + WS_MIX);
#pragma unroll
    for (int dt = 0; dt < 8; ++dt) {
        u32x2 ov; ov.x = cvt_pk_bf16(o[dt][0] * inv, o[dt][1] * inv); ov.y = cvt_pk_bf16(o[dt][2] * inv, o[dt][3] * inv);
        *(u32x2*)(MIX + (size_t)qrow * DM + head * 128 + 16 * dt + 4 * fq) = ov;
    }
    __syncthreads();
#undef ATT_SRC
#undef ATT_LOAD
}
__device__ __forceinline__ void r1_loads(const Params& p, int r, int tid, unsigned (&xr)[6]) {
    const int c64 = r >> 3, nb = r & 7, tok0 = c64 * 64;
    int s0, len; if (tok0 < NPR) { s0 = tok0 & ~255; len = 256; } else { s0 = NPR + ((tok0 - NPR) & ~2047); len = 2048; }
    const bf16_t* XR = (const bf16_t*)(p.ws + WS_XR);
    const int c = tid & 63, tg = tid >> 6, ch = nb * 64 + c;
    unsigned t[12];
#pragma unroll
    for (int i = 0; i < 11; ++i) { const int tk = tok0 + 8 * tg - 2 + i; t[i] = (tk >= s0 && tk < s0 + len) ? (unsigned)XR[(size_t)tk * 512 + ch] : 0u; }
    t[11] = 0u;
#pragma unroll
    for (int i = 0; i < 6; ++i) xr[i] = t[2 * i] | (t[2 * i + 1] << 16);
}
__device__ __forceinline__ void r1_tile(const Params& p, LAS unsigned char* lds, int r, unsigned (&xraw)[6], int rnext) {
    const int tid = otid(), lane = tid & 63, wave = tid >> 6, fr = lane & 15, fq = lane >> 4;
    unsigned char* ws = p.ws;
    const int c64 = r >> 3, nb = r & 7, tok0 = c64 * 64;
    int s0, len; if (tok0 < NPR) { s0 = tok0 & ~255; len = 256; } else { s0 = NPR + ((tok0 - NPR) & ~2047); len = 2048; }
    LAS float* XC = (LAS float*)lds; LAS unsigned char* XCB = lds + 16640; LAS float* A_ = (LAS float*)(lds + 25856); LAS float* U_ = (LAS float*)(lds + 58624);
    const bf16_t* XR = (const bf16_t*)(ws + WS_XR);
    bf16x8 gA[4][2], gX[4][2]; float gba[4], gbx[4], glm[4];
    {
        const int d = wave & 1; const bf16_t* GW = (const bf16_t*)(ws + WS_GW);
#pragma unroll
        for (int nt = 0; nt < 4; ++nt) {
#pragma unroll
            for (int ks = 0; ks < 2; ++ks) {
                gA[nt][ks] = *(const bf16x8*)(GW + (size_t)(((d * 2 + 0) * 8 + nb) * 64 + 16 * nt + fr) * 64 + 32 * ks + 8 * fq);
                gX[nt][ks] = *(const bf16x8*)(GW + (size_t)(((d * 2 + 1) * 8 + nb) * 64 + 16 * nt + fr) * 64 + 32 * ks + 8 * fq);
            }
            const int chn = d * 512 + nb * 64 + 16 * nt + fr;
            gba[nt] = p.in[I_BA][chn]; gbx[nt] = p.in[I_BX][chn]; glm[nt] = ((const float*)(ws + WS_SP))[chn];
        }
    }
    {
        const int c = tid & 63, tg = tid >> 6, ch = nb * 64 + c;
        const float* cw = p.in[I_CONVW]; const float w0 = cw[ch], w1 = cw[512 + ch], w2 = cw[1024 + ch], w3 = cw[1536 + ch], cb = p.in[I_CONVB][ch];
        float x[11];
#pragma unroll
        for (int i = 0; i < 11; ++i) x[i] = (i & 1) ? bfhi(xraw[i >> 1]) : bflo(xraw[i >> 1]);
#pragma unroll
        for (int k = 0; k < 8; ++k) {
            const float xc = cb + w0 * x[k] + w1 * x[k + 1] + w2 * x[k + 2] + w3 * x[k + 3];
            XC[(8 * tg + k) * 65 + c] = xc;
            *(LAS bf16_t*)(XCB + (8 * tg + k) * 144 + c * 2) = (bf16_t)(cvt_pk_bf16(xc, 0.f) & 0xffffu);
        }
    }
    if (rnext < 2048) r1_loads(p, rnext, tid, xraw);
    __syncthreads();
    {
        const int d = wave & 1, tq = wave >> 1;
        bf16x8 af[2];
#pragma unroll
        for (int ks = 0; ks < 2; ++ks) af[ks] = *(const LAS bf16x8*)(XCB + (16 * tq + fr) * 144 + (32 * ks + 8 * fq) * 2);
#pragma unroll
        for (int nt = 0; nt < 4; ++nt) {
            f32x4 aA = (f32x4){0.f, 0.f, 0.f, 0.f}, aX = (f32x4){0.f, 0.f, 0.f, 0.f};
#pragma unroll
            for (int ks = 0; ks < 2; ++ks) {
                aA = __builtin_amdgcn_mfma_f32_16x16x32_bf16(af[ks], gA[nt][ks], aA, 0, 0, 0);
                aX = __builtin_amdgcn_mfma_f32_16x16x32_bf16(af[ks], gX[nt][ks], aX, 0, 0, 0);
            }
            const int n = 16 * nt + fr, ch = nb * 64 + n;
            const float ba = gba[nt], bx = gbx[nt], sp = glm[nt];
#pragma unroll
            for (int j = 0; j < 4; ++j) {
                const int t = 16 * tq + 4 * fq + j;
                const float rg = sigmoidf_(aA[j] + ba), ig = sigmoidf_(aX[j] + bx), la = -8.f * rg * sp;
                const float av = __expf(la), uv = __builtin_amdgcn_sqrtf(one_minus_exp(2.f * la)) * ig * XC[t * 65 + n];
                A_[(d * 64 + t) * 64 + n] = av; U_[(d * 64 + t) * 64 + n] = uv;
            }
        }
    }
    __syncthreads();
    const int d = tid >> 8, sub = (tid >> 6) & 3, ch = tid & 63;
    {
        float h = 0.f, P = 1.f;
#pragma unroll
        for (int k = 0; k < 16; ++k) {
            const int t = d == 0 ? 16 * sub + k : 16 * sub + 15 - k, idx = (d * 64 + t) * 64 + ch;
            const float a = A_[idx], u = U_[idx]; h = a * h + u; P *= a; U_[idx] = h; A_[idx] = P;
        }
    }
    __syncthreads();
    {
        float chh = 0.f, cP = 1.f;
        if (d == 0) { for (int s = 0; s < sub; ++s) { const int e = (16 * s + 15) * 64 + ch; chh = U_[e] + A_[e] * chh; cP *= A_[e]; } }
        else { for (int s = 3; s > sub; --s) { const int e = (64 + 16 * s) * 64 + ch; chh = U_[e] + A_[e] * chh; cP *= A_[e]; } }
        bf16_t* HL = (bf16_t*)(ws + (d == 0 ? WS_HLF : WS_HLB)); bf16_t* PC = (bf16_t*)(ws + (d == 0 ? WS_PCF : WS_PCB));
#pragma unroll
        for (int k = 0; k < 16; ++k) {
            const int t = 16 * sub + k, idx = (d * 64 + t) * 64 + ch;
            const float hl = U_[idx], pl = A_[idx];
            const size_t g = (size_t)(tok0 + t) * 512 + nb * 64 + ch;
            const unsigned hp = cvt_pk_bf16(hl + pl * chh, pl * cP); HL[g] = (bf16_t)hp; PC[g] = (bf16_t)(hp >> 16);
        }
    }
    __syncthreads();
}
__device__ __forceinline__ void r2_tile(const Params& p, int c64) {
    const int ch = otid(); unsigned char* ws = p.ws;
    const int tok0 = c64 * 64; const bool prompt = tok0 < NPR;
    int s0, len; if (prompt) { s0 = tok0 & ~255; len = 256; } else { s0 = NPR + ((tok0 - NPR) & ~2047); len = 2048; }
    const int n = (tok0 - s0) >> 6, nc = len >> 6;
    const bf16_t* HLF = (const bf16_t*)(ws + WS_HLF); const bf16_t* HLB = (const bf16_t*)(ws + WS_HLB);
    const bf16_t* PCF = (const bf16_t*)(ws + WS_PCF); const bf16_t* PCB = (const bf16_t*)(ws + WS_PCB);
    float cf = 0.f, cb = 0.f;
    if (!prompt) { const int bs = (tok0 - NPR) >> 11; cf = p.in[I_STATE][(bs * 2 + 0) * 512 + ch]; cb = p.in[I_STATE][(bs * 2 + 1) * 512 + ch]; }
    for (int c0 = 0; c0 < n; c0 += 8) {
        float hv[8], pv[8];
#pragma unroll
        for (int i = 0; i < 8; ++i) { const int cc = (c0 + i < n) ? c0 + i : n - 1; const size_t g = (size_t)(s0 + 64 * cc + 63) * 512 + ch; hv[i] = bf2f(HLF[g]); pv[i] = bf2f(PCF[g]); }
#pragma unroll
        for (int i = 0; i < 8; ++i) if (c0 + i < n) cf = hv[i] + pv[i] * cf;
    }
    for (int c0 = nc - 1; c0 > n; c0 -= 8) {
        float hv[8], pv[8];
#pragma unroll
        for (int i = 0; i < 8; ++i) { const int cc = (c0 - i > n) ? c0 - i : n + 1; const size_t g = (size_t)(s0 + 64 * cc) * 512 + ch; hv[i] = bf2f(HLB[g]); pv[i] = bf2f(PCB[g]); }
#pragma unroll
        for (int i = 0; i < 8; ++i) if (c0 - i > n) cb = hv[i] + pv[i] * cb;
    }
    const bf16_t* XGb = (const bf16_t*)(ws + WS_XG); bf16_t* MIX = (bf16_t*)(ws + WS_MIX);
    float* ostate = p.out + (size_t)NTOK * DM + 2 * (size_t)NPR * 256;
#pragma unroll 8
    for (int t = 0; t < 64; ++t) {
        const size_t g = (size_t)(tok0 + t) * 512 + ch;
        const float hf = bf2f(__builtin_nontemporal_load(HLF + g)) + bf2f(__builtin_nontemporal_load(PCF + g)) * cf, hb = bf2f(__builtin_nontemporal_load(HLB + g)) + bf2f(__builtin_nontemporal_load(PCB + g)) * cb;
        const float y = (hf + hb) * geluf_(bf2f(XGb[g]));
        MIX[(size_t)(tok0 + t) * DM + 512 + ch] = (bf16_t)(cvt_pk_bf16(y, 0.f) & 0xffffu);
        if (prompt) {
            if (n == nc - 1 && t == 63) ostate[((tok0 >> 8) * 2 + 0) * 512 + ch] = hf;
            if (n == 0 && t == 0) ostate[((tok0 >> 8) * 2 + 1) * 512 + ch] = hb;
        }
    }
}
__device__ __forceinline__ void spatial_tile(const Params& p, LAS unsigned char* lds, int r) {
    const int tid = otid(), lane = tid & 63, wave = tid >> 6, fr = lane & 15, fq = lane >> 4;
    unsigned char* ws = p.ws;
    const int nchunk = r >> 3, g = r & 7, tok0 = nchunk * 128;
    LAS unsigned char* SA = lds; LAS unsigned char* SB = lds + 34816; LAS float* MU = (LAS float*)(lds + 69632); LAS float* RS = (LAS float*)(lds + 70144);
    if (tid < 128) {
        const float* st = (const float*)(ws + WS_VSTAT) + (size_t)(tok0 + tid) * 32;
        float s1 = 0.f, s2 = 0.f;
#pragma unroll
        for (int i = 0; i < 16; ++i) { s1 += st[2 * i]; s2 += st[2 * i + 1]; }
        const float mu = s1 * (1.f / 1024.f), var = fmaxf(s2 * (1.f / 1024.f) - mu * mu, 0.f);
        MU[tid] = mu; RS[tid] = rsqrtf(var + LN_EPS_C);
    }
    const bf16_t* SPW = (const bf16_t*)(ws + WS_SPW);
#pragma unroll
    for (int i = 0; i < 4; ++i) { const int idx = tid + 512 * i, pr = idx >> 4, c16 = idx & 15;
        *(LAS u32x4*)(SA + pr * 272 + c16 * 16) = *(const u32x4*)(SPW + (size_t)(g * 128 + pr) * 128 + c16 * 8); }
    const bf16_t* V2 = (const bf16_t*)(ws + WS_V2);
    u32x4 rawv[4];
#pragma unroll
    for (int i = 0; i < 4; ++i) { const int idx = tid + 512 * i, q = idx & 127, c8 = idx >> 7; rawv[i] = *(const u32x4*)(V2 + (size_t)(tok0 + q) * DM + g * 128 + c8 * 8); }
    __syncthreads();
#pragma unroll
    for (int i = 0; i < 4; ++i) { const int idx = tid + 512 * i, q = idx & 127, c8 = idx >> 7;
        const u32x4 raw = rawv[i];
        const float* lgp = p.in[I_SGLNG] + g * 128 + c8 * 8; const float* lbp = p.in[I_SGLNB] + g * 128 + c8 * 8;
        const f32x4 lg0 = *(const f32x4*)lgp, lg1 = *(const f32x4*)(lgp + 4), lb0 = *(const f32x4*)lbp, lb1 = *(const f32x4*)(lbp + 4);
        const float mu = MU[q], rs = RS[q];
        const unsigned w0 = cvt_pk_bf16((bflo(raw.x) - mu) * rs * lg0.x + lb0.x, (bfhi(raw.x) - mu) * rs * lg0.y + lb0.y);
        const unsigned w1 = cvt_pk_bf16((bflo(raw.y) - mu) * rs * lg0.z + lb0.z, (bfhi(raw.y) - mu) * rs * lg0.w + lb0.w);
        const unsigned w2 = cvt_pk_bf16((bflo(raw.z) - mu) * rs * lg1.x + lb1.x, (bfhi(raw.z) - mu) * rs * lg1.y + lb1.y);
        const unsigned w3 = cvt_pk_bf16((bflo(raw.w) - mu) * rs * lg1.z + lb1.z, (bfhi(raw.w) - mu) * rs * lg1.w + lb1.w);
        LAS unsigned char* sd = SB + (c8 * 8) * 272 + q * 2;
        *(LAS bf16_t*)(sd) = (bf16_t)w0; *(LAS bf16_t*)(sd + 272) = (bf16_t)(w0 >> 16); *(LAS bf16_t*)(sd + 2 * 272) = (bf16_t)w1; *(LAS bf16_t*)(sd + 3 * 272) = (bf16_t)(w1 >> 16);
        *(LAS bf16_t*)(sd + 4 * 272) = (bf16_t)w2; *(LAS bf16_t*)(sd + 5 * 272) = (bf16_t)(w2 >> 16); *(LAS bf16_t*)(sd + 6 * 272) = (bf16_t)w3; *(LAS bf16_t*)(sd + 7 * 272) = (bf16_t)(w3 >> 16); }
    __syncthreads();
    const int wr = wave >> 1, wc = wave & 1;
    const bf16_t* U = (const bf16_t*)(ws + WS_U); bf16_t* S_ = (bf16_t*)(ws + WS_MIX);
    u32x2 upre[2][4]; float bpre[2];
#pragma unroll
    for (int mt = 0; mt < 2; ++mt) { const int pr = 32 * wr + 16 * mt + fr; bpre[mt] = p.in[I_SPB][g * 128 + pr];
#pragma unroll
        for (int nt = 0; nt < 4; ++nt) upre[mt][nt] = *(const u32x2*)(U + (size_t)(tok0 + pr) * DM + g * 128 + 64 * wc + 16 * nt + 4 * fq); }
    f32x4 acc[2][4];
#pragma unroll
    for (int i = 0; i < 2; ++i)
#pragma unroll
        for (int j = 0; j < 4; ++j) acc[i][j] = (f32x4){0.f, 0.f, 0.f, 0.f};
#pragma unroll
    for (int ks = 0; ks < 4; ++ks) {
        bf16x8 af[2], bf[4];
#pragma unroll
        for (int mt = 0; mt < 2; ++mt) af[mt] = *(const LAS bf16x8*)(SA + (32 * wr + 16 * mt + fr) * 272 + (32 * ks + 8 * fq) * 2);
#pragma unroll
        for (int nt = 0; nt < 4; ++nt) bf[nt] = *(const LAS bf16x8*)(SB + (64 * wc + 16 * nt + fr) * 272 + (32 * ks + 8 * fq) * 2);
#pragma unroll
        for (int mt = 0; mt < 2; ++mt)
#pragma unroll
            for (int nt = 0; nt < 4; ++nt) acc[mt][nt] = __builtin_amdgcn_mfma_f32_16x16x32_bf16(bf[nt], af[mt], acc[mt][nt], 0, 0, 0);
    }
#pragma unroll
    for (int mt = 0; mt < 2; ++mt) {
        const int pr = 32 * wr + 16 * mt + fr; const float bias = bpre[mt];
#pragma unroll
        for (int nt = 0; nt < 4; ++nt) {
            const size_t off = (size_t)(tok0 + pr) * DM + g * 128 + 64 * wc + 16 * nt + 4 * fq;
            const u32x2 uu = upre[mt][nt];
            u32x2 ov; ov.x = cvt_pk_bf16(bflo(uu.x) * (acc[mt][nt][0] + bias), bfhi(uu.x) * (acc[mt][nt][1] + bias));
            ov.y = cvt_pk_bf16(bflo(uu.y) * (acc[mt][nt][2] + bias), bfhi(uu.y) * (acc[mt][nt][3] + bias));
            *(u32x2*)(S_ + off) = ov;
        }
    }
    __syncthreads();
}
__device__ __forceinline__ void phase_lnmix(const Params& p, LAS unsigned char* lds, int l) {
    const int tid = otid(), lane = tid & 63, wave = tid >> 6; unsigned char* ws = p.ws;
    LAS float* RW = (LAS float*)lds; LAS float* XT = (LAS float*)(lds + 65536); LAS float* PS = (LAS float*)(lds + 65536 + 65792);
    const float* rw = p.in[I_ROUTER] + (size_t)l * 16384;
    for (int i = tid; i < 4096; i += 512) *(LAS f32x4*)(RW + i * 4) = *(const f32x4*)(rw + i * 4);
    bf16_t* XA = (bf16_t*)(ws + WS_XA); unsigned char* HMOE = ws + WS_HMOE; float* AFF = (float*)(ws + WS_AFF);
    const float* gam = p.in[I_LNMG] + l * DM; const float* bet = p.in[I_LNMB] + l * DM;
    for (int tile = blockIdx.x; tile < NTOK / 16; tile += gridDim.x) {
        const int row0 = tile * 16;
        const float* modr = (const float*)(ws + WS_MOD) + (size_t)(l * 5 + cond_of(row0)) * 6144;
        f32x4 vv[2][4];
#pragma unroll
        for (int rr = 0; rr < 2; ++rr)
#pragma unroll
            for (int j = 0; j < 4; ++j) { const u32x2 w = *(const u32x2*)(XA + (size_t)(row0 + wave * 2 + rr) * DM + 4 * lane + 256 * j); vv[rr][j] = (f32x4){bflo(w.x), bfhi(w.x), bflo(w.y), bfhi(w.y)}; }
#pragma unroll
        for (int rr = 0; rr < 2; ++rr) {
            const int rl = wave * 2 + rr, row = row0 + rl;
            f32x4 v[4]; float s = 0.f;
#pragma unroll
            for (int j = 0; j < 4; ++j) { v[j] = vv[rr][j]; s += (v[j].x + v[j].y) + (v[j].z + v[j].w); }
            const float mean = wave_sum(s) * (1.f / DM); float s2 = 0.f;
#pragma unroll
            for (int j = 0; j < 4; ++j) { v[j] = v[j] - mean; s2 += (v[j].x * v[j].x + v[j].y * v[j].y) + (v[j].z * v[j].z + v[j].w * v[j].w); }
            const float rstd = rsqrtf(wave_sum(s2) * (1.f / DM) + LN_EPS_C);
#pragma unroll
            for (int j = 0; j < 4; ++j) {
                const int c = 4 * lane + 256 * j;
                const f32x4 x1 = v[j] * rstd * *(const f32x4*)(gam + c) + *(const f32x4*)(bet + c);
                { u32x2 ox; ox.x = cvt_pk_bf16(x1.x, x1.y); ox.y = cvt_pk_bf16(x1.z, x1.w); *(u32x2*)(XA + (size_t)row * DM + c) = ox; }
                const f32x4 hm = x1 * (*(const f32x4*)(modr + 4 * 1024 + c) + 1.f) + *(const f32x4*)(modr + 3 * 1024 + c);
                *(unsigned*)(HMOE + (size_t)row * DM + c) = pk4_fp8(hm.x, hm.y, hm.z, hm.w);
                *(LAS f32x4*)(XT + rl * 1028 + c) = hm;
            }
        }
        __syncthreads();
        {
            f32x4 acc = (f32x4){0.f, 0.f, 0.f, 0.f};
            const int ri = lane & 15, kq = lane >> 4, kb = wave * 128;
#pragma unroll 8
            for (int kk = 0; kk < 32; ++kk) {
                const int k = kb + 4 * kk + kq;
                acc = __builtin_amdgcn_mfma_f32_16x16x4f32(XT[ri * 1028 + k], RW[k * 16 + ri], acc, 0, 0, 0);
            }
#pragma unroll
            for (int r = 0; r < 4; ++r) PS[wave * 256 + (4 * kq + r) * 16 + ri] = acc[r];
        }
        __syncthreads();
        if (tid < 256) {
            float lg = 0.f;
#pragma unroll
            for (int w = 0; w < 8; ++w) lg += PS[w * 256 + tid];
            float mx = lg;
#pragma unroll
            for (int o = 1; o < 16; o <<= 1) mx = fmaxf(mx, __shfl_xor(mx, o));
            const float ex = __expf(lg - mx); float sm = ex;
#pragma unroll
            for (int o = 1; o < 16; o <<= 1) sm += __shfl_xor(sm, o);
            AFF[(size_t)(row0 + (tid >> 4)) * 16 + (tid & 15)] = ex / sm;
        }
        __syncthreads();
    }
}
__device__ __forceinline__ void phase_route(const Params& p, LAS unsigned char* lds) {
    const int tid = otid(), lane = tid & 63, wave = tid >> 6; unsigned char* ws = p.ws;
    LAS unsigned* key = (LAS unsigned*)lds; LAS int* idx = (LAS int*)(lds + 8192);
    const float* AFF = (const float*)(ws + WS_AFF); int* TOKSLOT = (int*)(ws + WS_TOKSLOT); float* SG = (float*)(ws + WS_SLOTGATE);
    const unsigned char* HMOE = ws + WS_HMOE; unsigned char* XG = ws + WS_XGATH;
    for (int tile = blockIdx.x; tile < 576; tile += gridDim.x) {
        int b, e, T, tok0, cap, ls0;
        if (tile < 64) { b = tile >> 4; e = tile & 15; T = 2048; tok0 = NPR + b * 2048; cap = 256; ls0 = 1024 + b * 256; }
        else { const int t2 = tile - 64; b = t2 >> 4; e = t2 & 15; T = 256; tok0 = b * 256; cap = 32; ls0 = b * 32; }
        for (int i = tid; i < T; i += 512) { key[i] = __builtin_bit_cast(unsigned, AFF[(size_t)(tok0 + i) * 16 + e]); idx[i] = i; }
        __syncthreads();
        for (int k = 2; k <= T; k <<= 1)
            for (int j = k >> 1; j > 0; j >>= 1) {
                for (int pp = tid; pp < (T >> 1); pp += 512) {
                    const int i = ((pp & ~(j - 1)) << 1) | (pp & (j - 1)), l = i | j;
                    const bool desc = (i & k) == 0;
                    const unsigned ki = key[i], kl = key[l]; const int ii = idx[i], il = idx[l];
                    const bool inorder = (ki > kl) || (ki == kl && ii < il);
                    if (inorder != desc) { key[i] = kl; key[l] = ki; idx[i] = il; idx[l] = ii; }
                }
                __syncthreads();
            }
        for (int pos = tid; pos < T; pos += 512) {
            const int tok = idx[pos];
            TOKSLOT[(size_t)(tok0 + tok) * 16 + e] = pos < cap ? ls0 + pos : -1;
            if (pos < cap) SG[e * 2048 + ls0 + pos] = __builtin_bit_cast(float, key[pos]);
        }
        for (int pos0 = wave * 4; pos0 < cap; pos0 += 32) {
            u32x4 rowv[4];
#pragma unroll
            for (int q = 0; q < 4; ++q) rowv[q] = ((const u32x4*)(HMOE + (size_t)(tok0 + idx[pos0 + q]) * DM))[lane];
#pragma unroll
            for (int q = 0; q < 4; ++q) ((u32x4*)(XG + (size_t)(e * 2048 + ls0 + pos0 + q) * DM))[lane] = rowv[q];
        }
        __syncthreads();
    }
}
__device__ __forceinline__ void phase_lnffn(const Params& p, int l) {
    const int tid = otid(), lane = tid & 63, wave = tid >> 6; unsigned char* ws = p.ws;
    bf16_t* XA = (bf16_t*)(ws + WS_XA); bf16_t* H = (bf16_t*)(ws + WS_H); const bf16_t* Y = (const bf16_t*)(ws + WS_Y); const int* TOKSLOT = (const int*)(ws + WS_TOKSLOT);
    const float* gam = p.in[I_LNFG] + l * DM; const float* bet = p.in[I_LNFB] + l * DM;
    const int rstride = gridDim.x * 8;
    int slv_n = 0; u32x2 xr_n[4];
    { const int row = blockIdx.x * 8 + wave;
      if (row < NTOK) { slv_n = TOKSLOT[(size_t)row * 16 + (lane & 15)];
#pragma unroll
          for (int j = 0; j < 4; ++j) xr_n[j] = *(const u32x2*)(XA + (size_t)row * DM + 4 * lane + 256 * j); } }
    for (int row = blockIdx.x * 8 + wave; row < NTOK; row += rstride) {
        const int cond = cond_of(row);
        const int slv = slv_n; u32x2 xr_c[4];
#pragma unroll
        for (int j = 0; j < 4; ++j) xr_c[j] = xr_n[j];
        if (row + rstride < NTOK) {
            slv_n = TOKSLOT[(size_t)(row + rstride) * 16 + (lane & 15)];
#pragma unroll
            for (int j = 0; j < 4; ++j) xr_n[j] = *(const u32x2*)(XA + (size_t)(row + rstride) * DM + 4 * lane + 256 * j);
        }
        const float* modr = (const float*)(ws + WS_MOD) + (size_t)(l * 5 + cond) * 6144;
        f32x4 f[4], xres[4];
#pragma unroll
        for (int j = 0; j < 4; ++j) { f[j] = (f32x4){0.f, 0.f, 0.f, 0.f}; { const u32x2 w = xr_c[j]; xres[j] = (f32x4){bflo(w.x), bfhi(w.x), bflo(w.y), bfhi(w.y)}; } }
        {
            unsigned long long m = __builtin_amdgcn_ballot_w64(slv >= 0) & 0xffffull;
            while (m) {
                const int e0 = __builtin_ctzll(m); m &= m - 1;
                const bool two = m != 0; const int e1 = two ? __builtin_ctzll(m) : e0; if (two) m &= m - 1;
                const int s0 = __builtin_amdgcn_readlane(slv, e0), s1 = __builtin_amdgcn_readlane(slv, e1);
                const bf16_t* y0 = Y + (size_t)(e0 * 2048 + s0) * DM; const bf16_t* y1 = Y + (size_t)(e1 * 2048 + s1) * DM;
                u32x2 w0[4], w1[4];
#pragma unroll
                for (int j = 0; j < 4; ++j) { w0[j] = __builtin_nontemporal_load((const u32x2*)(y0 + 4 * lane + 256 * j)); w1[j] = __builtin_nontemporal_load((const u32x2*)(y1 + 4 * lane + 256 * j)); }
                const float k1 = two ? 1.f : 0.f;
#pragma unroll
                for (int j = 0; j < 4; ++j) {
                    f[j].x += bflo(w0[j].x) + k1 * bflo(w1[j].x); f[j].y += bfhi(w0[j].x) + k1 * bfhi(w1[j].x);
                    f[j].z += bflo(w0[j].y) + k1 * bflo(w1[j].y); f[j].w += bfhi(w0[j].y) + k1 * bfhi(w1[j].y);
                }
            }
        }
        f32x4 v[4]; float s = 0.f;
#pragma unroll
        for (int j = 0; j < 4; ++j) { const int c = 4 * lane + 256 * j;
            v[j] = xres[j] * ALPHA_C + *(const f32x4*)(modr + 5 * 1024 + c) * f[j];
            s += (v[j].x + v[j].y) + (v[j].z + v[j].w); }
        const float mean = wave_sum(s) * (1.f / DM); float s2 = 0.f;
#pragma unroll
        for (int j = 0; j < 4; ++j) { v[j] = v[j] - mean; s2 += (v[j].x * v[j].x + v[j].y * v[j].y) + (v[j].z * v[j].z + v[j].w * v[j].w); }
        const float rstd = rsqrtf(wave_sum(s2) * (1.f / DM) + LN_EPS_C);
        const float* modn = (const float*)(ws + WS_MOD) + (size_t)(5 + cond) * 6144;
#pragma unroll
        for (int j = 0; j < 4; ++j) {
            const int c = 4 * lane + 256 * j;
            const f32x4 x2 = v[j] * rstd * *(const f32x4*)(gam + c) + *(const f32x4*)(bet + c);
            if (l == 0) {
                { u32x2 ox; ox.x = cvt_pk_bf16(x2.x, x2.y); ox.y = cvt_pk_bf16(x2.z, x2.w); *(u32x2*)(XA + (size_t)row * DM + c) = ox; }
                const f32x4 h = x2 * (*(const f32x4*)(modn + 1024 + c) + 1.f) + *(const f32x4*)(modn + c);
                u32x2 o; o.x = cvt_pk_bf16(h.x, h.y); o.y = cvt_pk_bf16(h.z, h.w);
                *(u32x2*)(H + (size_t)row * DM + c) = o;
            } else __builtin_nontemporal_store(x2, (f32x4*)(p.out + (size_t)row * DM + c));
        }
    }
}
#ifndef PHMASK
#define PHMASK 0xFFFFF
#endif
template <int PH> __device__ __forceinline__ void run_phase(const Params& p, LAS unsigned char* lds) {
    unsigned char* ws = p.ws;
    const int G = gridDim.x;
    constexpr int l = PH >= 11 ? 1 : 0;
    constexpr int base = PH >= 13 ? PH - 8 : PH;
    if constexpr (!(((PHMASK) >> (base)) & 1)) return;
    if constexpr (base == 0) phase_p0(p, lds);
    else if constexpr (base == 1) phase_p0b(p);
    else if constexpr (base == 2) {
        pg8::Gemm g; g.A = (const bf16_t*)(ws + WS_H); g.Bt = (const bf16_t*)(ws + WS_ABIN); g.M = NTOK; g.N = 2048; g.K = 1024;
        pg8::StaticOrder S; S.init(NTOK, 2048, G, blockIdx.x);
        EpiIn E; E.Q = (bf16_t*)(ws + WS_Q); E.Kb = (bf16_t*)(ws + WS_K); E.Vb = (bf16_t*)(ws + WS_V); E.XR = (bf16_t*)(ws + WS_XR); E.XGb = (bf16_t*)(ws + WS_XG);
        E.outK = p.out + (size_t)NTOK * DM; E.outV = p.out + (size_t)NTOK * DM + (size_t)NPR * 256; E.rope = (const float*)(ws + WS_ROPE);
        pg8::gemm_phase<EpiIn, pg8::StaticOrder, true, true>(lds, g, S, E);
    } else if constexpr (base == 3) {
        unsigned xraw[6]; bool primed = false;
        for (int t = blockIdx.x; t < 512 + 2048; t += G) {
            if (t < 512) attn_tile(p, lds, t);
            else { if (!primed) { r1_loads(p, t - 512, otid(), xraw); primed = true; } r1_tile(p, lds, t - 512, xraw, t - 512 + G); } }
    } else if constexpr (base == 4) {
        for (int t = blockIdx.x; t < 256; t += G) r2_tile(p, t);
    } else if constexpr (base == 5) {
        pg8::Gemm g; g.A = (const bf16_t*)(ws + WS_MIX); g.Bt = (const bf16_t*)(ws + (l ? WS_SGOUT : WS_ABOUT)); g.M = NTOK; g.N = 1024; g.K = 1024;
        pg8::StaticOrder S; S.init(NTOK, 1024, G, blockIdx.x);
        EpiOut<(l == 1)> E; E.XA = (bf16_t*)(ws + WS_XA); E.modl = (const float*)(ws + WS_MOD) + (size_t)l * 5 * 6144;
        E.xin_p = p.in[I_XP]; E.xin_s = p.in[I_XS];
        pg8::gemm_phase<EpiOut<(l == 1)>, pg8::StaticOrder, true, true>(lds, g, S, E);
    } else if constexpr (base == 6) phase_lnmix(p, lds, l);
    else if constexpr (base == 7) phase_route(p, lds);
    else if constexpr (base == 8) {
        pg8::Gemm g; g.A = (const bf16_t*)(ws + WS_XGATH); g.Bt = (const bf16_t*)(ws + WS_BTUP + (size_t)l * 16 * 4096 * 1024); g.M = 32768; g.N = 65536; g.K = 512;
        pg8::GroupOrder<2048, 128, 16> S; S.G = G; S.c = blockIdx.x;
        EpiUp E; E.Hid = ws + WS_HID;
        pg8::gemm_phase<EpiUp, pg8::GroupOrder<2048, 128, 16>, true, true, true>(lds, g, S, E);
    } else if constexpr (base == 9) {
        pg8::Gemm g; g.A = (const bf16_t*)(ws + WS_HID); g.Bt = (const bf16_t*)(ws + WS_BTDN + (size_t)l * 16 * 1024 * 2048); g.M = 32768; g.N = 16384; g.K = 1024;
        pg8::GroupOrder<512, 32, 4> S; S.G = G; S.c = blockIdx.x;
        EpiDn E; E.Y = (bf16_t*)(ws + WS_Y); E.gate = (const float*)(ws + WS_SLOTGATE);
        pg8::gemm_phase<EpiDn, pg8::GroupOrder<512, 32, 4>, true, true, true>(lds, g, S, E);
    } else if constexpr (base == 10) phase_lnffn(p, l);
    else if constexpr (base == 11) {
        pg8::Gemm g; g.A = (const bf16_t*)(ws + WS_H); g.Bt = (const bf16_t*)(ws + WS_SGIN); g.M = NTOK; g.N = 2048; g.K = 1024;
        pg8::StaticOrder S; S.init(NTOK, 2048, G, blockIdx.x);
        EpiSgu E; E.U = (bf16_t*)(ws + WS_U); E.V2 = (bf16_t*)(ws + WS_V2); E.vstat = (float*)(ws + WS_VSTAT); E.bias = p.in[I_SGINB];
        pg8::gemm_phase<EpiSgu, pg8::StaticOrder, true, true>(lds, g, S, E);
    } else if constexpr (base == 12) {
        for (int t = blockIdx.x; t < 1024; t += G) spatial_tile(p, lds, t);
    }
}
__global__ void __launch_bounds__(512, 2) fwd_kernel(Params p) {
    extern __shared__ __attribute__((aligned(16))) unsigned char smem[];
    LAS unsigned char* lds = (LAS unsigned char*)smem;
    volatile LAS unsigned* xst = (volatile LAS unsigned*)(lds + LDS_BYTES - 16);
    if (threadIdx.x == 0) { xst[0] = 0u; xst[1] = 0u; }
    __syncthreads();
    XcdBarrier xb = xcd_barrier_post((unsigned*)(p.ws + WS_BAR), xst);
#ifndef DUPMASK
#define DUPMASK 0
#endif
#define PHASE(k) if (p.ph_lo <= (k) && (k) < p.ph_hi) { run_phase<k>(p, lds); if constexpr (((DUPMASK) >> (k)) & 1) { xcd_barrier(xb); run_phase<k>(p, lds); } \
        if ((k) + 1 < p.ph_hi) { if ((k) == 0 && p.ph_hi > NPHASE) cg::this_grid().sync(); else xcd_barrier(xb); } }
    PHASE(0) PHASE(1) PHASE(2) PHASE(3) PHASE(4) PHASE(5) PHASE(6) PHASE(7) PHASE(8) PHASE(9)
    PHASE(10) PHASE(11) PHASE(12) PHASE(13) PHASE(14) PHASE(15) PHASE(16) PHASE(17) PHASE(18)
#undef PHASE
}

extern "C" void kernel_launch(void* const* d_in, const int* in_sizes, int n_in, void* d_out, int out_size, void* d_ws, size_t ws_size, hipStream_t stream) {
    static int grid = 0;
    if (grid == 0) {
        if (n_in != 34 || ws_size < WS_END) { fprintf(stderr, "kernel_launch: expected 34 inputs and >= %zu bytes of workspace; got %d, %zu\n", (size_t)WS_END, n_in, ws_size); grid = -1; return; }
        int dev = 0, cus = 0, per_cu = 0;
        hipGetDevice(&dev);
        hipDeviceGetAttribute(&cus, hipDeviceAttributeMultiprocessorCount, dev);
        if (hipFuncSetAttribute((const void*)fwd_kernel, hipFuncAttributeMaxDynamicSharedMemorySize, LDS_BYTES) != hipSuccess) { fprintf(stderr, "kernel_launch: hipFuncSetAttribute failed\n"); grid = -1; return; }
        hipOccupancyMaxActiveBlocksPerMultiprocessor(&per_cu, (const void*)fwd_kernel, 512, LDS_BYTES);
        if (per_cu < 1) { fprintf(stderr, "kernel_launch: occupancy query says %d blocks per CU\n", per_cu); per_cu = 1; }
        (void)hipGetLastError();
        grid = cus;
        if (grid % 8 != 0 || grid <= 0) grid = 256;
    }
    if (grid < 0) return;
    if (hipMemsetAsync((unsigned char*)d_ws + WS_BAR, 0, 16384, stream) != hipSuccess) { fprintf(stderr, "kernel_launch: memset of the barrier words failed\n"); return; }
    Params p{};
    for (int i = 0; i < 34; ++i) p.in[i] = (const float*)d_in[i];
    p.out = (float*)d_out; p.ws = (unsigned char*)d_ws;
#if N_SPLIT
    for (int ph = 0; ph < NPHASE; ++ph) { p.ph_lo = ph; p.ph_hi = ph + 1; hipLaunchKernelGGL(fwd_kernel, dim3(grid), dim3(512), LDS_BYTES, stream, p); }
#else
    p.ph_lo = 0; p.ph_hi = NPHASE;
    void* args[] = {&p};
    hipError_t e = hipLaunchCooperativeKernel((const void*)fwd_kernel, dim3(grid), dim3(512), args, LDS_BYTES, stream);
    if (e != hipSuccess) fprintf(stderr, "cooperative launch failed: %s (grid %d)\n", hipGetErrorString(e), grid);
#endif
}
```

```cpp
#include <hip/hip_runtime.h>
#include <hip/hip_cooperative_groups.h>
#include <cstdio>
#include <cstdint>
namespace cg = cooperative_groups;

#define LAS __attribute__((address_space(3)))
typedef unsigned short bf16_t;
typedef short bf16x8 __attribute__((ext_vector_type(8)));
typedef short s16x4 __attribute__((ext_vector_type(4)));
typedef float f32x4 __attribute__((ext_vector_type(4)));
typedef float f32x2 __attribute__((ext_vector_type(2)));
typedef unsigned u32x4 __attribute__((ext_vector_type(4)));
typedef unsigned u32x2 __attribute__((ext_vector_type(2)));

#ifndef N_SPLIT
#define N_SPLIT 0
#endif

constexpr int NTOK = 16384, DM = 1024, NPR = 8192;
constexpr float ALPHA_C = 1.41421356237309515f;
constexpr float ATTN_SCALE_C = 0.08838834764831845f;
constexpr float LN_EPS_C = 1e-6f;
constexpr int LDS_BYTES = 147456;
constexpr int NPHASE = 19;

constexpr size_t MB = 1024ull * 1024ull;
constexpr size_t WS_BTUP = 0;
constexpr size_t WS_BTDN = WS_BTUP + 256 * MB;
constexpr size_t WS_ABIN = WS_BTDN + 128 * MB;
constexpr size_t WS_ABOUT = WS_ABIN + 4 * MB;
constexpr size_t WS_SGIN = WS_ABOUT + 2 * MB;
constexpr size_t WS_SGOUT = WS_SGIN + 4 * MB;
constexpr size_t WS_SPW = WS_SGOUT + 2 * MB;
constexpr size_t WS_GW = WS_SPW + 262144;
constexpr size_t WS_MODP = WS_GW + 262144;
constexpr size_t WS_MOD = WS_MODP + 2 * MB;
constexpr size_t WS_SP = WS_MOD + 245760;
constexpr size_t WS_ROPE = WS_MOD + 262144;
constexpr size_t WS_CK = WS_ROPE + 32768;
constexpr size_t WS_CV = WS_CK + 524288;
constexpr size_t WS_AFF = WS_CV + 524288;
constexpr size_t WS_TOKSLOT = WS_AFF + 1 * MB;
constexpr size_t WS_SLOTGATE = WS_TOKSLOT + 1 * MB;
constexpr size_t WS_VSTAT = WS_SLOTGATE + 131072;
constexpr size_t WS_H = WS_VSTAT + 2 * MB;
constexpr size_t WS_HMOE = WS_H + 32 * MB;
constexpr size_t WS_XA = WS_HMOE + 32 * MB;
constexpr size_t WS_QKV = WS_XA + 64 * MB;
constexpr size_t WS_Q = WS_QKV;
constexpr size_t WS_K = WS_QKV + 16 * MB;
constexpr size_t WS_V = WS_QKV + 24 * MB;
constexpr size_t WS_XR = WS_QKV + 32 * MB;
constexpr size_t WS_XG = WS_QKV + 48 * MB;
constexpr size_t WS_U = WS_QKV;
constexpr size_t WS_V2 = WS_QKV + 32 * MB;
constexpr size_t WS_MIX = WS_QKV + 64 * MB;
constexpr size_t WS_BIG = WS_MIX + 32 * MB;
constexpr size_t WS_HLF = WS_BIG, WS_HLB = WS_BIG + 32 * MB, WS_PCF = WS_BIG + 64 * MB, WS_PCB = WS_BIG + 96 * MB;
constexpr size_t WS_HID = WS_BIG;
constexpr size_t WS_XGATH = WS_BIG + 128 * MB;
constexpr size_t WS_Y = WS_XGATH + 64 * MB;
constexpr size_t WS_BAR = WS_Y + 64 * MB;
constexpr size_t WS_END = WS_BAR + 16384;

struct Params { const float* in[34]; float* out; unsigned char* ws; int ph_lo, ph_hi; };

enum { I_XP = 0, I_XS, I_CK, I_CV, I_STATE, I_C, I_CCTX, I_MODW, I_MODB, I_LNMG, I_LNMB, I_LNFG, I_LNFB, I_ABIN, I_SINK, I_CONVW, I_CONVB,
       I_WA, I_BA, I_WX, I_BX, I_LAM, I_ABOUT, I_SGIN, I_SGINB, I_SGLNG, I_SGLNB, I_SPW, I_SPB, I_SGOUT, I_ROUTER, I_W1, I_W3, I_W2 };

__device__ __forceinline__ unsigned cvt_pk_bf16(float lo, float hi) { unsigned r; asm volatile("v_cvt_pk_bf16_f32 %0, %1, %2" : "=v"(r) : "v"(lo), "v"(hi)); return r; }
__device__ __forceinline__ float bf2f(unsigned h) { return __builtin_bit_cast(float, h << 16); }
__device__ __forceinline__ float bflo(unsigned w) { return __builtin_bit_cast(float, w << 16); }
__device__ __forceinline__ float bfhi(unsigned w) { return __builtin_bit_cast(float, w & 0xffff0000u); }
__device__ __forceinline__ float wave_sum(float v) {
#pragma unroll
    for (int o = 1; o < 64; o <<= 1) v += __shfl_xor(v, o);
    return v;
}
__device__ __forceinline__ float sigmoidf_(float x) { return __builtin_amdgcn_rcpf(1.f + __builtin_amdgcn_exp2f(x * -1.4426950408889634f)); }
__device__ __forceinline__ float siluf_(float x) { return x * __builtin_amdgcn_rcpf(1.f + __builtin_amdgcn_exp2f(x * -1.4426950408889634f)); }
__device__ __forceinline__ float geluf_(float x) { const float t = x * (-2.3022082f + -0.10294324f * (x * x)); return x * __builtin_amdgcn_rcpf(1.f + __builtin_amdgcn_exp2f(t)); }
__device__ __forceinline__ float one_minus_exp(float x) {
    const float pl = -x * (1.f + x * (0.5f + x * (0.16666667f + x * (0.041666668f + x * (0.0083333338f + x * 0.0013888889f)))));
    return x > -0.5f ? pl : 1.f - __expf(x);
}
__device__ __forceinline__ int cond_of(int row) { return row < NPR ? 0 : 1 + ((row - NPR) >> 11); }
__device__ __forceinline__ int otid() { int t = threadIdx.x; asm volatile("" : "+v"(t)); return t; }
#define LDS_WAIT() asm volatile("s_waitcnt lgkmcnt(0)" ::: "memory")

#define XB_TMO      128
#define XB_XCNT(j)  (256  + 64 * (j))
#define XB_XSUB(j)  (1280 + 64 * (j))
#define XB_XGEN(j)  (2304 + 64 * (j))
#define XB_TOP      3328
#define XB_TOPGEN   3392
#define XCD_BAR_WORDS 3456
#define XB_SPIN_CAP (1u << 18)

__device__ __forceinline__ unsigned xb_ld(unsigned* p)              { return __hip_atomic_load(p, __ATOMIC_RELAXED, __HIP_MEMORY_SCOPE_AGENT); }
__device__ __forceinline__ unsigned xb_add(unsigned* p, unsigned v) { return __hip_atomic_fetch_add(p, v, __ATOMIC_RELAXED, __HIP_MEMORY_SCOPE_AGENT); }
__device__ __forceinline__ unsigned xb_xcc_id() { return (unsigned)__builtin_amdgcn_s_getreg((3 << 11) | 20) & 0xFu; }
#define XB_SPIN(cond, bar) do { unsigned _sp = 0; while (cond) { __builtin_amdgcn_s_sleep(1); \
    if ((++_sp & 255u) == 0u) { if (xb_ld(&(bar)[XB_TMO])) break; if (_sp > XB_SPIN_CAP) { atomicAdd(&(bar)[XB_TMO], 1u); break; } } } } while (0)

struct XcdBarrier {
    unsigned* bar; unsigned x;
    volatile LAS unsigned* st;
};

__device__ __forceinline__ XcdBarrier xcd_barrier_post(unsigned* bar, volatile LAS unsigned* st) {
    XcdBarrier b; b.bar = bar; b.x = xb_xcc_id(); b.st = st;
    if (threadIdx.x == 0) (void)xb_add(&bar[XB_XCNT(b.x)], 1u);
    return b;
}
__device__ __forceinline__ void xcd_barrier_complete(unsigned* bar, unsigned x, unsigned& nloc, unsigned& nx) {
    const unsigned G = gridDim.x * gridDim.y * gridDim.z;
    unsigned sum, cnt, mine, sp = 0u;
    for (;;) {
        sum = 0u; cnt = 0u; mine = 0u;
#pragma unroll
        for (unsigned j = 0; j < 16; ++j) { const unsigned c = xb_ld(&bar[XB_XCNT(j)]); sum += c; cnt += (c > 0u) ? 1u : 0u; mine = (j == x) ? c : mine; }
        if (sum == G) break;
        __builtin_amdgcn_s_sleep(1);
        if ((++sp & 255u) == 0u) { if (xb_ld(&bar[XB_TMO])) break; if (sp > XB_SPIN_CAP) { atomicAdd(&bar[XB_TMO], 1u); break; } }
    }
    nloc = mine > 0u ? mine : 1u; nx = cnt > 0u ? cnt : 1u;
}

__device__ __forceinline__ void xcd_barrier(const XcdBarrier& b) {
    asm volatile("s_waitcnt vmcnt(0)" ::: "memory");
    __syncthreads();
    if (threadIdx.x == 0) {
        unsigned* bar = b.bar;
        __builtin_amdgcn_s_waitcnt(0);
        unsigned nloc = b.st[0], nx = b.st[1];
        if (nloc == 0u) { xcd_barrier_complete(bar, b.x, nloc, nx); b.st[0] = nloc; b.st[1] = nx; }
        const unsigned old = xb_add(&bar[XB_XSUB(b.x)], 1u);
        const unsigned gen = old / nloc;
        if (old + 1u == (gen + 1u) * nloc) {
            __builtin_amdgcn_fence(__ATOMIC_RELEASE, "agent");
            asm volatile("s_waitcnt vmcnt(0)" ::: "memory");
            const unsigned og = xb_add(&bar[XB_TOP], 1u);
            const unsigned tg = og / nx;
            if (og + 1u == (tg + 1u) * nx) xb_add(&bar[XB_TOPGEN], 1u);
            else XB_SPIN(xb_ld(&bar[XB_TOPGEN]) == tg, bar);
            __builtin_amdgcn_fence(__ATOMIC_ACQUIRE, "agent");
            xb_add(&bar[XB_XGEN(b.x)], 1u);
            asm volatile("s_waitcnt vmcnt(0)" ::: "memory");
        } else {
            XB_SPIN(xb_ld(&bar[XB_XGEN(b.x)]) == gen, bar);
            __builtin_amdgcn_fence(__ATOMIC_ACQUIRE, "agent");
            asm volatile("s_waitcnt vmcnt(0)" ::: "memory");
        }
    }
    __syncthreads();
}

namespace pg8 {
#define PG8_LAS __attribute__((address_space(3)))
constexpr int BM = 256, BK = 64, HALF = 128, HTB = HALF * BK * 2, STAGE_BYTES = 8 * HTB, NXCD = 8, WGM = 8;
__host__ __device__ __forceinline__ int lds_byte(int r, int c) { const int st = (r >> 4) * 2 + (c >> 5), rr = r & 15, cc = c & 31, ob = rr * 64 + cc * 2; return st * 1024 + (ob ^ (((ob >> 9) & 1) << 5)); }
__host__ __device__ __forceinline__ void stage_rc(int b, int& R, int& C) { const int st = b / 1024, sb = b % 1024, swz = sb ^ (((sb >> 9) & 1) << 5); R = (st >> 1) * 16 + swz / 64; C = (st & 1) * 32 + (swz % 64) / 2; }
__host__ __device__ __forceinline__ int perm32(int rho) { const int n = rho >> 4, i = rho & 15; return 8 * (i >> 2) + 4 * n + (i & 3); }
typedef int v4i_t __attribute__((ext_vector_type(4)));
typedef int v8i_t __attribute__((ext_vector_type(8)));
struct Unit { int pm, pn; };
struct Gemm { const bf16_t* A; const bf16_t* Bt; int M, N, K; };
struct StaticOrder {
    int nM, nN, nwg, G, c;
    __host__ __device__ void init(int M, int N, int G_, int c_) { nM = M / BM; nN = N / BM; nwg = nM * nN; G = G_; c = c_; }
    __host__ __device__ bool next(int i, Unit& u) const {
        const long L = (long)i * G + c; if (L >= nwg) return false;
        int wgid = (int)L; { const int q = nwg / NXCD, r = nwg % NXCD, xcd = wgid % NXCD, off = wgid / NXCD; wgid = (xcd < r ? xcd * (q + 1) : r * (q + 1) + (xcd - r) * q) + off; }
        const int nig = WGM * nN, gid = wgid / nig, fm = gid * WGM, gsz = (nM - fm) < WGM ? (nM - fm) : WGM;
        u.pm = fm + ((wgid % nig) % gsz); u.pn = (wgid % nig) / gsz; return true;
    }
    __device__ __forceinline__ void a_ready(const Unit&) const {}
    __device__ __forceinline__ void done(const Unit&) const {}
};
template <int NU, int UPE, int PNE> struct GroupOrder {
    int G, c;
    __device__ __forceinline__ bool next(int i, Unit& u) const {
        const long L = (long)i * G + c; if (L >= NU) return false;
        const int w = ((int)L % NXCD) * (NU / NXCD) + (int)L / NXCD;
        const int e = w / UPE, v = w % UPE;
        u.pm = e * 8 + (v & 7); u.pn = e * PNE + (v >> 3); return true;
    }
    __device__ __forceinline__ void a_ready(const Unit&) const {}
    __device__ __forceinline__ void done(const Unit&) const {}
};
template <class Epi, class Sched, bool ALIGN_EPI = false, bool SP2 = false, bool F8 = false>
__device__ __forceinline__ void gemm_phase(PG8_LAS unsigned char* lds, const Gemm g, const Sched& S, const Epi& E) {
    const int tid = otid(), wid = __builtin_amdgcn_readfirstlane(tid >> 6), lane = tid & 63, wr = wid >> 2, wc = wid & 3, fr = lane & 15, fq = lane >> 4;
    const int K = g.K, nt = K / BK;
    unsigned laneA, uA[2], uB[2];
    { const int sb = lane * 16, swz = sb ^ (((sb >> 9) & 1) << 5), sR = swz / 64, sC = (swz % 64) / 2;
      laneA = (unsigned)(sR * K + sC) * 2u;
#pragma unroll
      for (int i = 0; i < 2; ++i) { const int st = wid + 8 * i;
          uA[i] = (unsigned)(((st >> 1) * 16) * K + (st & 1) * 32) * 2u;
          uB[i] = Epi::PERM ? (unsigned)(((st >> 2) * 32 + 4 * ((st >> 1) & 1)) * K + (st & 1) * 32) * 2u : uA[i]; } }
    const size_t kstep = (size_t)(BK * 2);
    const size_t hstep = (size_t)HALF * K * 2;
    const size_t tstep = 2 * hstep;
    const unsigned ldsw = (unsigned)wid * 1024u;
    const int aoff = lds_byte(wr * 64 + fr, fq * 8), boff = lds_byte(wc * 32 + fr, fq * 8);
#define PG8_SA(b, h) (((b) * 2 + (h)) * HTB)
#define PG8_SB(b, h) ((4 + (b) * 2 + (h)) * HTB)
#define voffA 0
#define voffB 1
#define PG8_STAGE(bufoff, gbase, voff) do { _Pragma("unroll") for (int _i = 0; _i < 2; ++_i) { \
        unsigned vo_ = laneA; asm volatile("" : "+v"(vo_)); if ((voff) == 1 && Epi::PERM) vo_ += (unsigned)((otid() >> 4) & 3) * (unsigned)(8 * K); const unsigned uo_ = ((voff) == 1 ? uB[_i] : uA[_i]); \
        __builtin_amdgcn_global_load_lds((const unsigned*)((const char*)(gbase) + uo_ + vo_), (PG8_LAS unsigned*)(lds + (bufoff) + ldsw + _i * 8192), 16, 0, 0); } } while (0)
#define PG8_LDA(dst, b, h) do { if constexpr (F8) { _Pragma("unroll") for (int m = 0; m < 4; ++m) dst##8[m] = __builtin_shufflevector(*(const PG8_LAS v4i_t*)(lds + PG8_SA(b, h) + aoff + m * 2048), *(const PG8_LAS v4i_t*)(lds + PG8_SA(b, h) + aoff + m * 2048 + 1024), 0, 1, 2, 3, 4, 5, 6, 7); } \
    else { _Pragma("unroll") for (int m = 0; m < 4; ++m) _Pragma("unroll") for (int k = 0; k < 2; ++k) dst[m][k] = *(const PG8_LAS bf16x8*)(lds + PG8_SA(b, h) + aoff + m * 2048 + k * 1024); } } while (0)
#define PG8_LDB(dst, b, h) do { if constexpr (F8) { _Pragma("unroll") for (int n = 0; n < 2; ++n) dst##8[n] = __builtin_shufflevector(*(const PG8_LAS v4i_t*)(lds + PG8_SB(b, h) + boff + n * 2048), *(const PG8_LAS v4i_t*)(lds + PG8_SB(b, h) + boff + n * 2048 + 1024), 0, 1, 2, 3, 4, 5, 6, 7); } \
    else { _Pragma("unroll") for (int n = 0; n < 2; ++n) _Pragma("unroll") for (int k = 0; k < 2; ++k) dst[n][k] = *(const PG8_LAS bf16x8*)(lds + PG8_SB(b, h) + boff + n * 2048 + k * 1024); } } while (0)
#define PG8_MMA(ai, bj, At, Bt) do { __builtin_amdgcn_s_setprio(1); _Pragma("unroll") for (int m = 0; m < 4; ++m) _Pragma("unroll") for (int n = 0; n < 2; ++n) { \
        if constexpr (F8) asm volatile("v_mfma_scale_f32_16x16x128_f8f6f4 %0, %1, %2, %0, %3, %3 op_sel_hi:[0,0,0]" : "+a"(acc[ai][bj][m][n]) : "v"(Bt##8[n]), "v"(At##8[m]), "v"(sc127)); \
        else { _Pragma("unroll") for (int k = 0; k < 2; ++k) asm volatile("v_mfma_f32_16x16x32_bf16 %0, %1, %2, %0" : "+a"(acc[ai][bj][m][n]) : "v"(Bt[n][k]), "v"(At[m][k])); } } \
        __builtin_amdgcn_s_setprio(0); } while (0)
#define PG8_WAIT_V(n) asm volatile("s_waitcnt vmcnt(" #n ")" ::: "memory")
#define PG8_WAIT_L(n) asm volatile("s_waitcnt lgkmcnt(" #n ")" ::: "memory")
#define PG8_BAR __builtin_amdgcn_s_barrier()
#define PG8_SCHED __builtin_amdgcn_sched_barrier(0)
    Unit cur, nxt; int ui = 0;
    if (!S.next(0, cur)) return;
    f32x4 acc[2][2][4][2];
#pragma unroll
    for (int a = 0; a < 2; ++a)
#pragma unroll
        for (int b = 0; b < 2; ++b)
#pragma unroll
            for (int m = 0; m < 4; ++m)
#pragma unroll
                for (int n = 0; n < 2; ++n) acc[a][b][m][n] = (f32x4){0.f, 0.f, 0.f, 0.f};
    bf16x8 At[4][2], B0[2][2], B1[2][2]; v8i_t At8[4], B08[2], B18[2]; const int sc127 = 0x7f7f7f7f;
    const char* cA = (const char*)g.A + (size_t)cur.pm * tstep; const char* cB = (const char*)g.Bt + (size_t)cur.pn * tstep;
    S.a_ready(cur);
    if constexpr (SP2) {
        PG8_STAGE(PG8_SB(0, 0), cB, voffB); PG8_STAGE(PG8_SB(0, 1), cB + hstep, voffB); PG8_STAGE(PG8_SA(0, 0), cA, voffA); PG8_STAGE(PG8_SA(0, 1), cA + hstep, voffA);
        if (wr == 1) PG8_BAR;
        PG8_WAIT_V(2); PG8_BAR;
        PG8_STAGE(PG8_SB(1, 0), cB + kstep, voffB); PG8_STAGE(PG8_SA(1, 0), cA + kstep, voffA); PG8_STAGE(PG8_SB(1, 1), cB + hstep + kstep, voffB);
        PG8_WAIT_V(6); PG8_BAR;
    } else {
        PG8_STAGE(PG8_SB(0, 0), cB, voffB); PG8_STAGE(PG8_SA(0, 0), cA, voffA); PG8_STAGE(PG8_SB(0, 1), cB + hstep, voffB); PG8_STAGE(PG8_SA(0, 1), cA + hstep, voffA);
        if (wr == 1) PG8_BAR;
        PG8_WAIT_V(4); PG8_BAR;
        PG8_STAGE(PG8_SB(1, 0), cB + kstep, voffB); PG8_STAGE(PG8_SA(1, 0), cA + kstep, voffA); PG8_STAGE(PG8_SB(1, 1), cB + hstep + kstep, voffB);
        PG8_WAIT_V(6); PG8_BAR;
    }
    for (;;) {
        const bool has_next = S.next(ui + 1, nxt);
        const char* nA = has_next ? (const char*)g.A + (size_t)nxt.pm * tstep : cA; const char* nB = has_next ? (const char*)g.Bt + (size_t)nxt.pn * tstep : cB;
#pragma nounroll
        for (int t = 0; t < nt; t += 2) {
            const bool last = (t == nt - 2);
            const char* a1 = cA + (size_t)(t + 1) * kstep;
            const char* a2 = last ? nA : cA + (size_t)(t + 2) * kstep; const char* b2 = last ? nB : cB + (size_t)(t + 2) * kstep;
            const char* a3 = a2 + kstep; const char* b3 = b2 + kstep;
            if (last && has_next) S.a_ready(nxt);
            if constexpr (SP2) {
            PG8_LDB(B0, 0, 0); PG8_LDB(B1, 0, 1); PG8_SCHED; PG8_LDA(At, 0, 0); PG8_STAGE(PG8_SA(1, 1), a1 + hstep, voffA);
            PG8_WAIT_V(8); PG8_WAIT_L(0); PG8_BAR; PG8_MMA(0, 0, At, B0); PG8_MMA(0, 1, At, B1); PG8_BAR; PG8_SCHED;
            PG8_LDA(At, 0, 1); PG8_STAGE(PG8_SB(0, 0), b2, voffB); PG8_STAGE(PG8_SB(0, 1), b2 + hstep, voffB); PG8_STAGE(PG8_SA(0, 0), a2, voffA);
            PG8_WAIT_V(8); PG8_WAIT_L(0); PG8_BAR; PG8_MMA(1, 0, At, B0); PG8_MMA(1, 1, At, B1); PG8_BAR; PG8_SCHED;
            PG8_LDB(B0, 1, 0); PG8_LDB(B1, 1, 1); PG8_SCHED; PG8_LDA(At, 1, 0); PG8_STAGE(PG8_SA(0, 1), a2 + hstep, voffA);
            PG8_WAIT_V(8); PG8_WAIT_L(0); PG8_BAR; PG8_MMA(0, 0, At, B0); PG8_MMA(0, 1, At, B1); PG8_BAR; PG8_SCHED;
            PG8_LDA(At, 1, 1); PG8_STAGE(PG8_SB(1, 0), b3, voffB); PG8_STAGE(PG8_SB(1, 1), b3 + hstep, voffB); PG8_STAGE(PG8_SA(1, 0), a3, voffA);
            PG8_WAIT_V(8); PG8_WAIT_L(0); PG8_BAR; PG8_MMA(1, 0, At, B0); PG8_MMA(1, 1, At, B1); PG8_BAR; PG8_SCHED;
            } else {
            PG8_LDB(B0, 0, 0); PG8_SCHED; PG8_LDA(At, 0, 0); PG8_STAGE(PG8_SA(1, 1), a1 + hstep, voffA);
            PG8_WAIT_L(8); PG8_BAR; PG8_WAIT_L(0); PG8_MMA(0, 0, At, B0); PG8_BAR; PG8_SCHED;
            PG8_LDB(B1, 0, 1); PG8_STAGE(PG8_SB(0, 0), b2, voffB);
            PG8_BAR; PG8_WAIT_L(0); PG8_MMA(0, 1, At, B1); PG8_BAR;
            PG8_LDA(At, 0, 1); PG8_STAGE(PG8_SA(0, 0), a2, voffA);
            PG8_BAR; PG8_WAIT_L(0); PG8_MMA(1, 0, At, B0); PG8_BAR; PG8_SCHED;
            PG8_STAGE(PG8_SB(0, 1), b2 + hstep, voffB);
            PG8_WAIT_V(6); PG8_BAR; PG8_MMA(1, 1, At, B1); PG8_BAR;
            PG8_LDB(B0, 1, 0); PG8_SCHED; PG8_LDA(At, 1, 0); PG8_STAGE(PG8_SA(0, 1), a2 + hstep, voffA);
            PG8_WAIT_L(8); PG8_BAR; PG8_WAIT_L(0); PG8_MMA(0, 0, At, B0); PG8_BAR; PG8_SCHED;
            PG8_LDB(B1, 1, 1); PG8_STAGE(PG8_SB(1, 0), b3, voffB);
            PG8_BAR; PG8_WAIT_L(0); PG8_MMA(0, 1, At, B1); PG8_BAR;
            PG8_LDA(At, 1, 1); PG8_STAGE(PG8_SA(1, 0), a3, voffA);
            PG8_BAR; PG8_WAIT_L(0); PG8_MMA(1, 0, At, B0); PG8_BAR; PG8_SCHED;
            PG8_STAGE(PG8_SB(1, 1), b3 + hstep, voffB);
            PG8_WAIT_V(6); PG8_BAR; PG8_MMA(1, 1, At, B1); PG8_BAR;
            }
        }
        asm volatile("s_nop 15\n\ts_nop 15" ::: "memory");
        if constexpr (ALIGN_EPI) { if (wr == 0) PG8_BAR; }
        if constexpr (!Epi::AFTER_DRAIN) { const int t2_ = otid(); int fr_ = t2_ & 15, fq_ = (t2_ >> 4) & 3, wr_ = wr, wc_ = wc; asm volatile("" : "+s"(wr_), "+s"(wc_)); E(acc, cur, wr_, wc_, fr_, fq_); S.done(cur); }
        if (!has_next) break;
#pragma unroll
        for (int a = 0; a < 2; ++a)
#pragma unroll
            for (int b = 0; b < 2; ++b)
#pragma unroll
                for (int m = 0; m < 4; ++m)
#pragma unroll
                    for (int n = 0; n < 2; ++n) acc[a][b][m][n] = (f32x4){0.f, 0.f, 0.f, 0.f};
        cur = nxt; cA = nA; cB = nB; ++ui;
        if constexpr (ALIGN_EPI) { if (wr == 1) PG8_BAR; }
    }
    PG8_WAIT_V(0);
    if constexpr (!ALIGN_EPI) { if (wr == 0) PG8_BAR; }
    PG8_BAR;
    if constexpr (Epi::AFTER_DRAIN) { E.fused(acc, cur, wr, wc, fr, fq, lds, wid, lane); S.done(cur); }
#undef PG8_SA
#undef PG8_SB
#undef PG8_STAGE
#undef voffA
#undef voffB
#undef PG8_LDA
#undef PG8_LDB
#undef PG8_MMA
#undef PG8_WAIT_V
#undef PG8_WAIT_L
#undef PG8_BAR
#undef PG8_SCHED
}
}
using pg8::Unit;
struct EpiIn {
    static constexpr bool PERM = true, AFTER_DRAIN = false;
    bf16_t *Q, *Kb, *Vb, *XR, *XGb; float *outK, *outV; const float* rope;
    __device__ __forceinline__ void operator()(const f32x4 (&acc)[2][2][4][2], const Unit& u, int wr, int wc, int fr, int fq) const {
        const int pn = u.pn; const bool sample = u.pm >= 32;
        bf16_t* dbase; int dstride;
        if (pn <= 1) { dbase = Q + pn * 256; dstride = 512; }
        else if (pn == 2) { dbase = Kb; dstride = 256; }
        else if (pn == 3) { dbase = Vb; dstride = 256; }
        else if (pn <= 5) { dbase = XR + (pn - 4) * 256; dstride = 512; }
        else { dbase = XGb + (pn - 6) * 256; dstride = 512; }
        const bool dorope = sample && pn <= 2;
        float* fout = (!sample && (pn == 2 || pn == 3)) ? (pn == 2 ? outK : outV) : nullptr;
        const int rbase = u.pm * 256 + wr * 64 + fr;
        const float* tcol = rope + ((wc & 1) * 16 + fq * 4) * 2;
#define EPIIN_LD(it_, d0_, d1_) do { const int row_ = rbase + ((it_) >> 2) * 128 + ((it_) & 3) * 16, pos_ = (row_ - NPR) & 2047; \
            const int trow_ = dorope ? ((wc < 2) ? (pos_ >> 6) : (32 + (pos_ & 63))) : 96; const float* tp_ = tcol + (size_t)trow_ * 64; d0_ = *(const f32x4*)tp_; d1_ = *(const f32x4*)(tp_ + 4); } while (0)
        f32x4 cs[2][2];
        EPIIN_LD(0, cs[0][0], cs[0][1]);
#pragma unroll
        for (int it = 0; it < 8; ++it) {
            const int ai = it >> 2, m = it & 3, row = rbase + ai * 128 + m * 16;
            if (it < 7) EPIIN_LD(it + 1, cs[(it + 1) & 1][0], cs[(it + 1) & 1][1]);
            __builtin_amdgcn_sched_barrier(0);
            const f32x4 cs0 = cs[it & 1][0], cs1 = cs[it & 1][1];
#pragma unroll
            for (int bj = 0; bj < 2; ++bj) {
                const f32x4 v0 = acc[ai][bj][m][0], v1 = acc[ai][bj][m][1];
                const int ct = bj * 128 + wc * 32 + fq * 8;
                f32x4 r0, r1;
                r0.x = v0.x * cs0.x - v0.y * cs0.y; r0.y = v0.x * cs0.y + v0.y * cs0.x;
                r0.z = v0.z * cs0.z - v0.w * cs0.w; r0.w = v0.z * cs0.w + v0.w * cs0.z;
                r1.x = v1.x * cs1.x - v1.y * cs1.y; r1.y = v1.x * cs1.y + v1.y * cs1.x;
                r1.z = v1.z * cs1.z - v1.w * cs1.w; r1.w = v1.z * cs1.w + v1.w * cs1.z;
                u32x4 o; o.x = cvt_pk_bf16(r0.x, r0.y); o.y = cvt_pk_bf16(r0.z, r0.w); o.z = cvt_pk_bf16(r1.x, r1.y); o.w = cvt_pk_bf16(r1.z, r1.w);
                *(u32x4*)(dbase + (size_t)row * dstride + ct) = o;
                if (fout) { float* op = fout + (size_t)row * 256 + ct; *(f32x4*)op = r0; *(f32x4*)(op + 4) = r1; }
            }
        }
#undef EPIIN_LD
    }
};
template <bool XB16> struct EpiOut {
    static constexpr bool PERM = false, AFTER_DRAIN = false;
    const float *xin_p, *xin_s; bf16_t* XA; const float* modl;
    __device__ __forceinline__ void operator()(const f32x4 (&acc)[2][2][4][2], const Unit& u, int wr, int wc, int fr, int fq) const {
        const int rbase = u.pm * 256 + wr * 64 + fr, cbase = u.pn * 256 + wc * 32 + fq * 4;
        const float* gp = modl + (size_t)cond_of(u.pm * 256) * 6144 + 2 * 1024 + cbase;
        const float* xb = (u.pm < 32 ? xin_p + (size_t)rbase * DM : xin_s + (size_t)(rbase - NPR) * DM) + cbase;
        const bf16_t* xh = XA + (size_t)rbase * DM + cbase;
        f32x4 gv[2][2];
#pragma unroll
        for (int bj = 0; bj < 2; ++bj)
#pragma unroll
            for (int n = 0; n < 2; ++n) gv[bj][n] = *(const f32x4*)(gp + bj * 128 + n * 16);
#define EPIOUT_LD(it_, d_) do { const size_t ro_ = (size_t)(((it_) >> 2) * 128 + ((it_) & 3) * 16) * DM; \
            if constexpr (XB16) { const bf16_t* xr_ = xh + ro_; const u32x2 w0_ = *(const u32x2*)(xr_), w1_ = *(const u32x2*)(xr_ + 16), w2_ = *(const u32x2*)(xr_ + 128), w3_ = *(const u32x2*)(xr_ + 144); \
                d_[0] = (f32x4){bflo(w0_.x), bfhi(w0_.x), bflo(w0_.y), bfhi(w0_.y)}; d_[1] = (f32x4){bflo(w1_.x), bfhi(w1_.x), bflo(w1_.y), bfhi(w1_.y)}; \
                d_[2] = (f32x4){bflo(w2_.x), bfhi(w2_.x), bflo(w2_.y), bfhi(w2_.y)}; d_[3] = (f32x4){bflo(w3_.x), bfhi(w3_.x), bflo(w3_.y), bfhi(w3_.y)}; } \
            else { const float* xr_ = xb + ro_; d_[0] = __builtin_nontemporal_load((const f32x4*)(xr_)); d_[1] = __builtin_nontemporal_load((const f32x4*)(xr_ + 16)); d_[2] = __builtin_nontemporal_load((const f32x4*)(xr_ + 128)); d_[3] = __builtin_nontemporal_load((const f32x4*)(xr_ + 144)); } } while (0)
        f32x4 xv[2][4];
        EPIOUT_LD(0, xv[0]);
#pragma unroll
        for (int it = 0; it < 8; ++it) {
            const int ai = it >> 2, m = it & 3, row = rbase + ai * 128 + m * 16;
            if (it < 7) EPIOUT_LD(it + 1, xv[(it + 1) & 1]);
            __builtin_amdgcn_sched_barrier(0);
#pragma unroll
            for (int bj = 0; bj < 2; ++bj)
#pragma unroll
                for (int n = 0; n < 2; ++n) {
                    const f32x4 y = xv[it & 1][bj * 2 + n] * ALPHA_C + gv[bj][n] * acc[ai][bj][m][n];
                    u32x2 o; o.x = cvt_pk_bf16(y.x, y.y); o.y = cvt_pk_bf16(y.z, y.w);
                    *(u32x2*)(XA + (size_t)row * DM + cbase + bj * 128 + n * 16) = o;
                }
        }
#undef EPIOUT_LD
    }
};
__device__ __forceinline__ unsigned pk4_fp8(float a, float b, float c, float d) { unsigned w = 0u; asm volatile("v_cvt_pk_fp8_f32 %0, %1, %2" : "+v"(w) : "v"(a), "v"(b)); asm volatile("v_cvt_pk_fp8_f32 %0, %1, %2 op_sel:[0,0,1]" : "+v"(w) : "v"(c), "v"(d)); return w; }
constexpr float W13_SCALE = 32.f, W2_SCALE = 64.f;
struct EpiUp {
    static constexpr bool PERM = true, AFTER_DRAIN = false;
    unsigned char* Hid;
    __device__ __forceinline__ void operator()(const f32x4 (&acc)[2][2][4][2], const Unit& u, int wr, int wc, int fr, int fq) const {
        const int pnl = u.pn & 15; constexpr float ds = 1.f / W13_SCALE;
#pragma unroll
        for (int ai = 0; ai < 2; ++ai)
#pragma unroll
            for (int m = 0; m < 4; ++m) {
                const int row = u.pm * 256 + ai * 128 + wr * 64 + m * 16 + fr;
                __builtin_amdgcn_sched_barrier(0);
                const f32x4 a0 = acc[ai][0][m][0] * ds, a1 = acc[ai][0][m][1] * ds, b0 = acc[ai][1][m][0] * ds, b1 = acc[ai][1][m][1] * ds;
                u32x2 o;
                o.x = pk4_fp8(siluf_(a0.x) * b0.x, siluf_(a0.y) * b0.y, siluf_(a0.z) * b0.z, siluf_(a0.w) * b0.w);
                o.y = pk4_fp8(siluf_(a1.x) * b1.x, siluf_(a1.y) * b1.y, siluf_(a1.z) * b1.z, siluf_(a1.w) * b1.w);
                *(u32x2*)(Hid + (size_t)row * 2048 + pnl * 128 + wc * 32 + fq * 8) = o;
            }
    }
};
struct EpiDn {
    static constexpr bool PERM = true, AFTER_DRAIN = false;
    bf16_t* Y; const float* gate;
    __device__ __forceinline__ void operator()(const f32x4 (&acc)[2][2][4][2], const Unit& u, int wr, int wc, int fr, int fq) const {
        const int pnl = u.pn & 3, rbase = u.pm * 256 + wr * 64 + fr;
        float gg[8];
#pragma unroll
        for (int it = 0; it < 8; ++it) gg[it] = gate[rbase + (it >> 2) * 128 + (it & 3) * 16] * (1.f / W2_SCALE);
#pragma unroll
        for (int it = 0; it < 8; ++it) {
            const int ai = it >> 2, m = it & 3, row = rbase + ai * 128 + m * 16;
            __builtin_amdgcn_sched_barrier(0);
            const float g = gg[it];
#pragma unroll
            for (int bj = 0; bj < 2; ++bj) {
                const f32x4 v0 = acc[ai][bj][m][0] * g, v1 = acc[ai][bj][m][1] * g;
                u32x4 o; o.x = cvt_pk_bf16(v0.x, v0.y); o.y = cvt_pk_bf16(v0.z, v0.w); o.z = cvt_pk_bf16(v1.x, v1.y); o.w = cvt_pk_bf16(v1.z, v1.w);
                *(u32x4*)(Y + (size_t)row * DM + pnl * 256 + bj * 128 + wc * 32 + fq * 8) = o;
            }
        }
    }
};
struct EpiSgu {
    static constexpr bool PERM = true, AFTER_DRAIN = false;
    bf16_t *U, *V2; float* vstat; const float* bias;
    __device__ __forceinline__ void operator()(const f32x4 (&acc)[2][2][4][2], const Unit& u, int wr, int wc, int fr, int fq) const {
        const int pn = u.pn; const bool isv = pn >= 4;
        bf16_t* dbase = (isv ? V2 : U) + (pn & 3) * 256;
        f32x4 bvv[2][2];
#pragma unroll
        for (int bj = 0; bj < 2; ++bj) { const float* bp = bias + pn * 256 + bj * 128 + wc * 32 + fq * 8; bvv[bj][0] = *(const f32x4*)bp; bvv[bj][1] = *(const f32x4*)(bp + 4); }
#pragma unroll
        for (int ai = 0; ai < 2; ++ai)
#pragma unroll
            for (int m = 0; m < 4; ++m) {
                const int row = u.pm * 256 + ai * 128 + wr * 64 + m * 16 + fr;
                __builtin_amdgcn_sched_barrier(0);
                float s1 = 0.f, s2 = 0.f;
#pragma unroll
                for (int bj = 0; bj < 2; ++bj) {
                    const int ct = bj * 128 + wc * 32 + fq * 8, c = pn * 256 + ct;
                    f32x4 v0 = acc[ai][bj][m][0] + bvv[bj][0], v1 = acc[ai][bj][m][1] + bvv[bj][1];
                    v0.x = geluf_(v0.x); v0.y = geluf_(v0.y); v0.z = geluf_(v0.z); v0.w = geluf_(v0.w);
                    v1.x = geluf_(v1.x); v1.y = geluf_(v1.y); v1.z = geluf_(v1.z); v1.w = geluf_(v1.w);
                    u32x4 o; o.x = cvt_pk_bf16(v0.x, v0.y); o.y = cvt_pk_bf16(v0.z, v0.w); o.z = cvt_pk_bf16(v1.x, v1.y); o.w = cvt_pk_bf16(v1.z, v1.w);
                    *(u32x4*)(dbase + (size_t)row * DM + ct) = o;
                    s1 += (v0.x + v0.y) + (v0.z + v0.w) + (v1.x + v1.y) + (v1.z + v1.w);
                    s2 += (v0.x * v0.x + v0.y * v0.y) + (v0.z * v0.z + v0.w * v0.w) + (v1.x * v1.x + v1.y * v1.y) + (v1.z * v1.z + v1.w * v1.w);
                }
                { const int ln = fq * 16 + fr, i16 = (ln ^ 16) << 2, i32 = (ln ^ 32) << 2;
                  s1 += __builtin_bit_cast(float, __builtin_amdgcn_ds_bpermute(i16, __builtin_bit_cast(int, s1))); s2 += __builtin_bit_cast(float, __builtin_amdgcn_ds_bpermute(i16, __builtin_bit_cast(int, s2)));
                  s1 += __builtin_bit_cast(float, __builtin_amdgcn_ds_bpermute(i32, __builtin_bit_cast(int, s1))); s2 += __builtin_bit_cast(float, __builtin_amdgcn_ds_bpermute(i32, __builtin_bit_cast(int, s2))); }
                if (isv && fq == 0) { f32x2 st; st.x = s1; st.y = s2; *(f32x2*)(vstat + ((size_t)row * 16 + (pn - 4) * 4 + wc) * 2) = st; }
            }
    }
};
__device__ __forceinline__ void tr_item(const float* __restrict__ src, int N, bf16_t* dst, int Kd, int k0, int n0, int drow0, LAS float* scr, int lane) {
    f32x4 v[16];
    const float* s = src + (size_t)(k0 + (lane >> 4)) * N + n0 + (lane & 15) * 4;
#pragma unroll
    for (int i = 0; i < 16; ++i) v[i] = *(const f32x4*)(s + (size_t)i * 4 * N);
#pragma unroll
    for (int i = 0; i < 16; ++i) { LAS float* d = scr + (i * 4 + (lane >> 4)) * 65 + (lane & 15) * 4; d[0] = v[i].x; d[1] = v[i].y; d[2] = v[i].z; d[3] = v[i].w; }
    LDS_WAIT(); __builtin_amdgcn_wave_barrier();
    const int c = lane & 7;
#pragma unroll
    for (int j = 0; j < 8; ++j) {
        const int n = (lane >> 3) + 8 * j; const LAS float* r = scr + (8 * c) * 65 + n;
        u32x4 o; o.x = cvt_pk_bf16(r[0], r[65]); o.y = cvt_pk_bf16(r[2 * 65], r[3 * 65]); o.z = cvt_pk_bf16(r[4 * 65], r[5 * 65]); o.w = cvt_pk_bf16(r[6 * 65], r[7 * 65]);
        *(u32x4*)(dst + (size_t)(drow0 + n) * Kd + k0 + 8 * c) = o;
    }
    LDS_WAIT(); __builtin_amdgcn_wave_barrier();
}
__device__ __forceinline__ void tr_item8(const float* __restrict__ src, int N, unsigned char* dst, int Kd, int k0, int n0, int drow0, float sc, LAS float* scr, int lane) {
    f32x4 v[16];
    const float* s = src + (size_t)(k0 + (lane >> 4)) * N + n0 + (lane & 15) * 4;
#pragma unroll
    for (int i = 0; i < 16; ++i) v[i] = *(const f32x4*)(s + (size_t)i * 4 * N);
#pragma unroll
    for (int i = 0; i < 16; ++i) { LAS float* d = scr + (i * 4 + (lane >> 4)) * 65 + (lane & 15) * 4; d[0] = v[i].x * sc; d[1] = v[i].y * sc; d[2] = v[i].z * sc; d[3] = v[i].w * sc; }
    LDS_WAIT(); __builtin_amdgcn_wave_barrier();
    const int c = lane & 3;
#pragma unroll
    for (int j = 0; j < 4; ++j) {
        const int n = (lane >> 2) + 16 * j; const LAS float* r = scr + (16 * c) * 65 + n;
        u32x4 o; o.x = pk4_fp8(r[0], r[65], r[2 * 65], r[3 * 65]); o.y = pk4_fp8(r[4 * 65], r[5 * 65], r[6 * 65], r[7 * 65]);
        o.z = pk4_fp8(r[8 * 65], r[9 * 65], r[10 * 65], r[11 * 65]); o.w = pk4_fp8(r[12 * 65], r[13 * 65], r[14 * 65], r[15 * 65]);
        *(u32x4*)(dst + (size_t)(drow0 + n) * Kd + k0 + 16 * c) = o;
    }
    LDS_WAIT(); __builtin_amdgcn_wave_barrier();
}
__device__ __forceinline__ void cvt_item512(const float* __restrict__ src, bf16_t* dst, int item, int lane) {
    const size_t i = (size_t)item * 512 + lane * 8;
    const f32x4 a = *(const f32x4*)(src + i), b = *(const f32x4*)(src + i + 4);
    u32x4 o; o.x = cvt_pk_bf16(a.x, a.y); o.y = cvt_pk_bf16(a.z, a.w); o.z = cvt_pk_bf16(b.x, b.y); o.w = cvt_pk_bf16(b.z, b.w);
    *(u32x4*)(dst + i) = o;
}
struct MoeItem { const float* s; size_t rowstep; unsigned char* dst; int Kd; float sc; };
__device__ __forceinline__ MoeItem moe_item(const Params& p, int r, int lane) {
    MoeItem m; unsigned char* ws = p.ws;
    if (r < 32768) {
        const int w3 = r >= 16384; const int q = w3 ? r - 16384 : r;
        const int mat = q >> 9, rr = q & 511, n0 = (rr & 31) * 64, k0 = (rr >> 5) * 64;
        m.s = p.in[w3 ? I_W3 : I_W1] + (size_t)mat * 1024 * 2048 + (size_t)(k0 + (lane >> 4)) * 2048 + n0 + (lane & 15) * 4; m.rowstep = (size_t)4 * 2048;
        m.dst = ws + WS_BTUP + (size_t)mat * 4096 * 1024 + (size_t)((n0 >> 7) * 256 + (n0 & 127) + w3 * 128) * 1024 + k0; m.Kd = 1024; m.sc = W13_SCALE;
    } else {
        const int q = r - 32768, mat = q >> 9, rr = q & 511, n0 = (rr & 15) * 64, k0 = (rr >> 4) * 64;
        m.s = p.in[I_W2] + (size_t)mat * 2048 * 1024 + (size_t)(k0 + (lane >> 4)) * 1024 + n0 + (lane & 15) * 4; m.rowstep = (size_t)4 * 1024;
        m.dst = ws + WS_BTDN + (size_t)mat * 1024 * 2048 + (size_t)n0 * 2048 + k0; m.Kd = 2048; m.sc = W2_SCALE;
    }
    return m;
}
__device__ __forceinline__ void phase_p0(const Params& p, LAS unsigned char* lds) {
    const int tid = otid(), lane = tid & 63, wave = tid >> 6;
    LAS float* scr = (LAS float*)(lds + wave * 16640);
    unsigned char* ws = p.ws;
    const int gw = blockIdx.x * 8 + wave, NGW = gridDim.x * 8;
    constexpr int N_MOD = 1536, N_ABIN = 512, N_ABOUT = 256, N_SGIN = 512, N_SGOUT = 256, N_GW = 32, N_CVT = 512, N_CK = 512, N_SPW = 256, N_ROPE = 49, N_SP = 16;
    constexpr int TOTAL = N_MOD + N_ABIN + N_ABOUT + N_SGIN + N_SGOUT + N_GW + N_CVT + N_CK + N_SPW + N_ROPE + N_SP;
    for (int it = gw; it < TOTAL; it += NGW) {
        int r = it;
        if (r < N_MOD) {
            const int l = r / 768, rem = r % 768, cgp = rem >> 3, kp = rem & 7, n = cgp * 64 + lane;
            const float* w = p.in[I_MODW] + ((size_t)l * 1024 + 128 * kp) * 6144 + n;
            const float* cc = p.in[I_C]; const float* cx = p.in[I_CCTX];
            const int ka = 128 * kp + lane;
            const float s0a = siluf_(cx[ka]), s0b = siluf_(cx[ka + 64]), s1a = siluf_(cc[ka]), s1b = siluf_(cc[ka + 64]), s2a = siluf_(cc[1024 + ka]), s2b = siluf_(cc[1024 + ka + 64]);
            const float s3a = siluf_(cc[2048 + ka]), s3b = siluf_(cc[2048 + ka + 64]), s4a = siluf_(cc[3072 + ka]), s4b = siluf_(cc[3072 + ka + 64]);
            float a0 = 0.f, a1 = 0.f, a2 = 0.f, a3 = 0.f, a4 = 0.f;
#pragma unroll 8
            for (int k = 0; k < 64; ++k) {
                const float wa = w[(size_t)k * 6144], wb = w[(size_t)(k + 64) * 6144];
                a0 += __builtin_bit_cast(float, __builtin_amdgcn_readlane(__builtin_bit_cast(int, s0a), k)) * wa + __builtin_bit_cast(float, __builtin_amdgcn_readlane(__builtin_bit_cast(int, s0b), k)) * wb;
                a1 += __builtin_bit_cast(float, __builtin_amdgcn_readlane(__builtin_bit_cast(int, s1a), k)) * wa + __builtin_bit_cast(float, __builtin_amdgcn_readlane(__builtin_bit_cast(int, s1b), k)) * wb;
                a2 += __builtin_bit_cast(float, __builtin_amdgcn_readlane(__builtin_bit_cast(int, s2a), k)) * wa + __builtin_bit_cast(float, __builtin_amdgcn_readlane(__builtin_bit_cast(int, s2b), k)) * wb;
                a3 += __builtin_bit_cast(float, __builtin_amdgcn_readlane(__builtin_bit_cast(int, s3a), k)) * wa + __builtin_bit_cast(float, __builtin_amdgcn_readlane(__builtin_bit_cast(int, s3b), k)) * wb;
                a4 += __builtin_bit_cast(float, __builtin_amdgcn_readlane(__builtin_bit_cast(int, s4a), k)) * wa + __builtin_bit_cast(float, __builtin_amdgcn_readlane(__builtin_bit_cast(int, s4b), k)) * wb;
            }
            float* mp = (float*)(ws + WS_MODP) + (size_t)(kp * 2 + l) * 30720 + n;
            mp[0] = a0; mp[6144] = a1; mp[2 * 6144] = a2; mp[3 * 6144] = a3; mp[4 * 6144] = a4;
            continue;
        }
        r -= N_MOD;
        if (r < N_ABIN) { tr_item(p.in[I_ABIN], 2048, (bf16_t*)(ws + WS_ABIN), 1024, (r >> 5) * 64, (r & 31) * 64, (r & 31) * 64, scr, lane); continue; } r -= N_ABIN;
        if (r < N_ABOUT) { tr_item(p.in[I_ABOUT], 1024, (bf16_t*)(ws + WS_ABOUT), 1024, (r >> 4) * 64, (r & 15) * 64, (r & 15) * 64, scr, lane); continue; } r -= N_ABOUT;
        if (r < N_SGIN) { tr_item(p.in[I_SGIN], 2048, (bf16_t*)(ws + WS_SGIN), 1024, (r >> 5) * 64, (r & 31) * 64, (r & 31) * 64, scr, lane); continue; } r -= N_SGIN;
        if (r < N_SGOUT) { tr_item(p.in[I_SGOUT], 1024, (bf16_t*)(ws + WS_SGOUT), 1024, (r >> 4) * 64, (r & 15) * 64, (r & 15) * 64, scr, lane); continue; } r -= N_SGOUT;
        if (r < N_GW) {
            const int gate = r >> 4, rest = r & 15, dir = rest >> 3, blk = rest & 7;
            tr_item(p.in[gate ? I_WX : I_WA] + (size_t)(dir * 8 + blk) * 4096, 64, (bf16_t*)(ws + WS_GW) + (size_t)((dir * 2 + gate) * 8 + blk) * 4096, 64, 0, 0, 0, scr, lane);
            continue;
        }
        r -= N_GW;
        if (r < N_CVT) { cvt_item512(p.in[I_CV], (bf16_t*)(ws + WS_CV), r, lane); continue; } r -= N_CVT;
        if (r < N_CK) { cvt_item512(p.in[I_CK], (bf16_t*)(ws + WS_CK), r, lane); continue; } r -= N_CK;
        if (r < N_SPW) { cvt_item512(p.in[I_SPW], (bf16_t*)(ws + WS_SPW), r, lane); continue; } r -= N_SPW;
        if (r >= N_ROPE) { const int i = (r - N_ROPE) * 64 + lane; ((float*)(ws + WS_SP))[i] = log1pf(__expf(-p.in[I_LAM][i])); continue; }
        {
            const int idx = r * 64 + lane, pos = idx >> 5, f = idx & 31, pp = pos < 32 ? pos : pos - 32;
            double fr_ = 1.0; for (int i = 0; i < f; ++i) fr_ *= 0.74989420933245582;
            double ang = (double)pp * fr_;
            const double k = __builtin_rint(ang * 0.15915494309189535);
            double x = ang - k * 6.283185307179586; const double x2 = x * x;
            double sn = x, cs = 1.0, ts = x, tc = 1.0;
#pragma unroll
            for (int i = 1; i <= 14; ++i) { tc *= -x2 / (double)((2 * i - 1) * (2 * i)); cs += tc; ts *= -x2 / (double)((2 * i) * (2 * i + 1)); sn += ts; }
            f32x2 o; o.x = (float)cs; o.y = (float)sn;
            if (pos >= 96) { o.x = 1.f; o.y = 0.f; }
            if (idx < 97 * 32) *(f32x2*)((float*)(ws + WS_ROPE) + (size_t)idx * 2) = o;
        }
    }
    constexpr int NMOE = 49152;
    f32x4 va[16], vb[16];
    MoeItem ca, cb;
#define MOE_LOAD(V, C, IT) do { C = moe_item(p, (IT), lane); _Pragma("unroll") for (int i = 0; i < 16; ++i) V[i] = __builtin_nontemporal_load((const f32x4*)(C.s + (size_t)i * C.rowstep)); } while (0)
#define MOE_PROC(V, C, NXT) do { const float sc = C.sc; \
        _Pragma("unroll") for (int i = 0; i < 16; ++i) { LAS float* d = scr + (i * 4 + (lane >> 4)) * 65 + (lane & 15) * 4; d[0] = V[i].x * sc; d[1] = V[i].y * sc; d[2] = V[i].z * sc; d[3] = V[i].w * sc; } \
        unsigned char* cdst = C.dst; const int cKd = C.Kd; \
        if ((NXT) < NMOE) MOE_LOAD(V, C, (NXT)); \
        LDS_WAIT(); __builtin_amdgcn_wave_barrier(); \
        const int c = lane & 3; \
        _Pragma("unroll") for (int j = 0; j < 4; ++j) { const int n = (lane >> 2) + 16 * j; const LAS float* r = scr + (16 * c) * 65 + n; \
            u32x4 o; o.x = pk4_fp8(r[0], r[65], r[2 * 65], r[3 * 65]); o.y = pk4_fp8(r[4 * 65], r[5 * 65], r[6 * 65], r[7 * 65]); \
            o.z = pk4_fp8(r[8 * 65], r[9 * 65], r[10 * 65], r[11 * 65]); o.w = pk4_fp8(r[12 * 65], r[13 * 65], r[14 * 65], r[15 * 65]); \
            __builtin_nontemporal_store(o, (u32x4*)(cdst + (size_t)n * cKd + 16 * c)); } \
        LDS_WAIT(); __builtin_amdgcn_wave_barrier(); } while (0)
    if (gw < NMOE) MOE_LOAD(va, ca, gw);
    if (gw + NGW < NMOE) MOE_LOAD(vb, cb, gw + NGW);
    for (int it = gw; it < NMOE; it += 2 * NGW) {
        MOE_PROC(va, ca, it + 2 * NGW);
        if (it + NGW < NMOE) MOE_PROC(vb, cb, it + 3 * NGW);
    }
#undef MOE_LOAD
#undef MOE_PROC
}
__device__ __forceinline__ void phase_p0b(const Params& p) {
    const int tid = otid(); unsigned char* ws = p.ws;
    const float* modp = (const float*)(ws + WS_MODP);
    float* mod = (float*)(ws + WS_MOD);
    for (int i = blockIdx.x * 512 + tid; i < 61440; i += gridDim.x * 512) {
        const int l = i / 30720, rem = i % 30720;
        float s = p.in[I_MODB][l * 6144 + rem % 6144];
#pragma unroll
        for (int kp = 0; kp < 8; ++kp) s += modp[(size_t)(kp * 2 + l) * 30720 + rem];
        mod[i] = s;
    }
    bf16_t* H = (bf16_t*)(ws + WS_H);
    const int c4 = (tid & 255) * 4, rs = tid >> 8;
    for (int tile = blockIdx.x; tile < 256; tile += gridDim.x) {
        const int row0 = tile * 64, cond = cond_of(row0);
        f32x4 sh = *(const f32x4*)(p.in[I_MODB] + c4), sc = *(const f32x4*)(p.in[I_MODB] + 1024 + c4);
#pragma unroll
        for (int kp = 0; kp < 8; ++kp) {
            const float* b = modp + (size_t)(kp * 2) * 30720 + cond * 6144 + c4;
            sh += *(const f32x4*)b; sc += *(const f32x4*)(b + 1024);
        }
        sc += 1.f;
        const float* xt = (row0 < NPR ? p.in[I_XP] + (size_t)row0 * DM : p.in[I_XS] + (size_t)(row0 - NPR) * DM) + (size_t)rs * DM + c4;
        for (int it0 = 0; it0 < 32; it0 += 8) {
            f32x4 xv[8];
#pragma unroll
            for (int q = 0; q < 8; ++q) xv[q] = __builtin_nontemporal_load((const f32x4*)(xt + (size_t)(it0 + q) * 2 * DM));
#pragma unroll
            for (int q = 0; q < 8; ++q) {
                const f32x4 h = xv[q] * sc + sh;
                u32x2 o; o.x = cvt_pk_bf16(h.x, h.y); o.y = cvt_pk_bf16(h.z, h.w);
                *(u32x2*)(H + (size_t)(row0 + (it0 + q) * 2 + rs) * DM + c4) = o;
            }
        }
    }
}
__device__ __forceinline__ void attn_tile(const Params& p, LAS unsigned char* lds, int a) {
    const int tid = otid(), lane = tid & 63, wave = tid >> 6, fr = lane & 15, fq = lane >> 4;
    unsigned char* ws = p.ws;
    const bool lat = a >= 256;
    int b, kvh, qb, tokbase;
    if (!lat) { b = a >> 3; kvh = (a >> 2) & 1; qb = a & 3; tokbase = b * 256; }
    else { const int a2 = a - 256; b = a2 >> 6; kvh = (a2 >> 5) & 1; qb = a2 & 31; tokbase = NPR + b * 2048; }
    const int q0 = qb * 64, head = kvh * 2 + (wave >> 2);
    const int qloc = q0 + (wave & 3) * 16 + fr, qrow = tokbase + qloc;
    const bf16_t* Q = (const bf16_t*)(ws + WS_Q); const bf16_t* Kb = (const bf16_t*)(ws + WS_K); const bf16_t* Vb = (const bf16_t*)(ws + WS_V);
    const bf16_t* CK = (const bf16_t*)(ws + WS_CK); const bf16_t* CV = (const bf16_t*)(ws + WS_CV);
    bf16x8 qf[4];
#pragma unroll
    for (int ks = 0; ks < 4; ++ks) qf[ks] = *(const bf16x8*)(Q + (size_t)qrow * 512 + head * 128 + ks * 32 + fq * 8);
    float m = p.in[I_SINK][head] * 1.4426950408889634f, l = 1.f;
    f32x4 o[8];
#pragma unroll
    for (int i = 0; i < 8; ++i) o[i] = (f32x4){0.f, 0.f, 0.f, 0.f};
    int jlo = 0, jhi = 4, ntile = 4;
    if (lat) { jlo = q0 >= 128 ? 0 : (q0 == 64 ? 1 : 2); jhi = q0 <= 1856 ? 4 : (q0 == 1920 ? 3 : 2); ntile = 4 + (jhi - jlo + 1); }
    LAS unsigned char* sK = lds; LAS unsigned char* sV = lds + 17408;
    u32x4 rk[2], rv[2];
#define ATT_SRC(ti, kp_, kbase_, krs_, vbase_, vrs_) do { krs_ = 256; vrs_ = 256; \
        if (!lat) { kp_ = -100000; const size_t o_ = (size_t)(tokbase + 64 * (ti)) * 256 + kvh * 128; kbase_ = Kb + o_; vbase_ = Vb + o_; } \
        else if ((ti) < 4) { kp_ = -100000; const size_t o_ = (size_t)(b * 256 + 64 * (ti)) * 256 + kvh * 128; kbase_ = CK + o_; vbase_ = CV + o_; } \
        else { kp_ = q0 - 128 + 64 * (jlo + (ti) - 4); const size_t o_ = (size_t)(tokbase + kp_) * 256 + kvh * 128; kbase_ = Kb + o_; vbase_ = Vb + o_; } } while (0)
#define ATT_LOAD(ti) do { int kp_; const bf16_t* kb_; const bf16_t* vb_; int krs_, vrs_; ATT_SRC(ti, kp_, kb_, krs_, vb_, vrs_); (void)kp_; \
        _Pragma("unroll") for (int i = 0; i < 2; ++i) { const int idx = tid + 512 * i; \
            rk[i] = *(const u32x4*)(kb_ + (size_t)(idx >> 4) * krs_ + (idx & 15) * 8); \
            rv[i] = *(const u32x4*)(vb_ + (size_t)(idx & 63) * vrs_ + (idx >> 6) * 8); } } while (0)
    ATT_LOAD(0);
    for (int t = 0; t < ntile; ++t) {
        __syncthreads();
#pragma unroll
        for (int i = 0; i < 2; ++i) { const int idx = tid + 512 * i;
            *(LAS u32x4*)(sK + (idx >> 4) * 272 + (idx & 15) * 16) = rk[i];
            { LAS unsigned char* vd = sV + ((idx >> 6) * 8) * 144 + (idx & 63) * 2; const u32x4 w = rv[i];
              *(LAS bf16_t*)(vd) = (bf16_t)w.x; *(LAS bf16_t*)(vd + 144) = (bf16_t)(w.x >> 16); *(LAS bf16_t*)(vd + 2 * 144) = (bf16_t)w.y; *(LAS bf16_t*)(vd + 3 * 144) = (bf16_t)(w.y >> 16);
              *(LAS bf16_t*)(vd + 4 * 144) = (bf16_t)w.z; *(LAS bf16_t*)(vd + 5 * 144) = (bf16_t)(w.z >> 16); *(LAS bf16_t*)(vd + 6 * 144) = (bf16_t)w.w; *(LAS bf16_t*)(vd + 7 * 144) = (bf16_t)(w.w >> 16); } }
        __syncthreads();
        int kp0; { const bf16_t* kb_; const bf16_t* vb_; int krs_, vrs_; ATT_SRC(t, kp0, kb_, krs_, vb_, vrs_); (void)kb_; (void)vb_; (void)krs_; (void)vrs_; }
        if (t + 1 < ntile) ATT_LOAD(t + 1);
        f32x4 s[4];
#pragma unroll
        for (int nt = 0; nt < 4; ++nt) s[nt] = (f32x4){0.f, 0.f, 0.f, 0.f};
#pragma unroll
        for (int ks = 0; ks < 4; ++ks)
#pragma unroll
            for (int nt = 0; nt < 4; ++nt) {
                const bf16x8 kf = *(const LAS bf16x8*)(sK + (16 * nt + fr) * 272 + (32 * ks + 8 * fq) * 2);
                s[nt] = __builtin_amdgcn_mfma_f32_16x16x32_bf16(kf, qf[ks], s[nt], 0, 0, 0);
            }
        float mloc = -3.0e38f;
#pragma unroll
        for (int nt = 0; nt < 4; ++nt)
#pragma unroll
            for (int j = 0; j < 4; ++j) {
                float v = s[nt][j] * (ATTN_SCALE_C * 1.4426950408889634f);
                if (kp0 > -50000) { const int df = qloc - (kp0 + 16 * nt + 4 * fq + j); if (df > 128 || df < -128) v = -1e30f; }
                s[nt][j] = v; mloc = fmaxf(mloc, v);
            }
        mloc = fmaxf(mloc, __shfl_xor(mloc, 16)); mloc = fmaxf(mloc, __shfl_xor(mloc, 32));
        const float mn = fmaxf(m, mloc), alpha = __builtin_amdgcn_exp2f(m - mn);
        float ls = 0.f;
#pragma unroll
        for (int nt = 0; nt < 4; ++nt)
#pragma unroll
            for (int j = 0; j < 4; ++j) { const float e = __builtin_amdgcn_exp2f(s[nt][j] - mn); s[nt][j] = e; ls += e; }
        ls += __shfl_xor(ls, 16); ls += __shfl_xor(ls, 32);
        l = l * alpha + ls; m = mn;
#pragma unroll
        for (int i = 0; i < 8; ++i) o[i] *= alpha;
#pragma unroll
        for (int kk = 0; kk < 2; ++kk) {
            u32x4 pw; pw.x = cvt_pk_bf16(s[2 * kk][0], s[2 * kk][1]); pw.y = cvt_pk_bf16(s[2 * kk][2], s[2 * kk][3]);
            pw.z = cvt_pk_bf16(s[2 * kk + 1][0], s[2 * kk + 1][1]); pw.w = cvt_pk_bf16(s[2 * kk + 1][2], s[2 * kk + 1][3]);
            const bf16x8 pf = __builtin_bit_cast(bf16x8, pw);
#pragma unroll
            for (int dt = 0; dt < 8; ++dt) {
                const LAS unsigned char* vp = sV + (16 * dt + fr) * 144 + (32 * kk + 4 * fq) * 2;
                const u32x2 lo = *(const LAS u32x2*)vp, hi = *(const LAS u32x2*)(vp + 32);
                u32x4 vw; vw.x = lo.x; vw.y = lo.y; vw.z = hi.x; vw.w = hi.y;
                o[dt] = __builtin_amdgcn_mfma_f32_16x16x32_bf16(__builtin_bit_cast(bf16x8, vw), pf, o[dt], 0, 0, 0);
            }
        }
    }
    const float inv = 1.f / l;
    bf16_t* MIX = (bf16_t*)(ws + WS_MIX);
#pragma unroll
    for (int dt = 0; dt < 8; ++dt) {
        u32x2 ov; ov.x = cvt_pk_bf16(o[dt][0] * inv, o[dt][1] * inv); ov.y = cvt_pk_bf16(o[dt][2] * inv, o[dt][3] * inv);
        *(u32x2*)(MIX + (size_t)qrow * DM + head * 128 + 16 * dt + 4 * fq) = ov;
    }
    __syncthreads();
#undef ATT_SRC
#undef ATT_LOAD
}
__device__ __forceinline__ void r1_loads(const Params& p, int r, int tid, unsigned (&xr)[6]) {
    const int c64 = r >> 3, nb = r & 7, tok0 = c64 * 64;
    int s0, len; if (tok0 < NPR) { s0 = tok0 & ~255; len = 256; } else { s0 = NPR + ((tok0 - NPR) & ~2047); len = 2048; }
    const bf16_t* XR = (const bf16_t*)(p.ws + WS_XR);
    const int c = tid & 63, tg = tid >> 6, ch = nb * 64 + c;
    unsigned t[12];
#pragma unroll
    for (int i = 0; i < 11; ++i) { const int tk = tok0 + 8 * tg - 2 + i; t[i] = (tk >= s0 && tk < s0 + len) ? (unsigned)XR[(size_t)tk * 512 + ch] : 0u; }
    t[11] = 0u;
#pragma unroll
    for (int i = 0; i < 6; ++i) xr[i] = t[2 * i] | (t[2 * i + 1] << 16);
}
__device__ __forceinline__ void r1_tile(const Params& p, LAS unsigned char* lds, int r, unsigned (&xraw)[6], int rnext) {
    const int tid = otid(), lane = tid & 63, wave = tid >> 6, fr = lane & 15, fq = lane >> 4;
    unsigned char* ws = p.ws;
    const int c64 = r >> 3, nb = r & 7, tok0 = c64 * 64;
    int s0, len; if (tok0 < NPR) { s0 = tok0 & ~255; len = 256; } else { s0 = NPR + ((tok0 - NPR) & ~2047); len = 2048; }
    LAS float* XC = (LAS float*)lds; LAS unsigned char* XCB = lds + 16640; LAS float* A_ = (LAS float*)(lds + 25856); LAS float* U_ = (LAS float*)(lds + 58624);
    const bf16_t* XR = (const bf16_t*)(ws + WS_XR);
    bf16x8 gA[4][2], gX[4][2]; float gba[4], gbx[4], glm[4];
    {
        const int d = wave & 1; const bf16_t* GW = (const bf16_t*)(ws + WS_GW);
#pragma unroll
        for (int nt = 0; nt < 4; ++nt) {
#pragma unroll
            for (int ks = 0; ks < 2; ++ks) {
                gA[nt][ks] = *(const bf16x8*)(GW + (size_t)(((d * 2 + 0) * 8 + nb) * 64 + 16 * nt + fr) * 64 + 32 * ks + 8 * fq);
                gX[nt][ks] = *(const bf16x8*)(GW + (size_t)(((d * 2 + 1) * 8 + nb) * 64 + 16 * nt + fr) * 64 + 32 * ks + 8 * fq);
            }
            const int chn = d * 512 + nb * 64 + 16 * nt + fr;
            gba[nt] = p.in[I_BA][chn]; gbx[nt] = p.in[I_BX][chn]; glm[nt] = ((const float*)(ws + WS_SP))[chn];
        }
    }
    {
        const int c = tid & 63, tg = tid >> 6, ch = nb * 64 + c;
        const float* cw = p.in[I_CONVW]; const float w0 = cw[ch], w1 = cw[512 + ch], w2 = cw[1024 + ch], w3 = cw[1536 + ch], cb = p.in[I_CONVB][ch];
        float x[11];
#pragma unroll
        for (int i = 0; i < 11; ++i) x[i] = (i & 1) ? bfhi(xraw[i >> 1]) : bflo(xraw[i >> 1]);
#pragma unroll
        for (int k = 0; k < 8; ++k) {
            const float xc = cb + w0 * x[k] + w1 * x[k + 1] + w2 * x[k + 2] + w3 * x[k + 3];
            XC[(8 * tg + k) * 65 + c] = xc;
            *(LAS bf16_t*)(XCB + (8 * tg + k) * 144 + c * 2) = (bf16_t)(cvt_pk_bf16(xc, 0.f) & 0xffffu);
        }
    }
    if (rnext < 2048) r1_loads(p, rnext, tid, xraw);
    __syncthreads();
    {
        const int d = wave & 1, tq = wave >> 1;
        bf16x8 af[2];
#pragma unroll
        for (int ks = 0; ks < 2; ++ks) af[ks] = *(const LAS bf16x8*)(XCB + (16 * tq + fr) * 144 + (32 * ks + 8 * fq) * 2);
#pragma unroll
        for (int nt = 0; nt < 4; ++nt) {
            f32x4 aA = (f32x4){0.f, 0.f, 0.f, 0.f}, aX = (f32x4){0.f, 0.f, 0.f, 0.f};
#pragma unroll
            for (int ks = 0; ks < 2; ++ks) {
                aA = __builtin_amdgcn_mfma_f32_16x16x32_bf16(af[ks], gA[nt][ks], aA, 0, 0, 0);
                aX = __builtin_amdgcn_mfma_f32_16x16x32_bf16(af[ks], gX[nt][ks], aX, 0, 0, 0);
            }
            const int n = 16 * nt + fr, ch = nb * 64 + n;
            const float ba = gba[nt], bx = gbx[nt], sp = glm[nt];
#pragma unroll
            for (int j = 0; j < 4; ++j) {
                const int t = 16 * tq + 4 * fq + j;
                const float rg = sigmoidf_(aA[j] + ba), ig = sigmoidf_(aX[j] + bx), la = -8.f * rg * sp;
                const float av = __expf(la), uv = __builtin_amdgcn_sqrtf(one_minus_exp(2.f * la)) * ig * XC[t * 65 + n];
                A_[(d * 64 + t) * 64 + n] = av; U_[(d * 64 + t) * 64 + n] = uv;
            }
        }
    }
    __syncthreads();
    const int d = tid >> 8, sub = (tid >> 6) & 3, ch = tid & 63;
    {
        float h = 0.f, P = 1.f;
#pragma unroll
        for (int k = 0; k < 16; ++k) {
            const int t = d == 0 ? 16 * sub + k : 16 * sub + 15 - k, idx = (d * 64 + t) * 64 + ch;
            const float a = A_[idx], u = U_[idx]; h = a * h + u; P *= a; U_[idx] = h; A_[idx] = P;
        }
    }
    __syncthreads();
    {
        float chh = 0.f, cP = 1.f;
        if (d == 0) { for (int s = 0; s < sub; ++s) { const int e = (16 * s + 15) * 64 + ch; chh = U_[e] + A_[e] * chh; cP *= A_[e]; } }
        else { for (int s = 3; s > sub; --s) { const int e = (64 + 16 * s) * 64 + ch; chh = U_[e] + A_[e] * chh; cP *= A_[e]; } }
        bf16_t* HL = (bf16_t*)(ws + (d == 0 ? WS_HLF : WS_HLB)); bf16_t* PC = (bf16_t*)(ws + (d == 0 ? WS_PCF : WS_PCB));
#pragma unroll
        for (int k = 0; k < 16; ++k) {
            const int t = 16 * sub + k, idx = (d * 64 + t) * 64 + ch;
            const float hl = U_[idx], pl = A_[idx];
            const size_t g = (size_t)(tok0 + t) * 512 + nb * 64 + ch;
            const unsigned hp = cvt_pk_bf16(hl + pl * chh, pl * cP); HL[g] = (bf16_t)hp; PC[g] = (bf16_t)(hp >> 16);
        }
    }
    __syncthreads();
}
__device__ __forceinline__ void r2_tile(const Params& p, int c64) {
    const int ch = otid(); unsigned char* ws = p.ws;
    const int tok0 = c64 * 64; const bool prompt = tok0 < NPR;
    int s0, len; if (prompt) { s0 = tok0 & ~255; len = 256; } else { s0 = NPR + ((tok0 - NPR) & ~2047); len = 2048; }
    const int n = (tok0 - s0) >> 6, nc = len >> 6;
    const bf16_t* HLF = (const bf16_t*)(ws + WS_HLF); const bf16_t* HLB = (const bf16_t*)(ws + WS_HLB);
    const bf16_t* PCF = (const bf16_t*)(ws + WS_PCF); const bf16_t* PCB = (const bf16_t*)(ws + WS_PCB);
    float cf = 0.f, cb = 0.f;
    if (!prompt) { const int bs = (tok0 - NPR) >> 11; cf = p.in[I_STATE][(bs * 2 + 0) * 512 + ch]; cb = p.in[I_STATE][(bs * 2 + 1) * 512 + ch]; }
    for (int c0 = 0; c0 < n; c0 += 8) {
        float hv[8], pv[8];
#pragma unroll
        for (int i = 0; i < 8; ++i) { const int cc = (c0 + i < n) ? c0 + i : n - 1; const size_t g = (size_t)(s0 + 64 * cc + 63) * 512 + ch; hv[i] = bf2f(HLF[g]); pv[i] = bf2f(PCF[g]); }
#pragma unroll
        for (int i = 0; i < 8; ++i) if (c0 + i < n) cf = hv[i] + pv[i] * cf;
    }
    for (int c0 = nc - 1; c0 > n; c0 -= 8) {
        float hv[8], pv[8];
#pragma unroll
        for (int i = 0; i < 8; ++i) { const int cc = (c0 - i > n) ? c0 - i : n + 1; const size_t g = (size_t)(s0 + 64 * cc) * 512 + ch; hv[i] = bf2f(HLB[g]); pv[i] = bf2f(PCB[g]); }
#pragma unroll
        for (int i = 0; i < 8; ++i) if (c0 - i > n) cb = hv[i] + pv[i] * cb;
    }
    const bf16_t* XGb = (const bf16_t*)(ws + WS_XG); bf16_t* MIX = (bf16_t*)(ws + WS_MIX);
    float* ostate = p.out + (size_t)NTOK * DM + 2 * (size_t)NPR * 256;
#pragma unroll 8
    for (int t = 0; t < 64; ++t) {
        const size_t g = (size_t)(tok0 + t) * 512 + ch;
        const float hf = bf2f(__builtin_nontemporal_load(HLF + g)) + bf2f(__builtin_nontemporal_load(PCF + g)) * cf, hb = bf2f(__builtin_nontemporal_load(HLB + g)) + bf2f(__builtin_nontemporal_load(PCB + g)) * cb;
        const float y = (hf + hb) * geluf_(bf2f(XGb[g]));
        MIX[(size_t)(tok0 + t) * DM + 512 + ch] = (bf16_t)(cvt_pk_bf16(y, 0.f) & 0xffffu);
        if (prompt) {
            if (n == nc - 1 && t == 63) ostate[((tok0 >> 8) * 2 + 0) * 512 + ch] = hf;
            if (n == 0 && t == 0) ostate[((tok0 >> 8) * 2 + 1) * 512 + ch] = hb;
        }
    }
}
__device__ __forceinline__ void spatial_tile(const Params& p, LAS unsigned char* lds, int r) {
    const int tid = otid(), lane = tid & 63, wave = tid >> 6, fr = lane & 15, fq = lane >> 4;
    unsigned char* ws = p.ws;
    const int nchunk = r >> 3, g = r & 7, tok0 = nchunk * 128;
    LAS unsigned char* SA = lds; LAS unsigned char* SB = lds + 34816; LAS float* MU = (LAS float*)(lds + 69632); LAS float* RS = (LAS float*)(lds + 70144);
    if (tid < 128) {
        const float* st = (const float*)(ws + WS_VSTAT) + (size_t)(tok0 + tid) * 32;
        float s1 = 0.f, s2 = 0.f;
#pragma unroll
        for (int i = 0; i < 16; ++i) { s1 += st[2 * i]; s2 += st[2 * i + 1]; }
        const float mu = s1 * (1.f / 1024.f), var = fmaxf(s2 * (1.f / 1024.f) - mu * mu, 0.f);
        MU[tid] = mu; RS[tid] = rsqrtf(var + LN_EPS_C);
    }
    const bf16_t* SPW = (const bf16_t*)(ws + WS_SPW);
#pragma unroll
    for (int i = 0; i < 4; ++i) { const int idx = tid + 512 * i, pr = idx >> 4, c16 = idx & 15;
        *(LAS u32x4*)(SA + pr * 272 + c16 * 16) = *(const u32x4*)(SPW + (size_t)(g * 128 + pr) * 128 + c16 * 8); }
    const bf16_t* V2 = (const bf16_t*)(ws + WS_V2);
    u32x4 rawv[4];
#pragma unroll
    for (int i = 0; i < 4; ++i) { const int idx = tid + 512 * i, q = idx & 127, c8 = idx >> 7; rawv[i] = *(const u32x4*)(V2 + (size_t)(tok0 + q) * DM + g * 128 + c8 * 8); }
    __syncthreads();
#pragma unroll
    for (int i = 0; i < 4; ++i) { const int idx = tid + 512 * i, q = idx & 127, c8 = idx >> 7;
        const u32x4 raw = rawv[i];
        const float* lgp = p.in[I_SGLNG] + g * 128 + c8 * 8; const float* lbp = p.in[I_SGLNB] + g * 128 + c8 * 8;
        const f32x4 lg0 = *(const f32x4*)lgp, lg1 = *(const f32x4*)(lgp + 4), lb0 = *(const f32x4*)lbp, lb1 = *(const f32x4*)(lbp + 4);
        const float mu = MU[q], rs = RS[q];
        const unsigned w0 = cvt_pk_bf16((bflo(raw.x) - mu) * rs * lg0.x + lb0.x, (bfhi(raw.x) - mu) * rs * lg0.y + lb0.y);
        const unsigned w1 = cvt_pk_bf16((bflo(raw.y) - mu) * rs * lg0.z + lb0.z, (bfhi(raw.y) - mu) * rs * lg0.w + lb0.w);
        const unsigned w2 = cvt_pk_bf16((bflo(raw.z) - mu) * rs * lg1.x + lb1.x, (bfhi(raw.z) - mu) * rs * lg1.y + lb1.y);
        const unsigned w3 = cvt_pk_bf16((bflo(raw.w) - mu) * rs * lg1.z + lb1.z, (bfhi(raw.w) - mu) * rs * lg1.w + lb1.w);
        LAS unsigned char* sd = SB + (c8 * 8) * 272 + q * 2;
        *(LAS bf16_t*)(sd) = (bf16_t)w0; *(LAS bf16_t*)(sd + 272) = (bf16_t)(w0 >> 16); *(LAS bf16_t*)(sd + 2 * 272) = (bf16_t)w1; *(LAS bf16_t*)(sd + 3 * 272) = (bf16_t)(w1 >> 16);
        *(LAS bf16_t*)(sd + 4 * 272) = (bf16_t)w2; *(LAS bf16_t*)(sd + 5 * 272) = (bf16_t)(w2 >> 16); *(LAS bf16_t*)(sd + 6 * 272) = (bf16_t)w3; *(LAS bf16_t*)(sd + 7 * 272) = (bf16_t)(w3 >> 16); }
    __syncthreads();
    const int wr = wave >> 1, wc = wave & 1;
    const bf16_t* U = (const bf16_t*)(ws + WS_U); bf16_t* S_ = (bf16_t*)(ws + WS_MIX);
    u32x2 upre[2][4]; float bpre[2];
#pragma unroll
    for (int mt = 0; mt < 2; ++mt) { const int pr = 32 * wr + 16 * mt + fr; bpre[mt] = p.in[I_SPB][g * 128 + pr];
#pragma unroll
        for (int nt = 0; nt < 4; ++nt) upre[mt][nt] = *(const u32x2*)(U + (size_t)(tok0 + pr) * DM + g * 128 + 64 * wc + 16 * nt + 4 * fq); }
    f32x4 acc[2][4];
#pragma unroll
    for (int i = 0; i < 2; ++i)
#pragma unroll
        for (int j = 0; j < 4; ++j) acc[i][j] = (f32x4){0.f, 0.f, 0.f, 0.f};
#pragma unroll
    for (int ks = 0; ks < 4; ++ks) {
        bf16x8 af[2], bf[4];
#pragma unroll
        for (int mt = 0; mt < 2; ++mt) af[mt] = *(const LAS bf16x8*)(SA + (32 * wr + 16 * mt + fr) * 272 + (32 * ks + 8 * fq) * 2);
#pragma unroll
        for (int nt = 0; nt < 4; ++nt) bf[nt] = *(const LAS bf16x8*)(SB + (64 * wc + 16 * nt + fr) * 272 + (32 * ks + 8 * fq) * 2);
#pragma unroll
        for (int mt = 0; mt < 2; ++mt)
#pragma unroll
            for (int nt = 0; nt < 4; ++nt) acc[mt][nt] = __builtin_amdgcn_mfma_f32_16x16x32_bf16(bf[nt], af[mt], acc[mt][nt], 0, 0, 0);
    }
#pragma unroll
    for (int mt = 0; mt < 2; ++mt) {
        const int pr = 32 * wr + 16 * mt + fr; const float bias = bpre[mt];
#pragma unroll
        for (int nt = 0; nt < 4; ++nt) {
            const size_t off = (size_t)(tok0 + pr) * DM + g * 128 + 64 * wc + 16 * nt + 4 * fq;
            const u32x2 uu = upre[mt][nt];
            u32x2 ov; ov.x = cvt_pk_bf16(bflo(uu.x) * (acc[mt][nt][0] + bias), bfhi(uu.x) * (acc[mt][nt][1] + bias));
            ov.y = cvt_pk_bf16(bflo(uu.y) * (acc[mt][nt][2] + bias), bfhi(uu.y) * (acc[mt][nt][3] + bias));
            *(u32x2*)(S_ + off) = ov;
        }
    }
    __syncthreads();
}
__device__ __forceinline__ void phase_lnmix(const Params& p, LAS unsigned char* lds, int l) {
    const int tid = otid(), lane = tid & 63, wave = tid >> 6; unsigned char* ws = p.ws;
    LAS float* RW = (LAS float*)lds; LAS float* XT = (LAS float*)(lds + 65536); LAS float* PS = (LAS float*)(lds + 65536 + 65792);
    const float* rw = p.in[I_ROUTER] + (size_t)l * 16384;
    for (int i = tid; i < 4096; i += 512) *(LAS f32x4*)(RW + i * 4) = *(const f32x4*)(rw + i * 4);
    bf16_t* XA = (bf16_t*)(ws + WS_XA); unsigned char* HMOE = ws + WS_HMOE; float* AFF = (float*)(ws + WS_AFF);
    const float* gam = p.in[I_LNMG] + l * DM; const float* bet = p.in[I_LNMB] + l * DM;
    for (int tile = blockIdx.x; tile < NTOK / 16; tile += gridDim.x) {
        const int row0 = tile * 16;
        const float* modr = (const float*)(ws + WS_MOD) + (size_t)(l * 5 + cond_of(row0)) * 6144;
        f32x4 vv[2][4];
#pragma unroll
        for (int rr = 0; rr < 2; ++rr)
#pragma unroll
            for (int j = 0; j < 4; ++j) { const u32x2 w = *(const u32x2*)(XA + (size_t)(row0 + wave * 2 + rr) * DM + 4 * lane + 256 * j); vv[rr][j] = (f32x4){bflo(w.x), bfhi(w.x), bflo(w.y), bfhi(w.y)}; }
#pragma unroll
        for (int rr = 0; rr < 2; ++rr) {
            const int rl = wave * 2 + rr, row = row0 + rl;
            f32x4 v[4]; float s = 0.f;
#pragma unroll
            for (int j = 0; j < 4; ++j) { v[j] = vv[rr][j]; s += (v[j].x + v[j].y) + (v[j].z + v[j].w); }
            const float mean = wave_sum(s) * (1.f / DM); float s2 = 0.f;
#pragma unroll
            for (int j = 0; j < 4; ++j) { v[j] = v[j] - mean; s2 += (v[j].x * v[j].x + v[j].y * v[j].y) + (v[j].z * v[j].z + v[j].w * v[j].w); }
            const float rstd = rsqrtf(wave_sum(s2) * (1.f / DM) + LN_EPS_C);
#pragma unroll
            for (int j = 0; j < 4; ++j) {
                const int c = 4 * lane + 256 * j;
                const f32x4 x1 = v[j] * rstd * *(const f32x4*)(gam + c) + *(const f32x4*)(bet + c);
                { u32x2 ox; ox.x = cvt_pk_bf16(x1.x, x1.y); ox.y = cvt_pk_bf16(x1.z, x1.w); *(u32x2*)(XA + (size_t)row * DM + c) = ox; }
                const f32x4 hm = x1 * (*(const f32x4*)(modr + 4 * 1024 + c) + 1.f) + *(const f32x4*)(modr + 3 * 1024 + c);
                *(unsigned*)(HMOE + (size_t)row * DM + c) = pk4_fp8(hm.x, hm.y, hm.z, hm.w);
                *(LAS f32x4*)(XT + rl * 1028 + c) = hm;
            }
        }
        __syncthreads();
        {
            f32x4 acc = (f32x4){0.f, 0.f, 0.f, 0.f};
            const int ri = lane & 15, kq = lane >> 4, kb = wave * 128;
#pragma unroll 8
            for (int kk = 0; kk < 32; ++kk) {
                const int k = kb + 4 * kk + kq;
                acc = __builtin_amdgcn_mfma_f32_16x16x4f32(XT[ri * 1028 + k], RW[k * 16 + ri], acc, 0, 0, 0);
            }
#pragma unroll
            for (int r = 0; r < 4; ++r) PS[wave * 256 + (4 * kq + r) * 16 + ri] = acc[r];
        }
        __syncthreads();
        if (tid < 256) {
            float lg = 0.f;
#pragma unroll
            for (int w = 0; w < 8; ++w) lg += PS[w * 256 + tid];
            float mx = lg;
#pragma unroll
            for (int o = 1; o < 16; o <<= 1) mx = fmaxf(mx, __shfl_xor(mx, o));
            const float ex = __expf(lg - mx); float sm = ex;
#pragma unroll
            for (int o = 1; o < 16; o <<= 1) sm += __shfl_xor(sm, o);
            AFF[(size_t)(row0 + (tid >> 4)) * 16 + (tid & 15)] = ex / sm;
        }
        __syncthreads();
    }
}
__device__ __forceinline__ void phase_route(const Params& p, LAS unsigned char* lds) {
    const int tid = otid(), lane = tid & 63, wave = tid >> 6; unsigned char* ws = p.ws;
    LAS unsigned* key = (LAS unsigned*)lds; LAS int* idx = (LAS int*)(lds + 8192);
    const float* AFF = (const float*)(ws + WS_AFF); int* TOKSLOT = (int*)(ws + WS_TOKSLOT); float* SG = (float*)(ws + WS_SLOTGATE);
    const unsigned char* HMOE = ws + WS_HMOE; unsigned char* XG = ws + WS_XGATH;
    for (int tile = blockIdx.x; tile < 576; tile += gridDim.x) {
        int b, e, T, tok0, cap, ls0;
        if (tile < 64) { b = tile >> 4; e = tile & 15; T = 2048; tok0 = NPR + b * 2048; cap = 256; ls0 = 1024 + b * 256; }
        else { const int t2 = tile - 64; b = t2 >> 4; e = t2 & 15; T = 256; tok0 = b * 256; cap = 32; ls0 = b * 32; }
        for (int i = tid; i < T; i += 512) { key[i] = __builtin_bit_cast(unsigned, AFF[(size_t)(tok0 + i) * 16 + e]); idx[i] = i; }
        __syncthreads();
        for (int k = 2; k <= T; k <<= 1)
            for (int j = k >> 1; j > 0; j >>= 1) {
                for (int pp = tid; pp < (T >> 1); pp += 512) {
                    const int i = ((pp & ~(j - 1)) << 1) | (pp & (j - 1)), l = i | j;
                    const bool desc = (i & k) == 0;
                    const unsigned ki = key[i], kl = key[l]; const int ii = idx[i], il = idx[l];
                    const bool inorder = (ki > kl) || (ki == kl && ii < il);
                    if (inorder != desc) { key[i] = kl; key[l] = ki; idx[i] = il; idx[l] = ii; }
                }
                __syncthreads();
            }
        for (int pos = tid; pos < T; pos += 512) {
            const int tok = idx[pos];
            TOKSLOT[(size_t)(tok0 + tok) * 16 + e] = pos < cap ? ls0 + pos : -1;
            if (pos < cap) SG[e * 2048 + ls0 + pos] = __builtin_bit_cast(float, key[pos]);
        }
        for (int pos0 = wave * 4; pos0 < cap; pos0 += 32) {
            u32x4 rowv[4];
#pragma unroll
            for (int q = 0; q < 4; ++q) rowv[q] = ((const u32x4*)(HMOE + (size_t)(tok0 + idx[pos0 + q]) * DM))[lane];
#pragma unroll
            for (int q = 0; q < 4; ++q) ((u32x4*)(XG + (size_t)(e * 2048 + ls0 + pos0 + q) * DM))[lane] = rowv[q];
        }
        __syncthreads();
    }
}
__device__ __forceinline__ void phase_lnffn(const Params& p, int l) {
    const int tid = otid(), lane = tid & 63, wave = tid >> 6; unsigned char* ws = p.ws;
    bf16_t* XA = (bf16_t*)(ws + WS_XA); bf16_t* H = (bf16_t*)(ws + WS_H); const bf16_t* Y = (const bf16_t*)(ws + WS_Y); const int* TOKSLOT = (const int*)(ws + WS_TOKSLOT);
    const float* gam = p.in[I_LNFG] + l * DM; const float* bet = p.in[I_LNFB] + l * DM;
    const int rstride = gridDim.x * 8;
    int slv_n = 0; u32x2 xr_n[4];
    { const int row = blockIdx.x * 8 + wave;
      if (row < NTOK) { slv_n = TOKSLOT[(size_t)row * 16 + (lane & 15)];
#pragma unroll
          for (int j = 0; j < 4; ++j) xr_n[j] = *(const u32x2*)(XA + (size_t)row * DM + 4 * lane + 256 * j); } }
    for (int row = blockIdx.x * 8 + wave; row < NTOK; row += rstride) {
        const int cond = cond_of(row);
        const int slv = slv_n; u32x2 xr_c[4];
#pragma unroll
        for (int j = 0; j < 4; ++j) xr_c[j] = xr_n[j];
        if (row + rstride < NTOK) {
            slv_n = TOKSLOT[(size_t)(row + rstride) * 16 + (lane & 15)];
#pragma unroll
            for (int j = 0; j < 4; ++j) xr_n[j] = *(const u32x2*)(XA + (size_t)(row + rstride) * DM + 4 * lane + 256 * j);
        }
        const float* modr = (const float*)(ws + WS_MOD) + (size_t)(l * 5 + cond) * 6144;
        f32x4 f[4], xres[4];
#pragma unroll
        for (int j = 0; j < 4; ++j) { f[j] = (f32x4){0.f, 0.f, 0.f, 0.f}; { const u32x2 w = xr_c[j]; xres[j] = (f32x4){bflo(w.x), bfhi(w.x), bflo(w.y), bfhi(w.y)}; } }
        {
            unsigned long long m = __builtin_amdgcn_ballot_w64(slv >= 0) & 0xffffull;
            while (m) {
                const int e0 = __builtin_ctzll(m); m &= m - 1;
                const bool two = m != 0; const int e1 = two ? __builtin_ctzll(m) : e0; if (two) m &= m - 1;
                const int s0 = __builtin_amdgcn_readlane(slv, e0), s1 = __builtin_amdgcn_readlane(slv, e1);
                const bf16_t* y0 = Y + (size_t)(e0 * 2048 + s0) * DM; const bf16_t* y1 = Y + (size_t)(e1 * 2048 + s1) * DM;
                u32x2 w0[4], w1[4];
#pragma unroll
                for (int j = 0; j < 4; ++j) { w0[j] = __builtin_nontemporal_load((const u32x2*)(y0 + 4 * lane + 256 * j)); w1[j] = __builtin_nontemporal_load((const u32x2*)(y1 + 4 * lane + 256 * j)); }
                const float k1 = two ? 1.f : 0.f;
#pragma unroll
                for (int j = 0; j < 4; ++j) {
                    f[j].x += bflo(w0[j].x) + k1 * bflo(w1[j].x); f[j].y += bfhi(w0[j].x) + k1 * bfhi(w1[j].x);
                    f[j].z += bflo(w0[j].y) + k1 * bflo(w1[j].y); f[j].w += bfhi(w0[j].y) + k1 * bfhi(w1[j].y);
                }
            }
        }
        f32x4 v[4]; float s = 0.f;
#pragma unroll
        for (int j = 0; j < 4; ++j) { const int c = 4 * lane + 256 * j;
            v[j] = xres[j] * ALPHA_C + *(const f32x4*)(modr + 5 * 1024 + c) * f[j];
            s += (v[j].x + v[j].y) + (v[j].z + v[j].w); }
        const float mean = wave_sum(s) * (1.f / DM); float s2 = 0.f;
#pragma unroll
        for (int j = 0; j < 4; ++j) { v[j] = v[j] - mean; s2 += (v[j].x * v[j].x + v[j].y * v[j].y) + (v[j].z * v[j].z + v[j].w * v[j].w); }
        const float rstd = rsqrtf(wave_sum(s2) * (1.f / DM) + LN_EPS_C);
        const float* modn = (const float*)(ws + WS_MOD) + (size_t)(5 + cond) * 6144;
#pragma unroll
        for (int j = 0; j < 4; ++j) {
            const int c = 4 * lane + 256 * j;
            const f32x4 x2 = v[j] * rstd * *(const f32x4*)(gam + c) + *(const f32x4*)(bet + c);
            if (l == 0) {
                { u32x2 ox; ox.x = cvt_pk_bf16(x2.x, x2.y); ox.y = cvt_pk_bf16(x2.z, x2.w); *(u32x2*)(XA + (size_t)row * DM + c) = ox; }
                const f32x4 h = x2 * (*(const f32x4*)(modn + 1024 + c) + 1.f) + *(const f32x4*)(modn + c);
                u32x2 o; o.x = cvt_pk_bf16(h.x, h.y); o.y = cvt_pk_bf16(h.z, h.w);
                *(u32x2*)(H + (size_t)row * DM + c) = o;
            } else *(f32x4*)(p.out + (size_t)row * DM + c) = x2;
        }
    }
}
#ifndef PHMASK
#define PHMASK 0xFFFFF
#endif
template <int PH> __device__ __forceinline__ void run_phase(const Params& p, LAS unsigned char* lds) {
    unsigned char* ws = p.ws;
    const int G = gridDim.x;
    constexpr int l = PH >= 11 ? 1 : 0;
    constexpr int base = PH >= 13 ? PH - 8 : PH;
    if constexpr (!(((PHMASK) >> (base)) & 1)) return;
    if constexpr (base == 0) phase_p0(p, lds);
    else if constexpr (base == 1) phase_p0b(p);
    else if constexpr (base == 2) {
        pg8::Gemm g; g.A = (const bf16_t*)(ws + WS_H); g.Bt = (const bf16_t*)(ws + WS_ABIN); g.M = NTOK; g.N = 2048; g.K = 1024;
        pg8::StaticOrder S; S.init(NTOK, 2048, G, blockIdx.x);
        EpiIn E; E.Q = (bf16_t*)(ws + WS_Q); E.Kb = (bf16_t*)(ws + WS_K); E.Vb = (bf16_t*)(ws + WS_V); E.XR = (bf16_t*)(ws + WS_XR); E.XGb = (bf16_t*)(ws + WS_XG);
        E.outK = p.out + (size_t)NTOK * DM; E.outV = p.out + (size_t)NTOK * DM + (size_t)NPR * 256; E.rope = (const float*)(ws + WS_ROPE);
        pg8::gemm_phase<EpiIn, pg8::StaticOrder, true, true>(lds, g, S, E);
    } else if constexpr (base == 3) {
        unsigned xraw[6]; bool primed = false;
        for (int t = blockIdx.x; t < 512 + 2048; t += G) {
            if (t < 512) attn_tile(p, lds, t);
            else { if (!primed) { r1_loads(p, t - 512, otid(), xraw); primed = true; } r1_tile(p, lds, t - 512, xraw, t - 512 + G); } }
    } else if constexpr (base == 4) {
        for (int t = blockIdx.x; t < 256; t += G) r2_tile(p, t);
    } else if constexpr (base == 5) {
        pg8::Gemm g; g.A = (const bf16_t*)(ws + WS_MIX); g.Bt = (const bf16_t*)(ws + (l ? WS_SGOUT : WS_ABOUT)); g.M = NTOK; g.N = 1024; g.K = 1024;
        pg8::StaticOrder S; S.init(NTOK, 1024, G, blockIdx.x);
        EpiOut<(l == 1)> E; E.XA = (bf16_t*)(ws + WS_XA); E.modl = (const float*)(ws + WS_MOD) + (size_t)l * 5 * 6144;
        E.xin_p = p.in[I_XP]; E.xin_s = p.in[I_XS];
        pg8::gemm_phase<EpiOut<(l == 1)>, pg8::StaticOrder, true, true>(lds, g, S, E);
    } else if constexpr (base == 6) phase_lnmix(p, lds, l);
    else if constexpr (base == 7) phase_route(p, lds);
    else if constexpr (base == 8) {
        pg8::Gemm g; g.A = (const bf16_t*)(ws + WS_XGATH); g.Bt = (const bf16_t*)(ws + WS_BTUP + (size_t)l * 16 * 4096 * 1024); g.M = 32768; g.N = 65536; g.K = 512;
        pg8::GroupOrder<2048, 128, 16> S; S.G = G; S.c = blockIdx.x;
        EpiUp E; E.Hid = ws + WS_HID;
        pg8::gemm_phase<EpiUp, pg8::GroupOrder<2048, 128, 16>, true, true, true>(lds, g, S, E);
    } else if constexpr (base == 9) {
        pg8::Gemm g; g.A = (const bf16_t*)(ws + WS_HID); g.Bt = (const bf16_t*)(ws + WS_BTDN + (size_t)l * 16 * 1024 * 2048); g.M = 32768; g.N = 16384; g.K = 1024;
        pg8::GroupOrder<512, 32, 4> S; S.G = G; S.c = blockIdx.x;
        EpiDn E; E.Y = (bf16_t*)(ws + WS_Y); E.gate = (const float*)(ws + WS_SLOTGATE);
        pg8::gemm_phase<EpiDn, pg8::GroupOrder<512, 32, 4>, true, true, true>(lds, g, S, E);
    } else if constexpr (base == 10) phase_lnffn(p, l);
    else if constexpr (base == 11) {
        pg8::Gemm g; g.A = (const bf16_t*)(ws + WS_H); g.Bt = (const bf16_t*)(ws + WS_SGIN); g.M = NTOK; g.N = 2048; g.K = 1024;
        pg8::StaticOrder S; S.init(NTOK, 2048, G, blockIdx.x);
        EpiSgu E; E.U = (bf16_t*)(ws + WS_U); E.V2 = (bf16_t*)(ws + WS_V2); E.vstat = (float*)(ws + WS_VSTAT); E.bias = p.in[I_SGINB];
        pg8::gemm_phase<EpiSgu, pg8::StaticOrder, true, true>(lds, g, S, E);
    } else if constexpr (base == 12) {
        for (int t = blockIdx.x; t < 1024; t += G) spatial_tile(p, lds, t);
    }
}
__global__ void __launch_bounds__(512, 2) fwd_kernel(Params p) {
    extern __shared__ __attribute__((aligned(16))) unsigned char smem[];
    LAS unsigned char* lds = (LAS unsigned char*)smem;
    volatile LAS unsigned* xst = (volatile LAS unsigned*)(lds + LDS_BYTES - 16);
    if (threadIdx.x == 0) { xst[0] = 0u; xst[1] = 0u; }
    __syncthreads();
    XcdBarrier xb = xcd_barrier_post((unsigned*)(p.ws + WS_BAR), xst);
#ifndef DUPMASK
#define DUPMASK 0
#endif
#define PHASE(k) if (p.ph_lo <= (k) && (k) < p.ph_hi) { run_phase<k>(p, lds); if constexpr (((DUPMASK) >> (k)) & 1) { xcd_barrier(xb); run_phase<k>(p, lds); } \
        if ((k) + 1 < p.ph_hi) { if ((k) == 0 && p.ph_hi > NPHASE) cg::this_grid().sync(); else xcd_barrier(xb); } }
    PHASE(0) PHASE(1) PHASE(2) PHASE(3) PHASE(4) PHASE(5) PHASE(6) PHASE(7) PHASE(8) PHASE(9)
    PHASE(10) PHASE(11) PHASE(12) PHASE(13) PHASE(14) PHASE(15) PHASE(16) PHASE(17) PHASE(18)
#undef PHASE
}

extern "C" void kernel_launch(void* const* d_in, const int* in_sizes, int n_in, void* d_out, int out_size, void* d_ws, size_t ws_size, hipStream_t stream) {
    static int grid = 0;
    if (grid == 0) {
        if (n_in != 34 || ws_size < WS_END) { fprintf(stderr, "kernel_launch: expected 34 inputs and >= %zu bytes of workspace; got %d, %zu\n", (size_t)WS_END, n_in, ws_size); grid = -1; return; }
        int dev = 0, cus = 0, per_cu = 0;
        hipGetDevice(&dev);
        hipDeviceGetAttribute(&cus, hipDeviceAttributeMultiprocessorCount, dev);
        if (hipFuncSetAttribute((const void*)fwd_kernel, hipFuncAttributeMaxDynamicSharedMemorySize, LDS_BYTES) != hipSuccess) { fprintf(stderr, "kernel_launch: hipFuncSetAttribute failed\n"); grid = -1; return; }
        hipOccupancyMaxActiveBlocksPerMultiprocessor(&per_cu, (const void*)fwd_kernel, 512, LDS_BYTES);
        if (per_cu < 1) { fprintf(stderr, "kernel_launch: occupancy query says %d blocks per CU\n", per_cu); per_cu = 1; }
        (void)hipGetLastError();
        grid = cus;
        if (grid % 8 != 0 || grid <= 0) grid = 256;
    }
    if (grid < 0) return;
    if (hipMemsetAsync((unsigned char*)d_ws + WS_BAR, 0, 16384, stream) != hipSuccess) { fprintf(stderr, "kernel_launch: memset of the barrier words failed\n"); return; }
    Params p{};
    for (int i = 0; i < 34; ++i) p.in[i] = (const float*)d_in[i];
    p.out = (float*)d_out; p.ws = (unsigned char*)d_ws;
#if N_SPLIT
    for (int ph = 0; ph < NPHASE; ++ph) { p.ph_lo = ph; p.ph_hi = ph + 1; hipLaunchKernelGGL(fwd_kernel, dim3(grid), dim3(512), LDS_BYTES, stream, p); }
#else
    p.ph_lo = 0; p.ph_hi = NPHASE;
    void* args[] = {&p};
    hipError_t e = hipLaunchCooperativeKernel((const void*)fwd_kernel, dim3(grid), dim3(512), args, LDS_BYTES, stream);
    if (e != hipSuccess) fprintf(stderr, "cooperative launch failed: %s (grid %d)\n", hipGetErrorString(e), grid);
#endif
}
```

```cpp
#include <hip/hip_runtime.h>
#include <hip/hip_cooperative_groups.h>
#include <cstdio>
#include <cstdint>
namespace cg = cooperative_groups;

#define LAS __attribute__((address_space(3)))
typedef unsigned short bf16_t;
typedef short bf16x8 __attribute__((ext_vector_type(8)));
typedef short s16x4 __attribute__((ext_vector_type(4)));
typedef float f32x4 __attribute__((ext_vector_type(4)));
typedef float f32x2 __attribute__((ext_vector_type(2)));
typedef unsigned u32x4 __attribute__((ext_vector_type(4)));
typedef unsigned u32x2 __attribute__((ext_vector_type(2)));

#ifndef N_SPLIT
#define N_SPLIT 0
#endif

constexpr int NTOK = 16384, DM = 1024, NPR = 8192;
constexpr float ALPHA_C = 1.41421356237309515f;
constexpr float ATTN_SCALE_C = 0.08838834764831845f;
constexpr float LN_EPS_C = 1e-6f;
constexpr int LDS_BYTES = 147456;
constexpr int NPHASE = 19;

constexpr size_t MB = 1024ull * 1024ull;
constexpr size_t WS_BTUP = 0;
constexpr size_t WS_BTDN = WS_BTUP + 256 * MB;
constexpr size_t WS_ABIN = WS_BTDN + 128 * MB;
constexpr size_t WS_ABOUT = WS_ABIN + 4 * MB;
constexpr size_t WS_SGIN = WS_ABOUT + 2 * MB;
constexpr size_t WS_SGOUT = WS_SGIN + 4 * MB;
constexpr size_t WS_SPW = WS_SGOUT + 2 * MB;
constexpr size_t WS_GW = WS_SPW + 262144;
constexpr size_t WS_MODP = WS_GW + 262144;
constexpr size_t WS_MOD = WS_MODP + 2 * MB;
constexpr size_t WS_SP = WS_MOD + 245760;
constexpr size_t WS_ROPE = WS_MOD + 262144;
constexpr size_t WS_CK = WS_ROPE + 32768;
constexpr size_t WS_CV = WS_CK + 524288;
constexpr size_t WS_AFF = WS_CV + 524288;
constexpr size_t WS_TOKSLOT = WS_AFF + 1 * MB;
constexpr size_t WS_SLOTGATE = WS_TOKSLOT + 1 * MB;
constexpr size_t WS_VSTAT = WS_SLOTGATE + 131072;
constexpr size_t WS_H = WS_VSTAT + 2 * MB;
constexpr size_t WS_HMOE = WS_H + 32 * MB;
constexpr size_t WS_XA = WS_HMOE + 32 * MB;
constexpr size_t WS_QKV = WS_XA + 64 * MB;
constexpr size_t WS_Q = WS_QKV;
constexpr size_t WS_K = WS_QKV + 16 * MB;
constexpr size_t WS_V = WS_QKV + 24 * MB;
constexpr size_t WS_XR = WS_QKV + 32 * MB;
constexpr size_t WS_XG = WS_QKV + 48 * MB;
constexpr size_t WS_U = WS_QKV;
constexpr size_t WS_V2 = WS_QKV + 32 * MB;
constexpr size_t WS_MIX = WS_QKV + 64 * MB;
constexpr size_t WS_BIG = WS_MIX + 32 * MB;
constexpr size_t WS_HLF = WS_BIG, WS_HLB = WS_BIG + 32 * MB, WS_PCF = WS_BIG + 64 * MB, WS_PCB = WS_BIG + 96 * MB;
constexpr size_t WS_HID = WS_BIG;
constexpr size_t WS_XGATH = WS_BIG + 128 * MB;
constexpr size_t WS_Y = WS_XGATH + 64 * MB;
constexpr size_t WS_BAR = WS_Y + 64 * MB;
constexpr size_t WS_END = WS_BAR + 16384;

struct Params { const float* in[34]; float* out; unsigned char* ws; int ph_lo, ph_hi; };

enum { I_XP = 0, I_XS, I_CK, I_CV, I_STATE, I_C, I_CCTX, I_MODW, I_MODB, I_LNMG, I_LNMB, I_LNFG, I_LNFB, I_ABIN, I_SINK, I_CONVW, I_CONVB,
       I_WA, I_BA, I_WX, I_BX, I_LAM, I_ABOUT, I_SGIN, I_SGINB, I_SGLNG, I_SGLNB, I_SPW, I_SPB, I_SGOUT, I_ROUTER, I_W1, I_W3, I_W2 };

__device__ __forceinline__ unsigned cvt_pk_bf16(float lo, float hi) { unsigned r; asm volatile("v_cvt_pk_bf16_f32 %0, %1, %2" : "=v"(r) : "v"(lo), "v"(hi)); return r; }
__device__ __forceinline__ float bf2f(unsigned h) { return __builtin_bit_cast(float, h << 16); }
__device__ __forceinline__ float bflo(unsigned w) { return __builtin_bit_cast(float, w << 16); }
__device__ __forceinline__ float bfhi(unsigned w) { return __builtin_bit_cast(float, w & 0xffff0000u); }
__device__ __forceinline__ float wave_sum(float v) {
#pragma unroll
    for (int o = 1; o < 64; o <<= 1) v += __shfl_xor(v, o);
    return v;
}
__device__ __forceinline__ float sigmoidf_(float x) { return __builtin_amdgcn_rcpf(1.f + __builtin_amdgcn_exp2f(x * -1.4426950408889634f)); }
__device__ __forceinline__ float siluf_(float x) { return x * __builtin_amdgcn_rcpf(1.f + __builtin_amdgcn_exp2f(x * -1.4426950408889634f)); }
__device__ __forceinline__ float geluf_(float x) { const float t = x * (-2.3022082f + -0.10294324f * (x * x)); return x * __builtin_amdgcn_rcpf(1.f + __builtin_amdgcn_exp2f(t)); }
__device__ __forceinline__ float one_minus_exp(float x) {
    const float pl = -x * (1.f + x * (0.5f + x * (0.16666667f + x * (0.041666668f + x * (0.0083333338f + x * 0.0013888889f)))));
    return x > -0.5f ? pl : 1.f - __expf(x);
}
__device__ __forceinline__ int cond_of(int row) { return row < NPR ? 0 : 1 + ((row - NPR) >> 11); }
__device__ __forceinline__ int otid() { int t = threadIdx.x; asm volatile("" : "+v"(t)); return t; }
#define LDS_WAIT() asm volatile("s_waitcnt lgkmcnt(0)" ::: "memory")

#define XB_TMO      128
#define XB_XCNT(j)  (256  + 64 * (j))
#define XB_XSUB(j)  (1280 + 64 * (j))
#define XB_XGEN(j)  (2304 + 64 * (j))
#define XB_TOP      3328
#define XB_TOPGEN   3392
#define XCD_BAR_WORDS 3456
#define XB_SPIN_CAP (1u << 18)

__device__ __forceinline__ unsigned xb_ld(unsigned* p)              { return __hip_atomic_load(p, __ATOMIC_RELAXED, __HIP_MEMORY_SCOPE_AGENT); }
__device__ __forceinline__ unsigned xb_add(unsigned* p, unsigned v) { return __hip_atomic_fetch_add(p, v, __ATOMIC_RELAXED, __HIP_MEMORY_SCOPE_AGENT); }
__device__ __forceinline__ unsigned xb_xcc_id() { return (unsigned)__builtin_amdgcn_s_getreg((3 << 11) | 20) & 0xFu; }
#define XB_SPIN(cond, bar) do { unsigned _sp = 0; while (cond) { __builtin_amdgcn_s_sleep(1); \
    if ((++_sp & 255u) == 0u) { if (xb_ld(&(bar)[XB_TMO])) break; if (_sp > XB_SPIN_CAP) { atomicAdd(&(bar)[XB_TMO], 1u); break; } } } } while (0)

struct XcdBarrier {
    unsigned* bar; unsigned x;
    volatile LAS unsigned* st;
};

__device__ __forceinline__ XcdBarrier xcd_barrier_post(unsigned* bar, volatile LAS unsigned* st) {
    XcdBarrier b; b.bar = bar; b.x = xb_xcc_id(); b.st = st;
    if (threadIdx.x == 0) (void)xb_add(&bar[XB_XCNT(b.x)], 1u);
    return b;
}
__device__ __forceinline__ void xcd_barrier_complete(unsigned* bar, unsigned x, unsigned& nloc, unsigned& nx) {
    const unsigned G = gridDim.x * gridDim.y * gridDim.z;
    unsigned sum, cnt, mine, sp = 0u;
    for (;;) {
        sum = 0u; cnt = 0u; mine = 0u;
#pragma unroll
        for (unsigned j = 0; j < 16; ++j) { const unsigned c = xb_ld(&bar[XB_XCNT(j)]); sum += c; cnt += (c > 0u) ? 1u : 0u; mine = (j == x) ? c : mine; }
        if (sum == G) break;
        __builtin_amdgcn_s_sleep(1);
        if ((++sp & 255u) == 0u) { if (xb_ld(&bar[XB_TMO])) break; if (sp > XB_SPIN_CAP) { atomicAdd(&bar[XB_TMO], 1u); break; } }
    }
    nloc = mine > 0u ? mine : 1u; nx = cnt > 0u ? cnt : 1u;
}

__device__ __forceinline__ void xcd_barrier(const XcdBarrier& b) {
    asm volatile("s_waitcnt vmcnt(0)" ::: "memory");
    __syncthreads();
    if (threadIdx.x == 0) {
        unsigned* bar = b.bar;
        __builtin_amdgcn_s_waitcnt(0);
        unsigned nloc = b.st[0], nx = b.st[1];
        if (nloc == 0u) { xcd_barrier_complete(bar, b.x, nloc, nx); b.st[0] = nloc; b.st[1] = nx; }
        const unsigned old = xb_add(&bar[XB_XSUB(b.x)], 1u);
        const unsigned gen = old / nloc;
        if (old + 1u == (gen + 1u) * nloc) {
            __builtin_amdgcn_fence(__ATOMIC_RELEASE, "agent");
            asm volatile("s_waitcnt vmcnt(0)" ::: "memory");
            const unsigned og = xb_add(&bar[XB_TOP], 1u);
            const unsigned tg = og / nx;
            if (og + 1u == (tg + 1u) * nx) xb_add(&bar[XB_TOPGEN], 1u);
            else XB_SPIN(xb_ld(&bar[XB_TOPGEN]) == tg, bar);
            __builtin_amdgcn_fence(__ATOMIC_ACQUIRE, "agent");
            xb_add(&bar[XB_XGEN(b.x)], 1u);
            asm volatile("s_waitcnt vmcnt(0)" ::: "memory");
        } else {
            XB_SPIN(xb_ld(&bar[XB_XGEN(b.x)]) == gen, bar);
            __builtin_amdgcn_fence(__ATOMIC_ACQUIRE, "agent");
            asm volatile("s_waitcnt vmcnt(0)" ::: "memory");
        }
    }
    __syncthreads();
}

namespace pg8 {
#define PG8_LAS __attribute__((address_space(3)))
constexpr int BM = 256, BK = 64, HALF = 128, HTB = HALF * BK * 2, STAGE_BYTES = 8 * HTB, NXCD = 8, WGM = 8;
__host__ __device__ __forceinline__ int lds_byte(int r, int c) { const int st = (r >> 4) * 2 + (c >> 5), rr = r & 15, cc = c & 31, ob = rr * 64 + cc * 2; return st * 1024 + (ob ^ (((ob >> 9) & 1) << 5)); }
__host__ __device__ __forceinline__ void stage_rc(int b, int& R, int& C) { const int st = b / 1024, sb = b % 1024, swz = sb ^ (((sb >> 9) & 1) << 5); R = (st >> 1) * 16 + swz / 64; C = (st & 1) * 32 + (swz % 64) / 2; }
__host__ __device__ __forceinline__ int perm32(int rho) { const int n = rho >> 4, i = rho & 15; return 8 * (i >> 2) + 4 * n + (i & 3); }
typedef int v4i_t __attribute__((ext_vector_type(4)));
typedef int v8i_t __attribute__((ext_vector_type(8)));
struct Unit { int pm, pn; };
struct Gemm { const bf16_t* A; const bf16_t* Bt; int M, N, K; };
struct StaticOrder {
    int nM, nN, nwg, G, c;
    __host__ __device__ void init(int M, int N, int G_, int c_) { nM = M / BM; nN = N / BM; nwg = nM * nN; G = G_; c = c_; }
    __host__ __device__ bool next(int i, Unit& u) const {
        const long L = (long)i * G + c; if (L >= nwg) return false;
        int wgid = (int)L; { const int q = nwg / NXCD, r = nwg % NXCD, xcd = wgid % NXCD, off = wgid / NXCD; wgid = (xcd < r ? xcd * (q + 1) : r * (q + 1) + (xcd - r) * q) + off; }
        const int nig = WGM * nN, gid = wgid / nig, fm = gid * WGM, gsz = (nM - fm) < WGM ? (nM - fm) : WGM;
        u.pm = fm + ((wgid % nig) % gsz); u.pn = (wgid % nig) / gsz; return true;
    }
    __device__ __forceinline__ void a_ready(const Unit&) const {}
    __device__ __forceinline__ void done(const Unit&) const {}
};
template <int NU, int UPE, int PNE> struct GroupOrder {
    int G, c;
    __device__ __forceinline__ bool next(int i, Unit& u) const {
        const long L = (long)i * G + c; if (L >= NU) return false;
        const int w = ((int)L % NXCD) * (NU / NXCD) + (int)L / NXCD;
        const int e = w / UPE, v = w % UPE;
        u.pm = e * 8 + (v & 7); u.pn = e * PNE + (v >> 3); return true;
    }
    __device__ __forceinline__ void a_ready(const Unit&) const {}
    __device__ __forceinline__ void done(const Unit&) const {}
};
template <class Epi, class Sched, bool ALIGN_EPI = false, bool SP2 = false, bool F8 = false>
__device__ __forceinline__ void gemm_phase(PG8_LAS unsigned char* lds, const Gemm g, const Sched& S, const Epi& E) {
    const int tid = otid(), wid = __builtin_amdgcn_readfirstlane(tid >> 6), lane = tid & 63, wr = wid >> 2, wc = wid & 3, fr = lane & 15, fq = lane >> 4;
    const int K = g.K, nt = K / BK;
    unsigned laneA, uA[2], uB[2];
    { const int sb = lane * 16, swz = sb ^ (((sb >> 9) & 1) << 5), sR = swz / 64, sC = (swz % 64) / 2;
      laneA = (unsigned)(sR * K + sC) * 2u;
#pragma unroll
      for (int i = 0; i < 2; ++i) { const int st = wid + 8 * i;
          uA[i] = (unsigned)(((st >> 1) * 16) * K + (st & 1) * 32) * 2u;
          uB[i] = Epi::PERM ? (unsigned)(((st >> 2) * 32 + 4 * ((st >> 1) & 1)) * K + (st & 1) * 32) * 2u : uA[i]; } }
    const size_t kstep = (size_t)(BK * 2);
    const size_t hstep = (size_t)HALF * K * 2;
    const size_t tstep = 2 * hstep;
    const unsigned ldsw = (unsigned)wid * 1024u;
    const int aoff = lds_byte(wr * 64 + fr, fq * 8), boff = lds_byte(wc * 32 + fr, fq * 8);
#define PG8_SA(b, h) (((b) * 2 + (h)) * HTB)
#define PG8_SB(b, h) ((4 + (b) * 2 + (h)) * HTB)
#define voffA 0
#define voffB 1
#define PG8_STAGE(bufoff, gbase, voff) do { _Pragma("unroll") for (int _i = 0; _i < 2; ++_i) { \
        unsigned vo_ = laneA; asm volatile("" : "+v"(vo_)); if ((voff) == 1 && Epi::PERM) vo_ += (unsigned)((otid() >> 4) & 3) * (unsigned)(8 * K); const unsigned uo_ = ((voff) == 1 ? uB[_i] : uA[_i]); \
        __builtin_amdgcn_global_load_lds((const unsigned*)((const char*)(gbase) + uo_ + vo_), (PG8_LAS unsigned*)(lds + (bufoff) + ldsw + _i * 8192), 16, 0, 0); } } while (0)
#define PG8_LDA(dst, b, h) do { if constexpr (F8) { _Pragma("unroll") for (int m = 0; m < 4; ++m) dst##8[m] = __builtin_shufflevector(*(const PG8_LAS v4i_t*)(lds + PG8_SA(b, h) + aoff + m * 2048), *(const PG8_LAS v4i_t*)(lds + PG8_SA(b, h) + aoff + m * 2048 + 1024), 0, 1, 2, 3, 4, 5, 6, 7); } \
    else { _Pragma("unroll") for (int m = 0; m < 4; ++m) _Pragma("unroll") for (int k = 0; k < 2; ++k) dst[m][k] = *(const PG8_LAS bf16x8*)(lds + PG8_SA(b, h) + aoff + m * 2048 + k * 1024); } } while (0)
#define PG8_LDB(dst, b, h) do { if constexpr (F8) { _Pragma("unroll") for (int n = 0; n < 2; ++n) dst##8[n] = __builtin_shufflevector(*(const PG8_LAS v4i_t*)(lds + PG8_SB(b, h) + boff + n * 2048), *(const PG8_LAS v4i_t*)(lds + PG8_SB(b, h) + boff + n * 2048 + 1024), 0, 1, 2, 3, 4, 5, 6, 7); } \
    else { _Pragma("unroll") for (int n = 0; n < 2; ++n) _Pragma("unroll") for (int k = 0; k < 2; ++k) dst[n][k] = *(const PG8_LAS bf16x8*)(lds + PG8_SB(b, h) + boff + n * 2048 + k * 1024); } } while (0)
#define PG8_MMA(ai, bj, At, Bt) do { __builtin_amdgcn_s_setprio(1); _Pragma("unroll") for (int m = 0; m < 4; ++m) _Pragma("unroll") for (int n = 0; n < 2; ++n) { \
        if constexpr (F8) asm volatile("v_mfma_scale_f32_16x16x128_f8f6f4 %0, %1, %2, %0, %3, %3 op_sel_hi:[0,0,0]" : "+a"(acc[ai][bj][m][n]) : "v"(Bt##8[n]), "v"(At##8[m]), "v"(sc127)); \
        else { _Pragma("unroll") for (int k = 0; k < 2; ++k) asm volatile("v_mfma_f32_16x16x32_bf16 %0, %1, %2, %0" : "+a"(acc[ai][bj][m][n]) : "v"(Bt[n][k]), "v"(At[m][k])); } } \
        __builtin_amdgcn_s_setprio(0); } while (0)
#define PG8_WAIT_V(n) asm volatile("s_waitcnt vmcnt(" #n ")" ::: "memory")
#define PG8_WAIT_L(n) asm volatile("s_waitcnt lgkmcnt(" #n ")" ::: "memory")
#define PG8_BAR __builtin_amdgcn_s_barrier()
#define PG8_SCHED __builtin_amdgcn_sched_barrier(0)
    Unit cur, nxt; int ui = 0;
    if (!S.next(0, cur)) return;
    f32x4 acc[2][2][4][2];
#pragma unroll
    for (int a = 0; a < 2; ++a)
#pragma unroll
        for (int b = 0; b < 2; ++b)
#pragma unroll
            for (int m = 0; m < 4; ++m)
#pragma unroll
                for (int n = 0; n < 2; ++n) acc[a][b][m][n] = (f32x4){0.f, 0.f, 0.f, 0.f};
    bf16x8 At[4][2], B0[2][2], B1[2][2]; v8i_t At8[4], B08[2], B18[2]; const int sc127 = 0x7f7f7f7f;
    const char* cA = (const char*)g.A + (size_t)cur.pm * tstep; const char* cB = (const char*)g.Bt + (size_t)cur.pn * tstep;
    S.a_ready(cur);
    if constexpr (SP2) {
        PG8_STAGE(PG8_SB(0, 0), cB, voffB); PG8_STAGE(PG8_SB(0, 1), cB + hstep, voffB); PG8_STAGE(PG8_SA(0, 0), cA, voffA); PG8_STAGE(PG8_SA(0, 1), cA + hstep, voffA);
        if (wr == 1) PG8_BAR;
        PG8_WAIT_V(2); PG8_BAR;
        PG8_STAGE(PG8_SB(1, 0), cB + kstep, voffB); PG8_STAGE(PG8_SA(1, 0), cA + kstep, voffA); PG8_STAGE(PG8_SB(1, 1), cB + hstep + kstep, voffB);
        PG8_WAIT_V(6); PG8_BAR;
    } else {
        PG8_STAGE(PG8_SB(0, 0), cB, voffB); PG8_STAGE(PG8_SA(0, 0), cA, voffA); PG8_STAGE(PG8_SB(0, 1), cB + hstep, voffB); PG8_STAGE(PG8_SA(0, 1), cA + hstep, voffA);
        if (wr == 1) PG8_BAR;
        PG8_WAIT_V(4); PG8_BAR;
        PG8_STAGE(PG8_SB(1, 0), cB + kstep, voffB); PG8_STAGE(PG8_SA(1, 0), cA + kstep, voffA); PG8_STAGE(PG8_SB(1, 1), cB + hstep + kstep, voffB);
        PG8_WAIT_V(6); PG8_BAR;
    }
    for (;;) {
        const bool has_next = S.next(ui + 1, nxt);
        const char* nA = has_next ? (const char*)g.A + (size_t)nxt.pm * tstep : cA; const char* nB = has_next ? (const char*)g.Bt + (size_t)nxt.pn * tstep : cB;
#pragma nounroll
        for (int t = 0; t < nt; t += 2) {
            const bool last = (t == nt - 2);
            const char* a1 = cA + (size_t)(t + 1) * kstep;
            const char* a2 = last ? nA : cA + (size_t)(t + 2) * kstep; const char* b2 = last ? nB : cB + (size_t)(t + 2) * kstep;
            const char* a3 = a2 + kstep; const char* b3 = b2 + kstep;
            if (last && has_next) S.a_ready(nxt);
            if constexpr (SP2) {
            PG8_LDB(B0, 0, 0); PG8_LDB(B1, 0, 1); PG8_SCHED; PG8_LDA(At, 0, 0); PG8_STAGE(PG8_SA(1, 1), a1 + hstep, voffA);
            PG8_WAIT_V(8); PG8_WAIT_L(0); PG8_BAR; PG8_MMA(0, 0, At, B0); PG8_MMA(0, 1, At, B1); PG8_BAR; PG8_SCHED;
            PG8_LDA(At, 0, 1); PG8_STAGE(PG8_SB(0, 0), b2, voffB); PG8_STAGE(PG8_SB(0, 1), b2 + hstep, voffB); PG8_STAGE(PG8_SA(0, 0), a2, voffA);
            PG8_WAIT_V(8); PG8_WAIT_L(0); PG8_BAR; PG8_MMA(1, 0, At, B0); PG8_MMA(1, 1, At, B1); PG8_BAR; PG8_SCHED;
            PG8_LDB(B0, 1, 0); PG8_LDB(B1, 1, 1); PG8_SCHED; PG8_LDA(At, 1, 0); PG8_STAGE(PG8_SA(0, 1), a2 + hstep, voffA);
            PG8_WAIT_V(8); PG8_WAIT_L(0); PG8_BAR; PG8_MMA(0, 0, At, B0); PG8_MMA(0, 1, At, B1); PG8_BAR; PG8_SCHED;
            PG8_LDA(At, 1, 1); PG8_STAGE(PG8_SB(1, 0), b3, voffB); PG8_STAGE(PG8_SB(1, 1), b3 + hstep, voffB); PG8_STAGE(PG8_SA(1, 0), a3, voffA);
            PG8_WAIT_V(8); PG8_WAIT_L(0); PG8_BAR; PG8_MMA(1, 0, At, B0); PG8_MMA(1, 1, At, B1); PG8_BAR; PG8_SCHED;
            } else {
            PG8_LDB(B0, 0, 0); PG8_SCHED; PG8_LDA(At, 0, 0); PG8_STAGE(PG8_SA(1, 1), a1 + hstep, voffA);
            PG8_WAIT_L(8); PG8_BAR; PG8_WAIT_L(0); PG8_MMA(0, 0, At, B0); PG8_BAR; PG8_SCHED;
            PG8_LDB(B1, 0, 1); PG8_STAGE(PG8_SB(0, 0), b2, voffB);
            PG8_BAR; PG8_WAIT_L(0); PG8_MMA(0, 1, At, B1); PG8_BAR;
            PG8_LDA(At, 0, 1); PG8_STAGE(PG8_SA(0, 0), a2, voffA);
            PG8_BAR; PG8_WAIT_L(0); PG8_MMA(1, 0, At, B0); PG8_BAR; PG8_SCHED;
            PG8_STAGE(PG8_SB(0, 1), b2 + hstep, voffB);
            PG8_WAIT_V(6); PG8_BAR; PG8_MMA(1, 1, At, B1); PG8_BAR;
            PG8_LDB(B0, 1, 0); PG8_SCHED; PG8_LDA(At, 1, 0); PG8_STAGE(PG8_SA(0, 1), a2 + hstep, voffA);
            PG8_WAIT_L(8); PG8_BAR; PG8_WAIT_L(0); PG8_MMA(0, 0, At, B0); PG8_BAR; PG8_SCHED;
            PG8_LDB(B1, 1, 1); PG8_STAGE(PG8_SB(1, 0), b3, voffB);
            PG8_BAR; PG8_WAIT_L(0); PG8_MMA(0, 1, At, B1); PG8_BAR;
            PG8_LDA(At, 1, 1); PG8_STAGE(PG8_SA(1, 0), a3, voffA);
            PG8_BAR; PG8_WAIT_L(0); PG8_MMA(1, 0, At, B0); PG8_BAR; PG8_SCHED;
            PG8_STAGE(PG8_SB(1, 1), b3 + hstep, voffB);
            PG8_WAIT_V(6); PG8_BAR; PG8_MMA(1, 1, At, B1); PG8_BAR;
            }
        }
        asm volatile("s_nop 15\n\ts_nop 15" ::: "memory");
        if constexpr (ALIGN_EPI) { if (wr == 0) PG8_BAR; }
        if constexpr (!Epi::AFTER_DRAIN) { const int t2_ = otid(); int fr_ = t2_ & 15, fq_ = (t2_ >> 4) & 3, wr_ = wr, wc_ = wc; asm volatile("" : "+s"(wr_), "+s"(wc_)); E(acc, cur, wr_, wc_, fr_, fq_); S.done(cur); }
        if (!has_next) break;
#pragma unroll
        for (int a = 0; a < 2; ++a)
#pragma unroll
            for (int b = 0; b < 2; ++b)
#pragma unroll
                for (int m = 0; m < 4; ++m)
#pragma unroll
                    for (int n = 0; n < 2; ++n) acc[a][b][m][n] = (f32x4){0.f, 0.f, 0.f, 0.f};
        cur = nxt; cA = nA; cB = nB; ++ui;
        if constexpr (ALIGN_EPI) { if (wr == 1) PG8_BAR; }
    }
    PG8_WAIT_V(0);
    if constexpr (!ALIGN_EPI) { if (wr == 0) PG8_BAR; }
    PG8_BAR;
    if constexpr (Epi::AFTER_DRAIN) { E.fused(acc, cur, wr, wc, fr, fq, lds, wid, lane); S.done(cur); }
#undef PG8_SA
#undef PG8_SB
#undef PG8_STAGE
#undef voffA
#undef voffB
#undef PG8_LDA
#undef PG8_LDB
#undef PG8_MMA
#undef PG8_WAIT_V
#undef PG8_WAIT_L
#undef PG8_BAR
#undef PG8_SCHED
}
}
using pg8::Unit;
struct EpiIn {
    static constexpr bool PERM = true, AFTER_DRAIN = false;
    bf16_t *Q, *Kb, *Vb, *XR, *XGb; float *outK, *outV; const float* rope;
    __device__ __forceinline__ void operator()(const f32x4 (&acc)[2][2][4][2], const Unit& u, int wr, int wc, int fr, int fq) const {
        const int pn = u.pn; const bool sample = u.pm >= 32;
        bf16_t* dbase; int dstride;
        if (pn <= 1) { dbase = Q + pn * 256; dstride = 512; }
        else if (pn == 2) { dbase = Kb; dstride = 256; }
        else if (pn == 3) { dbase = Vb; dstride = 256; }
        else if (pn <= 5) { dbase = XR + (pn - 4) * 256; dstride = 512; }
        else { dbase = XGb + (pn - 6) * 256; dstride = 512; }
        const bool dorope = sample && pn <= 2;
        float* fout = (!sample && (pn == 2 || pn == 3)) ? (pn == 2 ? outK : outV) : nullptr;
        const int rbase = u.pm * 256 + wr * 64 + fr;
        const float* tcol = rope + ((wc & 1) * 16 + fq * 4) * 2;
#define EPIIN_LD(it_, d0_, d1_) do { const int row_ = rbase + ((it_) >> 2) * 128 + ((it_) & 3) * 16, pos_ = (row_ - NPR) & 2047; \
            const int trow_ = dorope ? ((wc < 2) ? (pos_ >> 6) : (32 + (pos_ & 63))) : 96; const float* tp_ = tcol + (size_t)trow_ * 64; d0_ = *(const f32x4*)tp_; d1_ = *(const f32x4*)(tp_ + 4); } while (0)
        f32x4 cs[2][2];
        EPIIN_LD(0, cs[0][0], cs[0][1]);
#pragma unroll
        for (int it = 0; it < 8; ++it) {
            const int ai = it >> 2, m = it & 3, row = rbase + ai * 128 + m * 16;
            if (it < 7) EPIIN_LD(it + 1, cs[(it + 1) & 1][0], cs[(it + 1) & 1][1]);
            __builtin_amdgcn_sched_barrier(0);
            const f32x4 cs0 = cs[it & 1][0], cs1 = cs[it & 1][1];
#pragma unroll
            for (int bj = 0; bj < 2; ++bj) {
                const f32x4 v0 = acc[ai][bj][m][0], v1 = acc[ai][bj][m][1];
                const int ct = bj * 128 + wc * 32 + fq * 8;
                f32x4 r0, r1;
                r0.x = v0.x * cs0.x - v0.y * cs0.y; r0.y = v0.x * cs0.y + v0.y * cs0.x;
                r0.z = v0.z * cs0.z - v0.w * cs0.w; r0.w = v0.z * cs0.w + v0.w * cs0.z;
                r1.x = v1.x * cs1.x - v1.y * cs1.y; r1.y = v1.x * cs1.y + v1.y * cs1.x;
                r1.z = v1.z * cs1.z - v1.w * cs1.w; r1.w = v1.z * cs1.w + v1.w * cs1.z;
                u32x4 o; o.x = cvt_pk_bf16(r0.x, r0.y); o.y = cvt_pk_bf16(r0.z, r0.w); o.z = cvt_pk_bf16(r1.x, r1.y); o.w = cvt_pk_bf16(r1.z, r1.w);
                *(u32x4*)(dbase + (size_t)row * dstride + ct) = o;
                if (fout) { float* op = fout + (size_t)row * 256 + ct; *(f32x4*)op = r0; *(f32x4*)(op + 4) = r1; }
            }
        }
#undef EPIIN_LD
    }
};
template <bool XB16> struct EpiOut {
    static constexpr bool PERM = false, AFTER_DRAIN = false;
    const float *xin_p, *xin_s; bf16_t* XA; const float* modl;
    __device__ __forceinline__ void operator()(const f32x4 (&acc)[2][2][4][2], const Unit& u, int wr, int wc, int fr, int fq) const {
        const int rbase = u.pm * 256 + wr * 64 + fr, cbase = u.pn * 256 + wc * 32 + fq * 4;
        const float* gp = modl + (size_t)cond_of(u.pm * 256) * 6144 + 2 * 1024 + cbase;
        const float* xb = (u.pm < 32 ? xin_p + (size_t)rbase * DM : xin_s + (size_t)(rbase - NPR) * DM) + cbase;
        const bf16_t* xh = XA + (size_t)rbase * DM + cbase;
        f32x4 gv[2][2];
#pragma unroll
        for (int bj = 0; bj < 2; ++bj)
#pragma unroll
            for (int n = 0; n < 2; ++n) gv[bj][n] = *(const f32x4*)(gp + bj * 128 + n * 16);
#define EPIOUT_LD(it_, d_) do { const size_t ro_ = (size_t)(((it_) >> 2) * 128 + ((it_) & 3) * 16) * DM; \
            if constexpr (XB16) { const bf16_t* xr_ = xh + ro_; const u32x2 w0_ = *(const u32x2*)(xr_), w1_ = *(const u32x2*)(xr_ + 16), w2_ = *(const u32x2*)(xr_ + 128), w3_ = *(const u32x2*)(xr_ + 144); \
                d_[0] = (f32x4){bflo(w0_.x), bfhi(w0_.x), bflo(w0_.y), bfhi(w0_.y)}; d_[1] = (f32x4){bflo(w1_.x), bfhi(w1_.x), bflo(w1_.y), bfhi(w1_.y)}; \
                d_[2] = (f32x4){bflo(w2_.x), bfhi(w2_.x), bflo(w2_.y), bfhi(w2_.y)}; d_[3] = (f32x4){bflo(w3_.x), bfhi(w3_.x), bflo(w3_.y), bfhi(w3_.y)}; } \
            else { const float* xr_ = xb + ro_; d_[0] = *(const f32x4*)(xr_); d_[1] = *(const f32x4*)(xr_ + 16); d_[2] = *(const f32x4*)(xr_ + 128); d_[3] = *(const f32x4*)(xr_ + 144); } } while (0)
        f32x4 xv[2][4];
        EPIOUT_LD(0, xv[0]);
#pragma unroll
        for (int it = 0; it < 8; ++it) {
            const int ai = it >> 2, m = it & 3, row = rbase + ai * 128 + m * 16;
            if (it < 7) EPIOUT_LD(it + 1, xv[(it + 1) & 1]);
            __builtin_amdgcn_sched_barrier(0);
#pragma unroll
            for (int bj = 0; bj < 2; ++bj)
#pragma unroll
                for (int n = 0; n < 2; ++n) {
                    const f32x4 y = xv[it & 1][bj * 2 + n] * ALPHA_C + gv[bj][n] * acc[ai][bj][m][n];
                    u32x2 o; o.x = cvt_pk_bf16(y.x, y.y); o.y = cvt_pk_bf16(y.z, y.w);
                    *(u32x2*)(XA + (size_t)row * DM + cbase + bj * 128 + n * 16) = o;
                }
        }
#undef EPIOUT_LD
    }
};
__device__ __forceinline__ unsigned pk4_fp8(float a, float b, float c, float d) { unsigned w = 0u; asm volatile("v_cvt_pk_fp8_f32 %0, %1, %2" : "+v"(w) : "v"(a), "v"(b)); asm volatile("v_cvt_pk_fp8_f32 %0, %1, %2 op_sel:[0,0,1]" : "+v"(w) : "v"(c), "v"(d)); return w; }
constexpr float W13_SCALE = 32.f, W2_SCALE = 64.f;
struct EpiUp {
    static constexpr bool PERM = true, AFTER_DRAIN = false;
    unsigned char* Hid;
    __device__ __forceinline__ void operator()(const f32x4 (&acc)[2][2][4][2], const Unit& u, int wr, int wc, int fr, int fq) const {
        const int pnl = u.pn & 15; constexpr float ds = 1.f / W13_SCALE;
#pragma unroll
        for (int ai = 0; ai < 2; ++ai)
#pragma unroll
            for (int m = 0; m < 4; ++m) {
                const int row = u.pm * 256 + ai * 128 + wr * 64 + m * 16 + fr;
                __builtin_amdgcn_sched_barrier(0);
                const f32x4 a0 = acc[ai][0][m][0] * ds, a1 = acc[ai][0][m][1] * ds, b0 = acc[ai][1][m][0] * ds, b1 = acc[ai][1][m][1] * ds;
                u32x2 o;
                o.x = pk4_fp8(siluf_(a0.x) * b0.x, siluf_(a0.y) * b0.y, siluf_(a0.z) * b0.z, siluf_(a0.w) * b0.w);
                o.y = pk4_fp8(siluf_(a1.x) * b1.x, siluf_(a1.y) * b1.y, siluf_(a1.z) * b1.z, siluf_(a1.w) * b1.w);
                *(u32x2*)(Hid + (size_t)row * 2048 + pnl * 128 + wc * 32 + fq * 8) = o;
            }
    }
};
struct EpiDn {
    static constexpr bool PERM = true, AFTER_DRAIN = false;
    bf16_t* Y; const float* gate;
    __device__ __forceinline__ void operator()(const f32x4 (&acc)[2][2][4][2], const Unit& u, int wr, int wc, int fr, int fq) const {
        const int pnl = u.pn & 3, rbase = u.pm * 256 + wr * 64 + fr;
        float gg[8];
#pragma unroll
        for (int it = 0; it < 8; ++it) gg[it] = gate[rbase + (it >> 2) * 128 + (it & 3) * 16] * (1.f / W2_SCALE);
#pragma unroll
        for (int it = 0; it < 8; ++it) {
            const int ai = it >> 2, m = it & 3, row = rbase + ai * 128 + m * 16;
            __builtin_amdgcn_sched_barrier(0);
            const float g = gg[it];
#pragma unroll
            for (int bj = 0; bj < 2; ++bj) {
                const f32x4 v0 = acc[ai][bj][m][0] * g, v1 = acc[ai][bj][m][1] * g;
                u32x4 o; o.x = cvt_pk_bf16(v0.x, v0.y); o.y = cvt_pk_bf16(v0.z, v0.w); o.z = cvt_pk_bf16(v1.x, v1.y); o.w = cvt_pk_bf16(v1.z, v1.w);
                *(u32x4*)(Y + (size_t)row * DM + pnl * 256 + bj * 128 + wc * 32 + fq * 8) = o;
            }
        }
    }
};
struct EpiSgu {
    static constexpr bool PERM = true, AFTER_DRAIN = false;
    bf16_t *U, *V2; float* vstat; const float* bias;
    __device__ __forceinline__ void operator()(const f32x4 (&acc)[2][2][4][2], const Unit& u, int wr, int wc, int fr, int fq) const {
        const int pn = u.pn; const bool isv = pn >= 4;
        bf16_t* dbase = (isv ? V2 : U) + (pn & 3) * 256;
        f32x4 bvv[2][2];
#pragma unroll
        for (int bj = 0; bj < 2; ++bj) { const float* bp = bias + pn * 256 + bj * 128 + wc * 32 + fq * 8; bvv[bj][0] = *(const f32x4*)bp; bvv[bj][1] = *(const f32x4*)(bp + 4); }
#pragma unroll
        for (int ai = 0; ai < 2; ++ai)
#pragma unroll
            for (int m = 0; m < 4; ++m) {
                const int row = u.pm * 256 + ai * 128 + wr * 64 + m * 16 + fr;
                __builtin_amdgcn_sched_barrier(0);
                float s1 = 0.f, s2 = 0.f;
#pragma unroll
                for (int bj = 0; bj < 2; ++bj) {
                    const int ct = bj * 128 + wc * 32 + fq * 8, c = pn * 256 + ct;
                    f32x4 v0 = acc[ai][bj][m][0] + bvv[bj][0], v1 = acc[ai][bj][m][1] + bvv[bj][1];
                    v0.x = geluf_(v0.x); v0.y = geluf_(v0.y); v0.z = geluf_(v0.z); v0.w = geluf_(v0.w);
                    v1.x = geluf_(v1.x); v1.y = geluf_(v1.y); v1.z = geluf_(v1.z); v1.w = geluf_(v1.w);
                    u32x4 o; o.x = cvt_pk_bf16(v0.x, v0.y); o.y = cvt_pk_bf16(v0.z, v0.w); o.z = cvt_pk_bf16(v1.x, v1.y); o.w = cvt_pk_bf16(v1.z, v1.w);
                    *(u32x4*)(dbase + (size_t)row * DM + ct) = o;
                    s1 += (v0.x + v0.y) + (v0.z + v0.w) + (v1.x + v1.y) + (v1.z + v1.w);
                    s2 += (v0.x * v0.x + v0.y * v0.y) + (v0.z * v0.z + v0.w * v0.w) + (v1.x * v1.x + v1.y * v1.y) + (v1.z * v1.z + v1.w * v1.w);
                }
                { const int ln = fq * 16 + fr, i16 = (ln ^ 16) << 2, i32 = (ln ^ 32) << 2;
                  s1 += __builtin_bit_cast(float, __builtin_amdgcn_ds_bpermute(i16, __builtin_bit_cast(int, s1))); s2 += __builtin_bit_cast(float, __builtin_amdgcn_ds_bpermute(i16, __builtin_bit_cast(int, s2)));
                  s1 += __builtin_bit_cast(float, __builtin_amdgcn_ds_bpermute(i32, __builtin_bit_cast(int, s1))); s2 += __builtin_bit_cast(float, __builtin_amdgcn_ds_bpermute(i32, __builtin_bit_cast(int, s2))); }
                if (isv && fq == 0) { f32x2 st; st.x = s1; st.y = s2; *(f32x2*)(vstat + ((size_t)row * 16 + (pn - 4) * 4 + wc) * 2) = st; }
            }
    }
};
__device__ __forceinline__ void tr_item(const float* __restrict__ src, int N, bf16_t* dst, int Kd, int k0, int n0, int drow0, LAS float* scr, int lane) {
    f32x4 v[16];
    const float* s = src + (size_t)(k0 + (lane >> 4)) * N + n0 + (lane & 15) * 4;
#pragma unroll
    for (int i = 0; i < 16; ++i) v[i] = __builtin_nontemporal_load((const f32x4*)(s + (size_t)i * 4 * N));
#pragma unroll
    for (int i = 0; i < 16; ++i) { LAS float* d = scr + (i * 4 + (lane >> 4)) * 65 + (lane & 15) * 4; d[0] = v[i].x; d[1] = v[i].y; d[2] = v[i].z; d[3] = v[i].w; }
    LDS_WAIT(); __builtin_amdgcn_wave_barrier();
    const int c = lane & 7;
#pragma unroll
    for (int j = 0; j < 8; ++j) {
        const int n = (lane >> 3) + 8 * j; const LAS float* r = scr + (8 * c) * 65 + n;
        u32x4 o; o.x = cvt_pk_bf16(r[0], r[65]); o.y = cvt_pk_bf16(r[2 * 65], r[3 * 65]); o.z = cvt_pk_bf16(r[4 * 65], r[5 * 65]); o.w = cvt_pk_bf16(r[6 * 65], r[7 * 65]);
        *(u32x4*)(dst + (size_t)(drow0 + n) * Kd + k0 + 8 * c) = o;
    }
    LDS_WAIT(); __builtin_amdgcn_wave_barrier();
}
__device__ __forceinline__ void tr_item8(const float* __restrict__ src, int N, unsigned char* dst, int Kd, int k0, int n0, int drow0, float sc, LAS float* scr, int lane) {
    f32x4 v[16];
    const float* s = src + (size_t)(k0 + (lane >> 4)) * N + n0 + (lane & 15) * 4;
#pragma unroll
    for (int i = 0; i < 16; ++i) v[i] = *(const f32x4*)(s + (size_t)i * 4 * N);
#pragma unroll
    for (int i = 0; i < 16; ++i) { LAS float* d = scr + (i * 4 + (lane >> 4)) * 65 + (lane & 15) * 4; d[0] = v[i].x * sc; d[1] = v[i].y * sc; d[2] = v[i].z * sc; d[3] = v[i].w * sc; }
    LDS_WAIT(); __builtin_amdgcn_wave_barrier();
    const int c = lane & 3;
#pragma unroll
    for (int j = 0; j < 4; ++j) {
        const int n = (lane >> 2) + 16 * j; const LAS float* r = scr + (16 * c) * 65 + n;
        u32x4 o; o.x = pk4_fp8(r[0], r[65], r[2 * 65], r[3 * 65]); o.y = pk4_fp8(r[4 * 65], r[5 * 65], r[6 * 65], r[7 * 65]);
        o.z = pk4_fp8(r[8 * 65], r[9 * 65], r[10 * 65], r[11 * 65]); o.w = pk4_fp8(r[12 * 65], r[13 * 65], r[14 * 65], r[15 * 65]);
        *(u32x4*)(dst + (size_t)(drow0 + n) * Kd + k0 + 16 * c) = o;
    }
    LDS_WAIT(); __builtin_amdgcn_wave_barrier();
}
__device__ __forceinline__ void cvt_item512(const float* __restrict__ src, bf16_t* dst, int item, int lane) {
    const size_t i = (size_t)item * 512 + lane * 8;
    const f32x4 a = __builtin_nontemporal_load((const f32x4*)(src + i)), b = __builtin_nontemporal_load((const f32x4*)(src + i + 4));
    u32x4 o; o.x = cvt_pk_bf16(a.x, a.y); o.y = cvt_pk_bf16(a.z, a.w); o.z = cvt_pk_bf16(b.x, b.y); o.w = cvt_pk_bf16(b.z, b.w);
    *(u32x4*)(dst + i) = o;
}
struct MoeItem { const float* s; size_t rowstep; unsigned char* dst; int Kd; float sc; };
__device__ __forceinline__ MoeItem moe_item(const Params& p, int r, int lane) {
    MoeItem m; unsigned char* ws = p.ws;
    if (r < 32768) {
        const int w3 = r >= 16384; const int q = w3 ? r - 16384 : r;
        const int mat = q >> 9, rr = q & 511, n0 = (rr & 31) * 64, k0 = (rr >> 5) * 64;
        m.s = p.in[w3 ? I_W3 : I_W1] + (size_t)mat * 1024 * 2048 + (size_t)(k0 + (lane >> 4)) * 2048 + n0 + (lane & 15) * 4; m.rowstep = (size_t)4 * 2048;
        m.dst = ws + WS_BTUP + (size_t)mat * 4096 * 1024 + (size_t)((n0 >> 7) * 256 + (n0 & 127) + w3 * 128) * 1024 + k0; m.Kd = 1024; m.sc = W13_SCALE;
    } else {
        const int q = r - 32768, mat = q >> 9, rr = q & 511, n0 = (rr & 15) * 64, k0 = (rr >> 4) * 64;
        m.s = p.in[I_W2] + (size_t)mat * 2048 * 1024 + (size_t)(k0 + (lane >> 4)) * 1024 + n0 + (lane & 15) * 4; m.rowstep = (size_t)4 * 1024;
        m.dst = ws + WS_BTDN + (size_t)mat * 1024 * 2048 + (size_t)n0 * 2048 + k0; m.Kd = 2048; m.sc = W2_SCALE;
    }
    return m;
}
__device__ __forceinline__ void phase_p0(const Params& p, LAS unsigned char* lds) {
    const int tid = otid(), lane = tid & 63, wave = tid >> 6;
    LAS float* scr = (LAS float*)(lds + wave * 16640);
    unsigned char* ws = p.ws;
    const int gw = blockIdx.x * 8 + wave, NGW = gridDim.x * 8;
    constexpr int N_MOD = 1536, N_ABIN = 512, N_ABOUT = 256, N_SGIN = 512, N_SGOUT = 256, N_GW = 32, N_CVT = 512, N_CK = 512, N_SPW = 256, N_ROPE = 49, N_SP = 16;
    constexpr int TOTAL = N_MOD + N_ABIN + N_ABOUT + N_SGIN + N_SGOUT + N_GW + N_CVT + N_CK + N_SPW + N_ROPE + N_SP;
    for (int it = gw; it < TOTAL; it += NGW) {
        int r = it;
        if (r < N_MOD) {
            const int l = r / 768, rem = r % 768, cgp = rem >> 3, kp = rem & 7, n = cgp * 64 + lane;
            const float* w = p.in[I_MODW] + ((size_t)l * 1024 + 128 * kp) * 6144 + n;
            const float* cc = p.in[I_C]; const float* cx = p.in[I_CCTX];
            const int ka = 128 * kp + lane;
            const float s0a = siluf_(cx[ka]), s0b = siluf_(cx[ka + 64]), s1a = siluf_(cc[ka]), s1b = siluf_(cc[ka + 64]), s2a = siluf_(cc[1024 + ka]), s2b = siluf_(cc[1024 + ka + 64]);
            const float s3a = siluf_(cc[2048 + ka]), s3b = siluf_(cc[2048 + ka + 64]), s4a = siluf_(cc[3072 + ka]), s4b = siluf_(cc[3072 + ka + 64]);
            float a0 = 0.f, a1 = 0.f, a2 = 0.f, a3 = 0.f, a4 = 0.f;
#pragma unroll 8
            for (int k = 0; k < 64; ++k) {
                const float wa = w[(size_t)k * 6144], wb = w[(size_t)(k + 64) * 6144];
                a0 += __builtin_bit_cast(float, __builtin_amdgcn_readlane(__builtin_bit_cast(int, s0a), k)) * wa + __builtin_bit_cast(float, __builtin_amdgcn_readlane(__builtin_bit_cast(int, s0b), k)) * wb;
                a1 += __builtin_bit_cast(float, __builtin_amdgcn_readlane(__builtin_bit_cast(int, s1a), k)) * wa + __builtin_bit_cast(float, __builtin_amdgcn_readlane(__builtin_bit_cast(int, s1b), k)) * wb;
                a2 += __builtin_bit_cast(float, __builtin_amdgcn_readlane(__builtin_bit_cast(int, s2a), k)) * wa + __builtin_bit_cast(float, __builtin_amdgcn_readlane(__builtin_bit_cast(int, s2b), k)) * wb;
                a3 += __builtin_bit_cast(float, __builtin_amdgcn_readlane(__builtin_bit_cast(int, s3a), k)) * wa + __builtin_bit_cast(float, __builtin_amdgcn_readlane(__builtin_bit_cast(int, s3b), k)) * wb;
                a4 += __builtin_bit_cast(float, __builtin_amdgcn_readlane(__builtin_bit_cast(int, s4a), k)) * wa + __builtin_bit_cast(float, __builtin_amdgcn_readlane(__builtin_bit_cast(int, s4b), k)) * wb;
            }
            float* mp = (float*)(ws + WS_MODP) + (size_t)(kp * 2 + l) * 30720 + n;
            mp[0] = a0; mp[6144] = a1; mp[2 * 6144] = a2; mp[3 * 6144] = a3; mp[4 * 6144] = a4;
            continue;
        }
        r -= N_MOD;
        if (r < N_ABIN) { tr_item(p.in[I_ABIN], 2048, (bf16_t*)(ws + WS_ABIN), 1024, (r >> 5) * 64, (r & 31) * 64, (r & 31) * 64, scr, lane); continue; } r -= N_ABIN;
        if (r < N_ABOUT) { tr_item(p.in[I_ABOUT], 1024, (bf16_t*)(ws + WS_ABOUT), 1024, (r >> 4) * 64, (r & 15) * 64, (r & 15) * 64, scr, lane); continue; } r -= N_ABOUT;
        if (r < N_SGIN) { tr_item(p.in[I_SGIN], 2048, (bf16_t*)(ws + WS_SGIN), 1024, (r >> 5) * 64, (r & 31) * 64, (r & 31) * 64, scr, lane); continue; } r -= N_SGIN;
        if (r < N_SGOUT) { tr_item(p.in[I_SGOUT], 1024, (bf16_t*)(ws + WS_SGOUT), 1024, (r >> 4) * 64, (r & 15) * 64, (r & 15) * 64, scr, lane); continue; } r -= N_SGOUT;
        if (r < N_GW) {
            const int gate = r >> 4, rest = r & 15, dir = rest >> 3, blk = rest & 7;
            tr_item(p.in[gate ? I_WX : I_WA] + (size_t)(dir * 8 + blk) * 4096, 64, (bf16_t*)(ws + WS_GW) + (size_t)((dir * 2 + gate) * 8 + blk) * 4096, 64, 0, 0, 0, scr, lane);
            continue;
        }
        r -= N_GW;
        if (r < N_CVT) { cvt_item512(p.in[I_CV], (bf16_t*)(ws + WS_CV), r, lane); continue; } r -= N_CVT;
        if (r < N_CK) { cvt_item512(p.in[I_CK], (bf16_t*)(ws + WS_CK), r, lane); continue; } r -= N_CK;
        if (r < N_SPW) { cvt_item512(p.in[I_SPW], (bf16_t*)(ws + WS_SPW), r, lane); continue; } r -= N_SPW;
        if (r >= N_ROPE) { const int i = (r - N_ROPE) * 64 + lane; ((float*)(ws + WS_SP))[i] = log1pf(__expf(-p.in[I_LAM][i])); continue; }
        {
            const int idx = r * 64 + lane, pos = idx >> 5, f = idx & 31, pp = pos < 32 ? pos : pos - 32;
            double fr_ = 1.0; for (int i = 0; i < f; ++i) fr_ *= 0.74989420933245582;
            double ang = (double)pp * fr_;
            const double k = __builtin_rint(ang * 0.15915494309189535);
            double x = ang - k * 6.283185307179586; const double x2 = x * x;
            double sn = x, cs = 1.0, ts = x, tc = 1.0;
#pragma unroll
            for (int i = 1; i <= 14; ++i) { tc *= -x2 / (double)((2 * i - 1) * (2 * i)); cs += tc; ts *= -x2 / (double)((2 * i) * (2 * i + 1)); sn += ts; }
            f32x2 o; o.x = (float)cs; o.y = (float)sn;
            if (pos >= 96) { o.x = 1.f; o.y = 0.f; }
            if (idx < 97 * 32) *(f32x2*)((float*)(ws + WS_ROPE) + (size_t)idx * 2) = o;
        }
    }
    constexpr int NMOE = 49152;
    f32x4 va[16], vb[16];
    MoeItem ca, cb;
#define MOE_LOAD(V, C, IT) do { C = moe_item(p, (IT), lane); _Pragma("unroll") for (int i = 0; i < 16; ++i) V[i] = __builtin_nontemporal_load((const f32x4*)(C.s + (size_t)i * C.rowstep)); } while (0)
#define MOE_PROC(V, C, NXT) do { const float sc = C.sc; \
        _Pragma("unroll") for (int i = 0; i < 16; ++i) { LAS float* d = scr + (i * 4 + (lane >> 4)) * 65 + (lane & 15) * 4; d[0] = V[i].x * sc; d[1] = V[i].y * sc; d[2] = V[i].z * sc; d[3] = V[i].w * sc; } \
        unsigned char* cdst = C.dst; const int cKd = C.Kd; \
        if ((NXT) < NMOE) MOE_LOAD(V, C, (NXT)); \
        LDS_WAIT(); __builtin_amdgcn_wave_barrier(); \
        const int c = lane & 3; \
        _Pragma("unroll") for (int j = 0; j < 4; ++j) { const int n = (lane >> 2) + 16 * j; const LAS float* r = scr + (16 * c) * 65 + n; \
            u32x4 o; o.x = pk4_fp8(r[0], r[65], r[2 * 65], r[3 * 65]); o.y = pk4_fp8(r[4 * 65], r[5 * 65], r[6 * 65], r[7 * 65]); \
            o.z = pk4_fp8(r[8 * 65], r[9 * 65], r[10 * 65], r[11 * 65]); o.w = pk4_fp8(r[12 * 65], r[13 * 65], r[14 * 65], r[15 * 65]); \
            __builtin_nontemporal_store(o, (u32x4*)(cdst + (size_t)n * cKd + 16 * c)); } \
        LDS_WAIT(); __builtin_amdgcn_wave_barrier(); } while (0)
    if (gw < NMOE) MOE_LOAD(va, ca, gw);
    if (gw + NGW < NMOE) MOE_LOAD(vb, cb, gw + NGW);
    for (int it = gw; it < NMOE; it += 2 * NGW) {
        MOE_PROC(va, ca, it + 2 * NGW);
        if (it + NGW < NMOE) MOE_PROC(vb, cb, it + 3 * NGW);
    }
#undef MOE_LOAD
#undef MOE_PROC
}
__device__ __forceinline__ void phase_p0b(const Params& p) {
    const int tid = otid(); unsigned char* ws = p.ws;
    const float* modp = (const float*)(ws + WS_MODP);
    float* mod = (float*)(ws + WS_MOD);
    for (int i = blockIdx.x * 512 + tid; i < 61440; i += gridDim.x * 512) {
        const int l = i / 30720, rem = i % 30720;
        float s = p.in[I_MODB][l * 6144 + rem % 6144];
#pragma unroll
        for (int kp = 0; kp < 8; ++kp) s += modp[(size_t)(kp * 2 + l) * 30720 + rem];
        mod[i] = s;
    }
    bf16_t* H = (bf16_t*)(ws + WS_H);
    const int c4 = (tid & 255) * 4, rs = tid >> 8;
    for (int tile = blockIdx.x; tile < 256; tile += gridDim.x) {
        const int row0 = tile * 64, cond = cond_of(row0);
        f32x4 sh = *(const f32x4*)(p.in[I_MODB] + c4), sc = *(const f32x4*)(p.in[I_MODB] + 1024 + c4);
#pragma unroll
        for (int kp = 0; kp < 8; ++kp) {
            const float* b = modp + (size_t)(kp * 2) * 30720 + cond * 6144 + c4;
            sh += *(const f32x4*)b; sc += *(const f32x4*)(b + 1024);
        }
        sc += 1.f;
        const float* xt = (row0 < NPR ? p.in[I_XP] + (size_t)row0 * DM : p.in[I_XS] + (size_t)(row0 - NPR) * DM) + (size_t)rs * DM + c4;
        for (int it0 = 0; it0 < 32; it0 += 8) {
            f32x4 xv[8];
#pragma unroll
            for (int q = 0; q < 8; ++q) xv[q] = __builtin_nontemporal_load((const f32x4*)(xt + (size_t)(it0 + q) * 2 * DM));
#pragma unroll
            for (int q = 0; q < 8; ++q) {
                const f32x4 h = xv[q] * sc + sh;
                u32x2 o; o.x = cvt_pk_bf16(h.x, h.y); o.y = cvt_pk_bf16(h.z, h.w);
                *(u32x2*)(H + (size_t)(row0 + (it0 + q) * 2 + rs) * DM + c4) = o;
            }
        }
    }
}
__device__ __forceinline__ void attn_tile(const Params& p, LAS unsigned char* lds, int a) {
    const int tid = otid(), lane = tid & 63, wave = tid >> 6, fr = lane & 15, fq = lane >> 4;
    unsigned char* ws = p.ws;
    const bool lat = a >= 256;
    int b, kvh, qb, tokbase;
    if (!lat) { b = a >> 3; kvh = (a >> 2) & 1; qb = a & 3; tokbase = b * 256; }
    else { const int a2 = a - 256; b = a2 >> 6; kvh = (a2 >> 5) & 1; qb = a2 & 31; tokbase = NPR + b * 2048; }
    const int q0 = qb * 64, head = kvh * 2 + (wave >> 2);
    const int qloc = q0 + (wave & 3) * 16 + fr, qrow = tokbase + qloc;
    const bf16_t* Q = (const bf16_t*)(ws + WS_Q); const bf16_t* Kb = (const bf16_t*)(ws + WS_K); const bf16_t* Vb = (const bf16_t*)(ws + WS_V);
    const bf16_t* CK = (const bf16_t*)(ws + WS_CK); const bf16_t* CV = (const bf16_t*)(ws + WS_CV);
    bf16x8 qf[4];
#pragma unroll
    for (int ks = 0; ks < 4; ++ks) qf[ks] = *(const bf16x8*)(Q + (size_t)qrow * 512 + head * 128 + ks * 32 + fq * 8);
    float m = p.in[I_SINK][head] * 1.4426950408889634f, l = 1.f;
    f32x4 o[8];
#pragma unroll
    for (int i = 0; i < 8; ++i) o[i] = (f32x4){0.f, 0.f, 0.f, 0.f};
    int jlo = 0, jhi = 4, ntile = 4;
    if (lat) { jlo = q0 >= 128 ? 0 : (q0 == 64 ? 1 : 2); jhi = q0 <= 1856 ? 4 : (q0 == 1920 ? 3 : 2); ntile = 4 + (jhi - jlo + 1); }
    LAS unsigned char* sK = lds; LAS unsigned char* sV = lds + 17408;
    u32x4 rk[2], rv[2];
#define ATT_SRC(ti, kp_, kbase_, krs_, vbase_, vrs_) do { krs_ = 256; vrs_ = 256; \
        if (!lat) { kp_ = -100000; const size_t o_ = (size_t)(tokbase + 64 * (ti)) * 256 + kvh * 128; kbase_ = Kb + o_; vbase_ = Vb + o_; } \
        else if ((ti) < 4) { kp_ = -100000; const size_t o_ = (size_t)(b * 256 + 64 * (ti)) * 256 + kvh * 128; kbase_ = CK + o_; vbase_ = CV + o_; } \
        else { kp_ = q0 - 128 + 64 * (jlo + (ti) - 4); const size_t o_ = (size_t)(tokbase + kp_) * 256 + kvh * 128; kbase_ = Kb + o_; vbase_ = Vb + o_; } } while (0)
#define ATT_LOAD(ti) do { int kp_; const bf16_t* kb_; const bf16_t* vb_; int krs_, vrs_; ATT_SRC(ti, kp_, kb_, krs_, vb_, vrs_); (void)kp_; \
        _Pragma("unroll") for (int i = 0; i < 2; ++i) { const int idx = tid + 512 * i; \
            rk[i] = *(const u32x4*)(kb_ + (size_t)(idx >> 4) * krs_ + (idx & 15) * 8); \
            rv[i] = *(const u32x4*)(vb_ + (size_t)(idx & 63) * vrs_ + (idx >> 6) * 8); } } while (0)
    ATT_LOAD(0);
    for (int t = 0; t < ntile; ++t) {
        __syncthreads();
#pragma unroll
        for (int i = 0; i < 2; ++i) { const int idx = tid + 512 * i;
            *(LAS u32x4*)(sK + (idx >> 4) * 272 + (idx & 15) * 16) = rk[i];
            { LAS unsigned char* vd = sV + ((idx >> 6) * 8) * 144 + (idx & 63) * 2; const u32x4 w = rv[i];
              *(LAS bf16_t*)(vd) = (bf16_t)w.x; *(LAS bf16_t*)(vd + 144) = (bf16_t)(w.x >> 16); *(LAS bf16_t*)(vd + 2 * 144) = (bf16_t)w.y; *(LAS bf16_t*)(vd + 3 * 144) = (bf16_t)(w.y >> 16);
              *(LAS bf16_t*)(vd + 4 * 144) = (bf16_t)w.z; *(LAS bf16_t*)(vd + 5 * 144) = (bf16_t)(w.z >> 16); *(LAS bf16_t*)(vd + 6 * 144) = (bf16_t)w.w; *(LAS bf16_t*)(vd + 7 * 144) = (bf16_t)(w.w >> 16); } }
        __syncthreads();
        int kp0; { const bf16_t* kb_; const bf16_t* vb_; int krs_, vrs_; ATT_SRC(t, kp0, kb_, krs_, vb_, vrs_); (void)kb_; (void)vb_; (void)krs_; (void)vrs_; }
        if (t + 1 < ntile) ATT_LOAD(t + 1);
        f32x4 s[4];
#pragma unroll
        for (int nt = 0; nt < 4; ++nt) s[nt] = (f32x4){0.f, 0.f, 0.f, 0.f};
#pragma unroll
        for (int ks = 0; ks < 4; ++ks)
#pragma unroll
            for (int nt = 0; nt < 4; ++nt) {
                const bf16x8 kf = *(const LAS bf16x8*)(sK + (16 * nt + fr) * 272 + (32 * ks + 8 * fq) * 2);
                s[nt] = __builtin_amdgcn_mfma_f32_16x16x32_bf16(kf, qf[ks], s[nt], 0, 0, 0);
            }
        float mloc = -3.0e38f;
#pragma unroll
        for (int nt = 0; nt < 4; ++nt)
#pragma unroll
            for (int j = 0; j < 4; ++j) {
                float v = s[nt][j] * (ATTN_SCALE_C * 1.4426950408889634f);
                if (kp0 > -50000) { const int df = qloc - (kp0 + 16 * nt + 4 * fq + j); if (df > 128 || df < -128) v = -1e30f; }
                s[nt][j] = v; mloc = fmaxf(mloc, v);
            }
        mloc = fmaxf(mloc, __shfl_xor(mloc, 16)); mloc = fmaxf(mloc, __shfl_xor(mloc, 32));
        const float mn = fmaxf(m, mloc), alpha = __builtin_amdgcn_exp2f(m - mn);
        float ls = 0.f;
#pragma unroll
        for (int nt = 0; nt < 4; ++nt)
#pragma unroll
            for (int j = 0; j < 4; ++j) { const float e = __builtin_amdgcn_exp2f(s[nt][j] - mn); s[nt][j] = e; ls += e; }
        ls += __shfl_xor(ls, 16); ls += __shfl_xor(ls, 32);
        l = l * alpha + ls; m = mn;
#pragma unroll
        for (int i = 0; i < 8; ++i) o[i] *= alpha;
#pragma unroll
        for (int kk = 0; kk < 2; ++kk) {
            u32x4 pw; pw.x = cvt_pk_bf16(s[2 * kk][0], s[2 * kk][1]); pw.y = cvt_pk_bf16(s[2 * kk][2], s[2 * kk][3]);
            pw.z = cvt_pk_bf16(s[2 * kk + 1][0], s[2 * kk + 1][1]); pw.w = cvt_pk_bf16(s[2 * kk + 1][2], s[2 * kk + 1][3]);
            const bf16x8 pf = __builtin_bit_cast(bf16x8, pw);
#pragma unroll
            for (int dt = 0; dt < 8; ++dt) {
                const LAS unsigned char* vp = sV + (16 * dt + fr) * 144 + (32 * kk + 4 * fq) * 2;
                const u32x2 lo = *(const LAS u32x2*)vp, hi = *(const LAS u32x2*)(vp + 32);
                u32x4 vw; vw.x = lo.x; vw.y = lo.y; vw.z = hi.x; vw.w = hi.y;
                o[dt] = __builtin_amdgcn_mfma_f32_16x16x32_bf16(__builtin_bit_cast(bf16x8, vw), pf, o[dt], 0, 0, 0);
            }
        }
    }
    const float inv = 1.f / l;
    bf16_t* MIX = (bf16_t*)(ws + WS_MIX);
#pragma unroll
    for (int dt = 0; dt < 8; ++dt) {
        u32x2 ov; ov.x = cvt_pk_bf16(o[dt][0] * inv, o[dt][1] * inv); ov.y = cvt_pk_bf16(o[dt][2] * inv, o[dt][3] * inv);
        *(u32x2*)(MIX + (size_t)qrow * DM + head * 128 + 16 * dt + 4 * fq) = ov;
    }
    __syncthreads();
#undef ATT_SRC
#undef ATT_LOAD
}
__device__ __forceinline__ void r1_loads(const Params& p, int r, int tid, unsigned (&xr)[6]) {
    const int c64 = r >> 3, nb = r & 7, tok0 = c64 * 64;
    int s0, len; if (tok0 < NPR) { s0 = tok0 & ~255; len = 256; } else { s0 = NPR + ((tok0 - NPR) & ~2047); len = 2048; }
    const bf16_t* XR = (const bf16_t*)(p.ws + WS_XR);
    const int c = tid & 63, tg = tid >> 6, ch = nb * 64 + c;
    unsigned t[12];
#pragma unroll
    for (int i = 0; i < 11; ++i) { const int tk = tok0 + 8 * tg - 2 + i; t[i] = (tk >= s0 && tk < s0 + len) ? (unsigned)XR[(size_t)tk * 512 + ch] : 0u; }
    t[11] = 0u;
#pragma unroll
    for (int i = 0; i < 6; ++i) xr[i] = t[2 * i] | (t[2 * i + 1] << 16);
}
__device__ __forceinline__ void r1_tile(const Params& p, LAS unsigned char* lds, int r, unsigned (&xraw)[6], int rnext) {
    const int tid = otid(), lane = tid & 63, wave = tid >> 6, fr = lane & 15, fq = lane >> 4;
    unsigned char* ws = p.ws;
    const int c64 = r >> 3, nb = r & 7, tok0 = c64 * 64;
    int s0, len; if (tok0 < NPR) { s0 = tok0 & ~255; len = 256; } else { s0 = NPR + ((tok0 - NPR) & ~2047); len = 2048; }
    LAS float* XC = (LAS float*)lds; LAS unsigned char* XCB = lds + 16640; LAS float* A_ = (LAS float*)(lds + 25856); LAS float* U_ = (LAS float*)(lds + 58624);
    const bf16_t* XR = (const bf16_t*)(ws + WS_XR);
    bf16x8 gA[4][2], gX[4][2]; float gba[4], gbx[4], glm[4];
    {
        const int d = wave & 1; const bf16_t* GW = (const bf16_t*)(ws + WS_GW);
#pragma unroll
        for (int nt = 0; nt < 4; ++nt) {
#pragma unroll
            for (int ks = 0; ks < 2; ++ks) {
                gA[nt][ks] = *(const bf16x8*)(GW + (size_t)(((d * 2 + 0) * 8 + nb) * 64 + 16 * nt + fr) * 64 + 32 * ks + 8 * fq);
                gX[nt][ks] = *(const bf16x8*)(GW + (size_t)(((d * 2 + 1) * 8 + nb) * 64 + 16 * nt + fr) * 64 + 32 * ks + 8 * fq);
            }
            const int chn = d * 512 + nb * 64 + 16 * nt + fr;
            gba[nt] = p.in[I_BA][chn]; gbx[nt] = p.in[I_BX][chn]; glm[nt] = ((const float*)(ws + WS_SP))[chn];
        }
    }
    {
        const int c = tid & 63, tg = tid >> 6, ch = nb * 64 + c;
        const float* cw = p.in[I_CONVW]; const float w0 = cw[ch], w1 = cw[512 + ch], w2 = cw[1024 + ch], w3 = cw[1536 + ch], cb = p.in[I_CONVB][ch];
        float x[11];
#pragma unroll
        for (int i = 0; i < 11; ++i) x[i] = (i & 1) ? bfhi(xraw[i >> 1]) : bflo(xraw[i >> 1]);
#pragma unroll
        for (int k = 0; k < 8; ++k) {
            const float xc = cb + w0 * x[k] + w1 * x[k + 1] + w2 * x[k + 2] + w3 * x[k + 3];
            XC[(8 * tg + k) * 65 + c] = xc;
            *(LAS bf16_t*)(XCB + (8 * tg + k) * 144 + c * 2) = (bf16_t)(cvt_pk_bf16(xc, 0.f) & 0xffffu);
        }
    }
    if (rnext < 2048) r1_loads(p, rnext, tid, xraw);
    __syncthreads();
    {
        const int d = wave & 1, tq = wave >> 1;
        bf16x8 af[2];
#pragma unroll
        for (int ks = 0; ks < 2; ++ks) af[ks] = *(const LAS bf16x8*)(XCB + (16 * tq + fr) * 144 + (32 * ks + 8 * fq) * 2);
#pragma unroll
        for (int nt = 0; nt < 4; ++nt) {
            f32x4 aA = (f32x4){0.f, 0.f, 0.f, 0.f}, aX = (f32x4){0.f, 0.f, 0.f, 0.f};
#pragma unroll
            for (int ks = 0; ks < 2; ++ks) {
                aA = __builtin_amdgcn_mfma_f32_16x16x32_bf16(af[ks], gA[nt][ks], aA, 0, 0, 0);
                aX = __builtin_amdgcn_mfma_f32_16x16x32_bf16(af[ks], gX[nt][ks], aX, 0, 0, 0);
            }
            const int n = 16 * nt + fr, ch = nb * 64 + n;
            const float ba = gba[nt], bx = gbx[nt], sp = glm[nt];
#pragma unroll
            for (int j = 0; j < 4; ++j) {
                const int t = 16 * tq + 4 * fq + j;
                const float rg = sigmoidf_(aA[j] + ba), ig = sigmoidf_(aX[j] + bx), la = -8.f * rg * sp;
                const float av = __expf(la), uv = __builtin_amdgcn_sqrtf(one_minus_exp(2.f * la)) * ig * XC[t * 65 + n];
                A_[(d * 64 + t) * 64 + n] = av; U_[(d * 64 + t) * 64 + n] = uv;
            }
        }
    }
    __syncthreads();
    const int d = tid >> 8, sub = (tid >> 6) & 3, ch = tid & 63;
    {
        float h = 0.f, P = 1.f;
#pragma unroll
        for (int k = 0; k < 16; ++k) {
            const int t = d == 0 ? 16 * sub + k : 16 * sub + 15 - k, idx = (d * 64 + t) * 64 + ch;
            const float a = A_[idx], u = U_[idx]; h = a * h + u; P *= a; U_[idx] = h; A_[idx] = P;
        }
    }
    __syncthreads();
    {
        float chh = 0.f, cP = 1.f;
        if (d == 0) { for (int s = 0; s < sub; ++s) { const int e = (16 * s + 15) * 64 + ch; chh = U_[e] + A_[e] * chh; cP *= A_[e]; } }
        else { for (int s = 3; s > sub; --s) { const int e = (64 + 16 * s) * 64 + ch; chh = U_[e] + A_[e] * chh; cP *= A_[e]; } }
        bf16_t* HL = (bf16_t*)(ws + (d == 0 ? WS_HLF : WS_HLB)); bf16_t* PC = (bf16_t*)(ws + (d == 0 ? WS_PCF : WS_PCB));
#pragma unroll
        for (int k = 0; k < 16; ++k) {
            const int t = 16 * sub + k, idx = (d * 64 + t) * 64 + ch;
            const float hl = U_[idx], pl = A_[idx];
            const size_t g = (size_t)(tok0 + t) * 512 + nb * 64 + ch;
            const unsigned hp = cvt_pk_bf16(hl + pl * chh, pl * cP); HL[g] = (bf16_t)hp; PC[g] = (bf16_t)(hp >> 16);
        }
    }
    __syncthreads();
}
__device__ __forceinline__ void r2_tile(const Params& p, int c64) {
    const int ch = otid(); unsigned char* ws = p.ws;
    const int tok0 = c64 * 64; const bool prompt = tok0 < NPR;
    int s0, len; if (prompt) { s0 = tok0 & ~255; len = 256; } else { s0 = NPR + ((tok0 - NPR) & ~2047); len = 2048; }
    const int n = (tok0 - s0) >> 6, nc = len >> 6;
    const bf16_t* HLF = (const bf16_t*)(ws + WS_HLF); const bf16_t* HLB = (const bf16_t*)(ws + WS_HLB);
    const bf16_t* PCF = (const bf16_t*)(ws + WS_PCF); const bf16_t* PCB = (const bf16_t*)(ws + WS_PCB);
    float cf = 0.f, cb = 0.f;
    if (!prompt) { const int bs = (tok0 - NPR) >> 11; cf = p.in[I_STATE][(bs * 2 + 0) * 512 + ch]; cb = p.in[I_STATE][(bs * 2 + 1) * 512 + ch]; }
    for (int c0 = 0; c0 < n; c0 += 8) {
        float hv[8], pv[8];
#pragma unroll
        for (int i = 0; i < 8; ++i) { const int cc = (c0 + i < n) ? c0 + i : n - 1; const size_t g = (size_t)(s0 + 64 * cc + 63) * 512 + ch; hv[i] = bf2f(HLF[g]); pv[i] = bf2f(PCF[g]); }
#pragma unroll
        for (int i = 0; i < 8; ++i) if (c0 + i < n) cf = hv[i] + pv[i] * cf;
    }
    for (int c0 = nc - 1; c0 > n; c0 -= 8) {
        float hv[8], pv[8];
#pragma unroll
        for (int i = 0; i < 8; ++i) { const int cc = (c0 - i > n) ? c0 - i : n + 1; const size_t g = (size_t)(s0 + 64 * cc) * 512 + ch; hv[i] = bf2f(HLB[g]); pv[i] = bf2f(PCB[g]); }
#pragma unroll
        for (int i = 0; i < 8; ++i) if (c0 - i > n) cb = hv[i] + pv[i] * cb;
    }
    const bf16_t* XGb = (const bf16_t*)(ws + WS_XG); bf16_t* MIX = (bf16_t*)(ws + WS_MIX);
    float* ostate = p.out + (size_t)NTOK * DM + 2 * (size_t)NPR * 256;
#pragma unroll 8
    for (int t = 0; t < 64; ++t) {
        const size_t g = (size_t)(tok0 + t) * 512 + ch;
        const float hf = bf2f(__builtin_nontemporal_load(HLF + g)) + bf2f(__builtin_nontemporal_load(PCF + g)) * cf, hb = bf2f(__builtin_nontemporal_load(HLB + g)) + bf2f(__builtin_nontemporal_load(PCB + g)) * cb;
        const float y = (hf + hb) * geluf_(bf2f(XGb[g]));
        MIX[(size_t)(tok0 + t) * DM + 512 + ch] = (bf16_t)(cvt_pk_bf16(y, 0.f) & 0xffffu);
        if (prompt) {
            if (n == nc - 1 && t == 63) ostate[((tok0 >> 8) * 2 + 0) * 512 + ch] = hf;
            if (n == 0 && t == 0) ostate[((tok0 >> 8) * 2 + 1) * 512 + ch] = hb;
        }
    }
}
__device__ __forceinline__ void spatial_tile(const Params& p, LAS unsigned char* lds, int r) {
    const int tid = otid(), lane = tid & 63, wave = tid >> 6, fr = lane & 15, fq = lane >> 4;
    unsigned char* ws = p.ws;
    const int nchunk = r >> 3, g = r & 7, tok0 = nchunk * 128;
    LAS unsigned char* SA = lds; LAS unsigned char* SB = lds + 34816; LAS float* MU = (LAS float*)(lds + 69632); LAS float* RS = (LAS float*)(lds + 70144);
    if (tid < 128) {
        const float* st = (const float*)(ws + WS_VSTAT) + (size_t)(tok0 + tid) * 32;
        float s1 = 0.f, s2 = 0.f;
#pragma unroll
        for (int i = 0; i < 16; ++i) { s1 += st[2 * i]; s2 += st[2 * i + 1]; }
        const float mu = s1 * (1.f / 1024.f), var = fmaxf(s2 * (1.f / 1024.f) - mu * mu, 0.f);
        MU[tid] = mu; RS[tid] = rsqrtf(var + LN_EPS_C);
    }
    const bf16_t* SPW = (const bf16_t*)(ws + WS_SPW);
#pragma unroll
    for (int i = 0; i < 4; ++i) { const int idx = tid + 512 * i, pr = idx >> 4, c16 = idx & 15;
        *(LAS u32x4*)(SA + pr * 272 + c16 * 16) = *(const u32x4*)(SPW + (size_t)(g * 128 + pr) * 128 + c16 * 8); }
    const bf16_t* V2 = (const bf16_t*)(ws + WS_V2);
    u32x4 rawv[4];
#pragma unroll
    for (int i = 0; i < 4; ++i) { const int idx = tid + 512 * i, q = idx & 127, c8 = idx >> 7; rawv[i] = *(const u32x4*)(V2 + (size_t)(tok0 + q) * DM + g * 128 + c8 * 8); }
    __syncthreads();
#pragma unroll
    for (int i = 0; i < 4; ++i) { const int idx = tid + 512 * i, q = idx & 127, c8 = idx >> 7;
        const u32x4 raw = rawv[i];
        const float* lgp = p.in[I_SGLNG] + g * 128 + c8 * 8; const float* lbp = p.in[I_SGLNB] + g * 128 + c8 * 8;
        const f32x4 lg0 = *(const f32x4*)lgp, lg1 = *(const f32x4*)(lgp + 4), lb0 = *(const f32x4*)lbp, lb1 = *(const f32x4*)(lbp + 4);
        const float mu = MU[q], rs = RS[q];
        const unsigned w0 = cvt_pk_bf16((bflo(raw.x) - mu) * rs * lg0.x + lb0.x, (bfhi(raw.x) - mu) * rs * lg0.y + lb0.y);
        const unsigned w1 = cvt_pk_bf16((bflo(raw.y) - mu) * rs * lg0.z + lb0.z, (bfhi(raw.y) - mu) * rs * lg0.w + lb0.w);
        const unsigned w2 = cvt_pk_bf16((bflo(raw.z) - mu) * rs * lg1.x + lb1.x, (bfhi(raw.z) - mu) * rs * lg1.y + lb1.y);
        const unsigned w3 = cvt_pk_bf16((bflo(raw.w) - mu) * rs * lg1.z + lb1.z, (bfhi(raw.w) - mu) * rs * lg1.w + lb1.w);
        LAS unsigned char* sd = SB + (c8 * 8) * 272 + q * 2;
        *(LAS bf16_t*)(sd) = (bf16_t)w0; *(LAS bf16_t*)(sd + 272) = (bf16_t)(w0 >> 16); *(LAS bf16_t*)(sd + 2 * 272) = (bf16_t)w1; *(LAS bf16_t*)(sd + 3 * 272) = (bf16_t)(w1 >> 16);
        *(LAS bf16_t*)(sd + 4 * 272) = (bf16_t)w2; *(LAS bf16_t*)(sd + 5 * 272) = (bf16_t)(w2 >> 16); *(LAS bf16_t*)(sd + 6 * 272) = (bf16_t)w3; *(LAS bf16_t*)(sd + 7 * 272) = (bf16_t)(w3 >> 16); }
    __syncthreads();
    const int wr = wave >> 1, wc = wave & 1;
    const bf16_t* U = (const bf16_t*)(ws + WS_U); bf16_t* S_ = (bf16_t*)(ws + WS_MIX);
    u32x2 upre[2][4]; float bpre[2];
#pragma unroll
    for (int mt = 0; mt < 2; ++mt) { const int pr = 32 * wr + 16 * mt + fr; bpre[mt] = p.in[I_SPB][g * 128 + pr];
#pragma unroll
        for (int nt = 0; nt < 4; ++nt) upre[mt][nt] = *(const u32x2*)(U + (size_t)(tok0 + pr) * DM + g * 128 + 64 * wc + 16 * nt + 4 * fq); }
    f32x4 acc[2][4];
#pragma unroll
    for (int i = 0; i < 2; ++i)
#pragma unroll
        for (int j = 0; j < 4; ++j) acc[i][j] = (f32x4){0.f, 0.f, 0.f, 0.f};
#pragma unroll
    for (int ks = 0; ks < 4; ++ks) {
        bf16x8 af[2], bf[4];
#pragma unroll
        for (int mt = 0; mt < 2; ++mt) af[mt] = *(const LAS bf16x8*)(SA + (32 * wr + 16 * mt + fr) * 272 + (32 * ks + 8 * fq) * 2);
#pragma unroll
        for (int nt = 0; nt < 4; ++nt) bf[nt] = *(const LAS bf16x8*)(SB + (64 * wc + 16 * nt + fr) * 272 + (32 * ks + 8 * fq) * 2);
#pragma unroll
        for (int mt = 0; mt < 2; ++mt)
#pragma unroll
            for (int nt = 0; nt < 4; ++nt) acc[mt][nt] = __builtin_amdgcn_mfma_f32_16x16x32_bf16(bf[nt], af[mt], acc[mt][nt], 0, 0, 0);
    }
#pragma unroll
    for (int mt = 0; mt < 2; ++mt) {
        const int pr = 32 * wr + 16 * mt + fr; const float bias = bpre[mt];
#pragma unroll
        for (int nt = 0; nt < 4; ++nt) {
            const size_t off = (size_t)(tok0 + pr) * DM + g * 128 + 64 * wc + 16 * nt + 4 * fq;
            const u32x2 uu = upre[mt][nt];
            u32x2 ov; ov.x = cvt_pk_bf16(bflo(uu.x) * (acc[mt][nt][0] + bias), bfhi(uu.x) * (acc[mt][nt][1] + bias));
            ov.y = cvt_pk_bf16(bflo(uu.y) * (acc[mt][nt][2] + bias), bfhi(uu.y) * (acc[mt][nt][3] + bias));
            *(u32x2*)(S_ + off) = ov;
        }
    }
    __syncthreads();
}
__device__ __forceinline__ void phase_lnmix(const Params& p, LAS unsigned char* lds, int l) {
    const int tid = otid(), lane = tid & 63, wave = tid >> 6; unsigned char* ws = p.ws;
    LAS float* RW = (LAS float*)lds; LAS float* XT = (LAS float*)(lds + 65536); LAS float* PS = (LAS float*)(lds + 65536 + 65792);
    const float* rw = p.in[I_ROUTER] + (size_t)l * 16384;
    for (int i = tid; i < 4096; i += 512) *(LAS f32x4*)(RW + i * 4) = *(const f32x4*)(rw + i * 4);
    bf16_t* XA = (bf16_t*)(ws + WS_XA); unsigned char* HMOE = ws + WS_HMOE; float* AFF = (float*)(ws + WS_AFF);
    const float* gam = p.in[I_LNMG] + l * DM; const float* bet = p.in[I_LNMB] + l * DM;
    for (int tile = blockIdx.x; tile < NTOK / 16; tile += gridDim.x) {
        const int row0 = tile * 16;
        const float* modr = (const float*)(ws + WS_MOD) + (size_t)(l * 5 + cond_of(row0)) * 6144;
        f32x4 vv[2][4];
#pragma unroll
        for (int rr = 0; rr < 2; ++rr)
#pragma unroll
            for (int j = 0; j < 4; ++j) { const u32x2 w = *(const u32x2*)(XA + (size_t)(row0 + wave * 2 + rr) * DM + 4 * lane + 256 * j); vv[rr][j] = (f32x4){bflo(w.x), bfhi(w.x), bflo(w.y), bfhi(w.y)}; }
#pragma unroll
        for (int rr = 0; rr < 2; ++rr) {
            const int rl = wave * 2 + rr, row = row0 + rl;
            f32x4 v[4]; float s = 0.f;
#pragma unroll
            for (int j = 0; j < 4; ++j) { v[j] = vv[rr][j]; s += (v[j].x + v[j].y) + (v[j].z + v[j].w); }
            const float mean = wave_sum(s) * (1.f / DM); float s2 = 0.f;
#pragma unroll
            for (int j = 0; j < 4; ++j) { v[j] = v[j] - mean; s2 += (v[j].x * v[j].x + v[j].y * v[j].y) + (v[j].z * v[j].z + v[j].w * v[j].w); }
            const float rstd = rsqrtf(wave_sum(s2) * (1.f / DM) + LN_EPS_C);
#pragma unroll
            for (int j = 0; j < 4; ++j) {
                const int c = 4 * lane + 256 * j;
                const f32x4 x1 = v[j] * rstd * *(const f32x4*)(gam + c) + *(const f32x4*)(bet + c);
                { u32x2 ox; ox.x = cvt_pk_bf16(x1.x, x1.y); ox.y = cvt_pk_bf16(x1.z, x1.w); *(u32x2*)(XA + (size_t)row * DM + c) = ox; }
                const f32x4 hm = x1 * (*(const f32x4*)(modr + 4 * 1024 + c) + 1.f) + *(const f32x4*)(modr + 3 * 1024 + c);
                *(unsigned*)(HMOE + (size_t)row * DM + c) = pk4_fp8(hm.x, hm.y, hm.z, hm.w);
                *(LAS f32x4*)(XT + rl * 1028 + c) = hm;
            }
        }
        __syncthreads();
        {
            f32x4 acc = (f32x4){0.f, 0.f, 0.f, 0.f};
            const int ri = lane & 15, kq = lane >> 4, kb = wave * 128;
#pragma unroll 8
            for (int kk = 0; kk < 32; ++kk) {
                const int k = kb + 4 * kk + kq;
                acc = __builtin_amdgcn_mfma_f32_16x16x4f32(XT[ri * 1028 + k], RW[k * 16 + ri], acc, 0, 0, 0);
            }
#pragma unroll
            for (int r = 0; r < 4; ++r) PS[wave * 256 + (4 * kq + r) * 16 + ri] = acc[r];
        }
        __syncthreads();
        if (tid < 256) {
            float lg = 0.f;
#pragma unroll
            for (int w = 0; w < 8; ++w) lg += PS[w * 256 + tid];
            float mx = lg;
#pragma unroll
            for (int o = 1; o < 16; o <<= 1) mx = fmaxf(mx, __shfl_xor(mx, o));
            const float ex = __expf(lg - mx); float sm = ex;
#pragma unroll
            for (int o = 1; o < 16; o <<= 1) sm += __shfl_xor(sm, o);
            AFF[(size_t)(row0 + (tid >> 4)) * 16 + (tid & 15)] = ex / sm;
        }
        __syncthreads();
    }
}
__device__ __forceinline__ void phase_route(const Params& p, LAS unsigned char* lds) {
    const int tid = otid(), lane = tid & 63, wave = tid >> 6; unsigned char* ws = p.ws;
    LAS unsigned* key = (LAS unsigned*)lds; LAS int* idx = (LAS int*)(lds + 8192);
    const float* AFF = (const float*)(ws + WS_AFF); int* TOKSLOT = (int*)(ws + WS_TOKSLOT); float* SG = (float*)(ws + WS_SLOTGATE);
    const unsigned char* HMOE = ws + WS_HMOE; unsigned char* XG = ws + WS_XGATH;
    for (int tile = blockIdx.x; tile < 576; tile += gridDim.x) {
        int b, e, T, tok0, cap, ls0;
        if (tile < 64) { b = tile >> 4; e = tile & 15; T = 2048; tok0 = NPR + b * 2048; cap = 256; ls0 = 1024 + b * 256; }
        else { const int t2 = tile - 64; b = t2 >> 4; e = t2 & 15; T = 256; tok0 = b * 256; cap = 32; ls0 = b * 32; }
        for (int i = tid; i < T; i += 512) { key[i] = __builtin_bit_cast(unsigned, AFF[(size_t)(tok0 + i) * 16 + e]); idx[i] = i; }
        __syncthreads();
        for (int k = 2; k <= T; k <<= 1)
            for (int j = k >> 1; j > 0; j >>= 1) {
                for (int pp = tid; pp < (T >> 1); pp += 512) {
                    const int i = ((pp & ~(j - 1)) << 1) | (pp & (j - 1)), l = i | j;
                    const bool desc = (i & k) == 0;
                    const unsigned ki = key[i], kl = key[l]; const int ii = idx[i], il = idx[l];
                    const bool inorder = (ki > kl) || (ki == kl && ii < il);
                    if (inorder != desc) { key[i] = kl; key[l] = ki; idx[i] = il; idx[l] = ii; }
                }
                __syncthreads();
            }
        for (int pos = tid; pos < T; pos += 512) {
            const int tok = idx[pos];
            TOKSLOT[(size_t)(tok0 + tok) * 16 + e] = pos < cap ? ls0 + pos : -1;
            if (pos < cap) SG[e * 2048 + ls0 + pos] = __builtin_bit_cast(float, key[pos]);
        }
        for (int pos0 = wave * 4; pos0 < cap; pos0 += 32) {
            u32x4 rowv[4];
#pragma unroll
            for (int q = 0; q < 4; ++q) rowv[q] = ((const u32x4*)(HMOE + (size_t)(tok0 + idx[pos0 + q]) * DM))[lane];
#pragma unroll
            for (int q = 0; q < 4; ++q) ((u32x4*)(XG + (size_t)(e * 2048 + ls0 + pos0 + q) * DM))[lane] = rowv[q];
        }
        __syncthreads();
    }
}
__device__ __forceinline__ void phase_lnffn(const Params& p, int l) {
    const int tid = otid(), lane = tid & 63, wave = tid >> 6; unsigned char* ws = p.ws;
    bf16_t* XA = (bf16_t*)(ws + WS_XA); bf16_t* H = (bf16_t*)(ws + WS_H); const bf16_t* Y = (const bf16_t*)(ws + WS_Y); const int* TOKSLOT = (const int*)(ws + WS_TOKSLOT);
    const float* gam = p.in[I_LNFG] + l * DM; const float* bet = p.in[I_LNFB] + l * DM;
    const int rstride = gridDim.x * 8;
    int slv_n = 0; u32x2 xr_n[4];
    { const int row = blockIdx.x * 8 + wave;
      if (row < NTOK) { slv_n = TOKSLOT[(size_t)row * 16 + (lane & 15)];
#pragma unroll
          for (int j = 0; j < 4; ++j) xr_n[j] = *(const u32x2*)(XA + (size_t)row * DM + 4 * lane + 256 * j); } }
    for (int row = blockIdx.x * 8 + wave; row < NTOK; row += rstride) {
        const int cond = cond_of(row);
        const int slv = slv_n; u32x2 xr_c[4];
#pragma unroll
        for (int j = 0; j < 4; ++j) xr_c[j] = xr_n[j];
        if (row + rstride < NTOK) {
            slv_n = TOKSLOT[(size_t)(row + rstride) * 16 + (lane & 15)];
#pragma unroll
            for (int j = 0; j < 4; ++j) xr_n[j] = *(const u32x2*)(XA + (size_t)(row + rstride) * DM + 4 * lane + 256 * j);
        }
        const float* modr = (const float*)(ws + WS_MOD) + (size_t)(l * 5 + cond) * 6144;
        f32x4 f[4], xres[4];
#pragma unroll
        for (int j = 0; j < 4; ++j) { f[j] = (f32x4){0.f, 0.f, 0.f, 0.f}; { const u32x2 w = xr_c[j]; xres[j] = (f32x4){bflo(w.x), bfhi(w.x), bflo(w.y), bfhi(w.y)}; } }
        {
            unsigned long long m = __builtin_amdgcn_ballot_w64(slv >= 0) & 0xffffull;
            while (m) {
                const int e0 = __builtin_ctzll(m); m &= m - 1;
                const bool two = m != 0; const int e1 = two ? __builtin_ctzll(m) : e0; if (two) m &= m - 1;
                const int s0 = __builtin_amdgcn_readlane(slv, e0), s1 = __builtin_amdgcn_readlane(slv, e1);
                const bf16_t* y0 = Y + (size_t)(e0 * 2048 + s0) * DM; const bf16_t* y1 = Y + (size_t)(e1 * 2048 + s1) * DM;
                u32x2 w0[4], w1[4];
#pragma unroll
                for (int j = 0; j < 4; ++j) { w0[j] = __builtin_nontemporal_load((const u32x2*)(y0 + 4 * lane + 256 * j)); w1[j] = __builtin_nontemporal_load((const u32x2*)(y1 + 4 * lane + 256 * j)); }
                const float k1 = two ? 1.f : 0.f;
#pragma unroll
                for (int j = 0; j < 4; ++j) {
                    f[j].x += bflo(w0[j].x) + k1 * bflo(w1[j].x); f[j].y += bfhi(w0[j].x) + k1 * bfhi(w1[j].x);
                    f[j].z += bflo(w0[j].y) + k1 * bflo(w1[j].y); f[j].w += bfhi(w0[j].y) + k1 * bfhi(w1[j].y);
                }
            }
        }
        f32x4 v[4]; float s = 0.f;
#pragma unroll
        for (int j = 0; j < 4; ++j) { const int c = 4 * lane + 256 * j;
            v[j] = xres[j] * ALPHA_C + *(const f32x4*)(modr + 5 * 1024 + c) * f[j];
            s += (v[j].x + v[j].y) + (v[j].z + v[j].w); }
        const float mean = wave_sum(s) * (1.f / DM); float s2 = 0.f;
#pragma unroll
        for (int j = 0; j < 4; ++j) { v[j] = v[j] - mean; s2 += (v[j].x * v[j].x + v[j].y * v[j].y) + (v[j].z * v[j].z + v[j].w * v[j].w); }
        const float rstd = rsqrtf(wave_sum(s2) * (1.f / DM) + LN_EPS_C);
        const float* modn = (const float*)(ws + WS_MOD) + (size_t)(5 + cond) * 6144;
#pragma unroll
        for (int j = 0; j < 4; ++j) {
            const int c = 4 * lane + 256 * j;
            const f32x4 x2 = v[j] * rstd * *(const f32x4*)(gam + c) + *(const f32x4*)(bet + c);
            if (l == 0) {
                { u32x2 ox; ox.x = cvt_pk_bf16(x2.x, x2.y); ox.y = cvt_pk_bf16(x2.z, x2.w); *(u32x2*)(XA + (size_t)row * DM + c) = ox; }
                const f32x4 h = x2 * (*(const f32x4*)(modn + 1024 + c) + 1.f) + *(const f32x4*)(modn + c);
                u32x2 o; o.x = cvt_pk_bf16(h.x, h.y); o.y = cvt_pk_bf16(h.z, h.w);
                *(u32x2*)(H + (size_t)row * DM + c) = o;
            } else *(f32x4*)(p.out + (size_t)row * DM + c) = x2;
        }
    }
}
#ifndef PHMASK
#define PHMASK 0xFFFFF
#endif
template <int PH> __device__ __forceinline__ void run_phase(const Params& p, LAS unsigned char* lds) {
    unsigned char* ws = p.ws;
    const int G = gridDim.x;
    constexpr int l = PH >= 11 ? 1 : 0;
    constexpr int base = PH >= 13 ? PH - 8 : PH;
    if constexpr (!(((PHMASK) >> (base)) & 1)) return;
    if constexpr (base == 0) phase_p0(p, lds);
    else if constexpr (base == 1) phase_p0b(p);
    else if constexpr (base == 2) {
        pg8::Gemm g; g.A = (const bf16_t*)(ws + WS_H); g.Bt = (const bf16_t*)(ws + WS_ABIN); g.M = NTOK; g.N = 2048; g.K = 1024;
        pg8::StaticOrder S; S.init(NTOK, 2048, G, blockIdx.x);
        EpiIn E; E.Q = (bf16_t*)(ws + WS_Q); E.Kb = (bf16_t*)(ws + WS_K); E.Vb = (bf16_t*)(ws + WS_V); E.XR = (bf16_t*)(ws + WS_XR); E.XGb = (bf16_t*)(ws + WS_XG);
        E.outK = p.out + (size_t)NTOK * DM; E.outV = p.out + (size_t)NTOK * DM + (size_t)NPR * 256; E.rope = (const float*)(ws + WS_ROPE);
        pg8::gemm_phase<EpiIn, pg8::StaticOrder, true, true>(lds, g, S, E);
    } else if constexpr (base == 3) {
        unsigned xraw[6]; bool primed = false;
        for (int t = blockIdx.x; t < 512 + 2048; t += G) {
            if (t < 512) attn_tile(p, lds, t);
            else { if (!primed) { r1_loads(p, t - 512, otid(), xraw); primed = true; } r1_tile(p, lds, t - 512, xraw, t - 512 + G); } }
    } else if constexpr (base == 4) {
        for (int t = blockIdx.x; t < 256; t += G) r2_tile(p, t);
    } else if constexpr (base == 5) {
        pg8::Gemm g; g.A = (const bf16_t*)(ws + WS_MIX); g.Bt = (const bf16_t*)(ws + (l ? WS_SGOUT : WS_ABOUT)); g.M = NTOK; g.N = 1024; g.K = 1024;
        pg8::StaticOrder S; S.init(NTOK, 1024, G, blockIdx.x);
        EpiOut<(l == 1)> E; E.XA = (bf16_t*)(ws + WS_XA); E.modl = (const float*)(ws + WS_MOD) + (size_t)l * 5 * 6144;
        E.xin_p = p.in[I_XP]; E.xin_s = p.in[I_XS];
        pg8::gemm_phase<EpiOut<(l == 1)>, pg8::StaticOrder, true, true>(lds, g, S, E);
    } else if constexpr (base == 6) phase_lnmix(p, lds, l);
    else if constexpr (base == 7) phase_route(p, lds);
    else if constexpr (base == 8) {
        pg8::Gemm g; g.A = (const bf16_t*)(ws + WS_XGATH); g.Bt = (const bf16_t*)(ws + WS_BTUP + (size_t)l * 16 * 4096 * 1024); g.M = 32768; g.N = 65536; g.K = 512;
        pg8::GroupOrder<2048, 128, 16> S; S.G = G; S.c = blockIdx.x;
        EpiUp E; E.Hid = ws + WS_HID;
        pg8::gemm_phase<EpiUp, pg8::GroupOrder<2048, 128, 16>, true, true, true>(lds, g, S, E);
    } else if constexpr (base == 9) {
        pg8::Gemm g; g.A = (const bf16_t*)(ws + WS_HID); g.Bt = (const bf16_t*)(ws + WS_BTDN + (size_t)l * 16 * 1024 * 2048); g.M = 32768; g.N = 16384; g.K = 1024;
        pg8::GroupOrder<512, 32, 4> S; S.G = G; S.c = blockIdx.x;
        EpiDn E; E.Y = (bf16_t*)(ws + WS_Y); E.gate = (const float*)(ws + WS_SLOTGATE);
        pg8::gemm_phase<EpiDn, pg8::GroupOrder<512, 32, 4>, true, true, true>(lds, g, S, E);
    } else if constexpr (base == 10) phase_lnffn(p, l);
    else if constexpr (base == 11) {
        pg8::Gemm g; g.A = (const bf16_t*)(ws + WS_H); g.Bt = (const bf16_t*)(ws + WS_SGIN); g.M = NTOK; g.N = 2048; g.K = 1024;
        pg8::StaticOrder S; S.init(NTOK, 2048, G, blockIdx.x);
        EpiSgu E; E.U = (bf16_t*)(ws + WS_U); E.V2 = (bf16_t*)(ws + WS_V2); E.vstat = (float*)(ws + WS_VSTAT); E.bias = p.in[I_SGINB];
        pg8::gemm_phase<EpiSgu, pg8::StaticOrder, true, true>(lds, g, S, E);
    } else if constexpr (base == 12) {
        for (int t = blockIdx.x; t < 1024; t += G) spatial_tile(p, lds, t);
    }
}
__global__ void __launch_bounds__(512, 2) fwd_kernel(Params p) {
    extern __shared__ __attribute__((aligned(16))) unsigned char smem[];
    LAS unsigned char* lds = (LAS unsigned char*)smem;
    volatile LAS unsigned* xst = (volatile LAS unsigned*)(lds + LDS_BYTES - 16);
    if (threadIdx.x == 0) { xst[0] = 0u; xst[1] = 0u; }
    __syncthreads();
    XcdBarrier xb = xcd_barrier_post((unsigned*)(p.ws + WS_BAR), xst);
#ifndef DUPMASK
#define DUPMASK 0
#endif
#define PHASE(k) if (p.ph_lo <= (k) && (k) < p.ph_hi) { run_phase<k>(p, lds); if constexpr (((DUPMASK) >> (k)) & 1) { xcd_barrier(xb); run_phase<k>(p, lds); } \
        if ((k) + 1 < p.ph_hi) { if ((k) == 0 && p.ph_hi > NPHASE) cg::this_grid().sync(); else xcd_barrier(xb); } }
    PHASE(0) PHASE(1) PHASE(2) PHASE(3) PHASE(4) PHASE(5) PHASE(6) PHASE(7) PHASE(8) PHASE(9)
    PHASE(10) PHASE(11) PHASE(12) PHASE(13) PHASE(14) PHASE(15) PHASE(16) PHASE(17) PHASE(18)
#undef PHASE
}

extern "C" void kernel_launch(void* const* d_in, const int* in_sizes, int n_in, void* d_out, int out_size, void* d_ws, size_t ws_size, hipStream_t stream) {
    static int grid = 0;
    if (grid == 0) {
        if (n_in != 34 || ws_size < WS_END) { fprintf(stderr, "kernel_launch: expected 34 inputs and >= %zu bytes of workspace; got %d, %zu\n", (size_t)WS_END, n_in, ws_size); grid = -1; return; }
        int dev = 0, cus = 0, per_cu = 0;
        hipGetDevice(&dev);
        hipDeviceGetAttribute(&cus, hipDeviceAttributeMultiprocessorCount, dev);
        if (hipFuncSetAttribute((const void*)fwd_kernel, hipFuncAttributeMaxDynamicSharedMemorySize, LDS_BYTES) != hipSuccess) { fprintf(stderr, "kernel_launch: hipFuncSetAttribute failed\n"); grid = -1; return; }
        hipOccupancyMaxActiveBlocksPerMultiprocessor(&per_cu, (const void*)fwd_kernel, 512, LDS_BYTES);
        if (per_cu < 1) { fprintf(stderr, "kernel_launch: occupancy query says %d blocks per CU\n", per_cu); per_cu = 1; }
        (void)hipGetLastError();
        grid = cus;
        if (grid % 8 != 0 || grid <= 0) grid = 256;
    }
    if (grid < 0) return;
    if (hipMemsetAsync((unsigned char*)d_ws + WS_BAR, 0, 16384, stream) != hipSuccess) { fprintf(stderr, "kernel_launch: memset of the barrier words failed\n"); return; }
    Params p{};
    for (int i = 0; i < 34; ++i) p.in[i] = (const float*)d_in[i];
    p.out = (float*)d_out; p.ws = (unsigned char*)d_ws;
#if N_SPLIT
    for (int ph = 0; ph < NPHASE; ++ph) { p.ph_lo = ph; p.ph_hi = ph + 1; hipLaunchKernelGGL(fwd_kernel, dim3(grid), dim3(512), LDS_BYTES, stream, p); }
#else
    p.ph_lo = 0; p.ph_hi = NPHASE;
    void* args[] = {&p};
    hipError_t e = hipLaunchCooperativeKernel((const void*)fwd_kernel, dim3(grid), dim3(512), args, LDS_BYTES, stream);
    if (e != hipSuccess) fprintf(stderr, "cooperative launch failed: %s (grid %d)\n", hipGetErrorString(e), grid);
#endif
}
```

```cpp
#include <hip/hip_runtime.h>
#include <hip/hip_cooperative_groups.h>
#include <cstdio>
#include <cstdint>
namespace cg = cooperative_groups;

#define LAS __attribute__((address_space(3)))
typedef unsigned short bf16_t;
typedef short bf16x8 __attribute__((ext_vector_type(8)));
typedef short s16x4 __attribute__((ext_vector_type(4)));
typedef float f32x4 __attribute__((ext_vector_type(4)));
typedef float f32x2 __attribute__((ext_vector_type(2)));
typedef unsigned u32x4 __attribute__((ext_vector_type(4)));
typedef unsigned u32x2 __attribute__((ext_vector_type(2)));

#ifndef N_SPLIT
#define N_SPLIT 0
#endif

constexpr int NTOK = 16384, DM = 1024, NPR = 8192;
constexpr float ALPHA_C = 1.41421356237309515f;
constexpr float ATTN_SCALE_C = 0.08838834764831845f;
constexpr float LN_EPS_C = 1e-6f;
constexpr int LDS_BYTES = 147456;
constexpr int NPHASE = 19;

constexpr size_t MB = 1024ull * 1024ull;
constexpr size_t WS_BTUP = 0;
constexpr size_t WS_BTDN = WS_BTUP + 256 * MB;
constexpr size_t WS_ABIN = WS_BTDN + 128 * MB;
constexpr size_t WS_ABOUT = WS_ABIN + 4 * MB;
constexpr size_t WS_SGIN = WS_ABOUT + 2 * MB;
constexpr size_t WS_SGOUT = WS_SGIN + 4 * MB;
constexpr size_t WS_SPW = WS_SGOUT + 2 * MB;
constexpr size_t WS_GW = WS_SPW + 262144;
constexpr size_t WS_MODP = WS_GW + 262144;
constexpr size_t WS_MOD = WS_MODP + 2 * MB;
constexpr size_t WS_SP = WS_MOD + 245760;
constexpr size_t WS_ROPE = WS_MOD + 262144;
constexpr size_t WS_CK = WS_ROPE + 32768;
constexpr size_t WS_CV = WS_CK + 524288;
constexpr size_t WS_AFF = WS_CV + 524288;
constexpr size_t WS_TOKSLOT = WS_AFF + 1 * MB;
constexpr size_t WS_SLOTGATE = WS_TOKSLOT + 1 * MB;
constexpr size_t WS_VSTAT = WS_SLOTGATE + 131072;
constexpr size_t WS_H = WS_VSTAT + 2 * MB;
constexpr size_t WS_HMOE = WS_H + 32 * MB;
constexpr size_t WS_XA = WS_HMOE + 32 * MB;
constexpr size_t WS_QKV = WS_XA + 64 * MB;
constexpr size_t WS_Q = WS_QKV;
constexpr size_t WS_K = WS_QKV + 16 * MB;
constexpr size_t WS_V = WS_QKV + 24 * MB;
constexpr size_t WS_XR = WS_QKV + 32 * MB;
constexpr size_t WS_XG = WS_QKV + 48 * MB;
constexpr size_t WS_U = WS_QKV;
constexpr size_t WS_V2 = WS_QKV + 32 * MB;
constexpr size_t WS_MIX = WS_QKV + 64 * MB;
constexpr size_t WS_BIG = WS_MIX + 32 * MB;
constexpr size_t WS_HLF = WS_BIG, WS_HLB = WS_BIG + 32 * MB, WS_PCF = WS_BIG + 64 * MB, WS_PCB = WS_BIG + 96 * MB;
constexpr size_t WS_HID = WS_BIG;
constexpr size_t WS_XGATH = WS_BIG + 128 * MB;
constexpr size_t WS_Y = WS_XGATH + 64 * MB;
constexpr size_t WS_BAR = WS_Y + 64 * MB;
constexpr size_t WS_END = WS_BAR + 16384;

struct Params { const float* in[34]; float* out; unsigned char* ws; int ph_lo, ph_hi; };

enum { I_XP = 0, I_XS, I_CK, I_CV, I_STATE, I_C, I_CCTX, I_MODW, I_MODB, I_LNMG, I_LNMB, I_LNFG, I_LNFB, I_ABIN, I_SINK, I_CONVW, I_CONVB,
       I_WA, I_BA, I_WX, I_BX, I_LAM, I_ABOUT, I_SGIN, I_SGINB, I_SGLNG, I_SGLNB, I_SPW, I_SPB, I_SGOUT, I_ROUTER, I_W1, I_W3, I_W2 };

__device__ __forceinline__ unsigned cvt_pk_bf16(float lo, float hi) { unsigned r; asm volatile("v_cvt_pk_bf16_f32 %0, %1, %2" : "=v"(r) : "v"(lo), "v"(hi)); return r; }
__device__ __forceinline__ float bf2f(unsigned h) { return __builtin_bit_cast(float, h << 16); }
__device__ __forceinline__ float bflo(unsigned w) { return __builtin_bit_cast(float, w << 16); }
__device__ __forceinline__ float bfhi(unsigned w) { return __builtin_bit_cast(float, w & 0xffff0000u); }
__device__ __forceinline__ float wave_sum(float v) {
#pragma unroll
    for (int o = 1; o < 64; o <<= 1) v += __shfl_xor(v, o);
    return v;
}
__device__ __forceinline__ float sigmoidf_(float x) { return __builtin_amdgcn_rcpf(1.f + __builtin_amdgcn_exp2f(x * -1.4426950408889634f)); }
__device__ __forceinline__ float siluf_(float x) { return x * __builtin_amdgcn_rcpf(1.f + __builtin_amdgcn_exp2f(x * -1.4426950408889634f)); }
__device__ __forceinline__ float geluf_(float x) { const float t = x * (-2.3022082f + -0.10294324f * (x * x)); return x * __builtin_amdgcn_rcpf(1.f + __builtin_amdgcn_exp2f(t)); }
__device__ __forceinline__ float one_minus_exp(float x) {
    const float pl = -x * (1.f + x * (0.5f + x * (0.16666667f + x * (0.041666668f + x * (0.0083333338f + x * 0.0013888889f)))));
    return x > -0.5f ? pl : 1.f - __expf(x);
}
__device__ __forceinline__ int cond_of(int row) { return row < NPR ? 0 : 1 + ((row - NPR) >> 11); }
__device__ __forceinline__ int otid() { int t = threadIdx.x; asm volatile("" : "+v"(t)); return t; }
#define LDS_WAIT() asm volatile("s_waitcnt lgkmcnt(0)" ::: "memory")

#define XB_TMO      128
#define XB_XCNT(j)  (256  + 64 * (j))
#define XB_XSUB(j)  (1280 + 64 * (j))
#define XB_XGEN(j)  (2304 + 64 * (j))
#define XB_TOP      3328
#define XB_TOPGEN   3392
#define XCD_BAR_WORDS 3456
#define XB_SPIN_CAP (1u << 18)

__device__ __forceinline__ unsigned xb_ld(unsigned* p)              { return __hip_atomic_load(p, __ATOMIC_RELAXED, __HIP_MEMORY_SCOPE_AGENT); }
__device__ __forceinline__ unsigned xb_add(unsigned* p, unsigned v) { return __hip_atomic_fetch_add(p, v, __ATOMIC_RELAXED, __HIP_MEMORY_SCOPE_AGENT); }
__device__ __forceinline__ unsigned xb_xcc_id() { return (unsigned)__builtin_amdgcn_s_getreg((3 << 11) | 20) & 0xFu; }
#define XB_SPIN(cond, bar) do { unsigned _sp = 0; while (cond) { __builtin_amdgcn_s_sleep(1); \
    if ((++_sp & 255u) == 0u) { if (xb_ld(&(bar)[XB_TMO])) break; if (_sp > XB_SPIN_CAP) { atomicAdd(&(bar)[XB_TMO], 1u); break; } } } } while (0)

struct XcdBarrier {
    unsigned* bar; unsigned x;
    volatile LAS unsigned* st;
};

__device__ __forceinline__ XcdBarrier xcd_barrier_post(unsigned* bar, volatile LAS unsigned* st) {
    XcdBarrier b; b.bar = bar; b.x = xb_xcc_id(); b.st = st;
    if (threadIdx.x == 0) (void)xb_add(&bar[XB_XCNT(b.x)], 1u);
    return b;
}
__device__ __forceinline__ void xcd_barrier_complete(unsigned* bar, unsigned x, unsigned& nloc, unsigned& nx) {
    const unsigned G = gridDim.x * gridDim.y * gridDim.z;
    unsigned sum, cnt, mine, sp = 0u;
    for (;;) {
        sum = 0u; cnt = 0u; mine = 0u;
#pragma unroll
        for (unsigned j = 0; j < 16; ++j) { const unsigned c = xb_ld(&bar[XB_XCNT(j)]); sum += c; cnt += (c > 0u) ? 1u : 0u; mine = (j == x) ? c : mine; }
        if (sum == G) break;
        __builtin_amdgcn_s_sleep(1);
        if ((++sp & 255u) == 0u) { if (xb_ld(&bar[XB_TMO])) break; if (sp > XB_SPIN_CAP) { atomicAdd(&bar[XB_TMO], 1u); break; } }
    }
    nloc = mine > 0u ? mine : 1u; nx = cnt > 0u ? cnt : 1u;
}

__device__ __forceinline__ void xcd_barrier(const XcdBarrier& b) {
    asm volatile("s_waitcnt vmcnt(0)" ::: "memory");
    __syncthreads();
    if (threadIdx.x == 0) {
        unsigned* bar = b.bar;
        __builtin_amdgcn_s_waitcnt(0);
        unsigned nloc = b.st[0], nx = b.st[1];
        if (nloc == 0u) { xcd_barrier_complete(bar, b.x, nloc, nx); b.st[0] = nloc; b.st[1] = nx; }
        const unsigned old = xb_add(&bar[XB_XSUB(b.x)], 1u);
        const unsigned gen = old / nloc;
        if (old + 1u == (gen + 1u) * nloc) {
            __builtin_amdgcn_fence(__ATOMIC_RELEASE, "agent");
            asm volatile("s_waitcnt vmcnt(0)" ::: "memory");
            const unsigned og = xb_add(&bar[XB_TOP], 1u);
            const unsigned tg = og / nx;
            if (og + 1u == (tg + 1u) * nx) xb_add(&bar[XB_TOPGEN], 1u);
            else XB_SPIN(xb_ld(&bar[XB_TOPGEN]) == tg, bar);
            __builtin_amdgcn_fence(__ATOMIC_ACQUIRE, "agent");
            xb_add(&bar[XB_XGEN(b.x)], 1u);
            asm volatile("s_waitcnt vmcnt(0)" ::: "memory");
        } else {
            XB_SPIN(xb_ld(&bar[XB_XGEN(b.x)]) == gen, bar);
            __builtin_amdgcn_fence(__ATOMIC_ACQUIRE, "agent");
            asm volatile("s_waitcnt vmcnt(0)" ::: "memory");
        }
    }
    __syncthreads();
}

namespace pg8 {
#define PG8_LAS __attribute__((address_space(3)))
constexpr int BM = 256, BK = 64, HALF = 128, HTB = HALF * BK * 2, STAGE_BYTES = 8 * HTB, NXCD = 8, WGM = 8;
__host__ __device__ __forceinline__ int lds_byte(int r, int c) { const int st = (r >> 4) * 2 + (c >> 5), rr = r & 15, cc = c & 31, ob = rr * 64 + cc * 2; return st * 1024 + (ob ^ (((ob >> 9) & 1) << 5)); }
__host__ __device__ __forceinline__ void stage_rc(int b, int& R, int& C) { const int st = b / 1024, sb = b % 1024, swz = sb ^ (((sb >> 9) & 1) << 5); R = (st >> 1) * 16 + swz / 64; C = (st & 1) * 32 + (swz % 64) / 2; }
__host__ __device__ __forceinline__ int perm32(int rho) { const int n = rho >> 4, i = rho & 15; return 8 * (i >> 2) + 4 * n + (i & 3); }
typedef int v4i_t __attribute__((ext_vector_type(4)));
typedef int v8i_t __attribute__((ext_vector_type(8)));
struct Unit { int pm, pn; };
struct Gemm { const bf16_t* A; const bf16_t* Bt; int M, N, K; };
struct StaticOrder {
    int nM, nN, nwg, G, c;
    __host__ __device__ void init(int M, int N, int G_, int c_) { nM = M / BM; nN = N / BM; nwg = nM * nN; G = G_; c = c_; }
    __host__ __device__ bool next(int i, Unit& u) const {
        const long L = (long)i * G + c; if (L >= nwg) return false;
        int wgid = (int)L; { const int q = nwg / NXCD, r = nwg % NXCD, xcd = wgid % NXCD, off = wgid / NXCD; wgid = (xcd < r ? xcd * (q + 1) : r * (q + 1) + (xcd - r) * q) + off; }
        const int nig = WGM * nN, gid = wgid / nig, fm = gid * WGM, gsz = (nM - fm) < WGM ? (nM - fm) : WGM;
        u.pm = fm + ((wgid % nig) % gsz); u.pn = (wgid % nig) / gsz; return true;
    }
    __device__ __forceinline__ void a_ready(const Unit&) const {}
    __device__ __forceinline__ void done(const Unit&) const {}
};
template <int NU, int UPE, int PNE> struct GroupOrder {
    int G, c;
    __device__ __forceinline__ bool next(int i, Unit& u) const {
        const long L = (long)i * G + c; if (L >= NU) return false;
        const int w = ((int)L % NXCD) * (NU / NXCD) + (int)L / NXCD;
        const int e = w / UPE, v = w % UPE;
        u.pm = e * 8 + (v & 7); u.pn = e * PNE + (v >> 3); return true;
    }
    __device__ __forceinline__ void a_ready(const Unit&) const {}
    __device__ __forceinline__ void done(const Unit&) const {}
};
template <class Epi, class Sched, bool ALIGN_EPI = false, bool SP2 = false, bool F8 = false>
__device__ __forceinline__ void gemm_phase(PG8_LAS unsigned char* lds, const Gemm g, const Sched& S, const Epi& E) {
    const int tid = otid(), wid = __builtin_amdgcn_readfirstlane(tid >> 6), lane = tid & 63, wr = wid >> 2, wc = wid & 3, fr = lane & 15, fq = lane >> 4;
    const int K = g.K, nt = K / BK;
    unsigned laneA, uA[2], uB[2];
    { const int sb = lane * 16, swz = sb ^ (((sb >> 9) & 1) << 5), sR = swz / 64, sC = (swz % 64) / 2;
      laneA = (unsigned)(sR * K + sC) * 2u;
#pragma unroll
      for (int i = 0; i < 2; ++i) { const int st = wid + 8 * i;
          uA[i] = (unsigned)(((st >> 1) * 16) * K + (st & 1) * 32) * 2u;
          uB[i] = Epi::PERM ? (unsigned)(((st >> 2) * 32 + 4 * ((st >> 1) & 1)) * K + (st & 1) * 32) * 2u : uA[i]; } }
    const size_t kstep = (size_t)(BK * 2);
    const size_t hstep = (size_t)HALF * K * 2;
    const size_t tstep = 2 * hstep;
    const unsigned ldsw = (unsigned)wid * 1024u;
    const int aoff = lds_byte(wr * 64 + fr, fq * 8), boff = lds_byte(wc * 32 + fr, fq * 8);
#define PG8_SA(b, h) (((b) * 2 + (h)) * HTB)
#define PG8_SB(b, h) ((4 + (b) * 2 + (h)) * HTB)
#define voffA 0
#define voffB 1
#define PG8_STAGE(bufoff, gbase, voff) do { _Pragma("unroll") for (int _i = 0; _i < 2; ++_i) { \
        unsigned vo_ = laneA; asm volatile("" : "+v"(vo_)); if ((voff) == 1 && Epi::PERM) vo_ += (unsigned)((otid() >> 4) & 3) * (unsigned)(8 * K); const unsigned uo_ = ((voff) == 1 ? uB[_i] : uA[_i]); \
        __builtin_amdgcn_global_load_lds((const unsigned*)((const char*)(gbase) + uo_ + vo_), (PG8_LAS unsigned*)(lds + (bufoff) + ldsw + _i * 8192), 16, 0, 0); } } while (0)
#define PG8_LDA(dst, b, h) do { if constexpr (F8) { _Pragma("unroll") for (int m = 0; m < 4; ++m) dst##8[m] = __builtin_shufflevector(*(const PG8_LAS v4i_t*)(lds + PG8_SA(b, h) + aoff + m * 2048), *(const PG8_LAS v4i_t*)(lds + PG8_SA(b, h) + aoff + m * 2048 + 1024), 0, 1, 2, 3, 4, 5, 6, 7); } \
    else { _Pragma("unroll") for (int m = 0; m < 4; ++m) _Pragma("unroll") for (int k = 0; k < 2; ++k) dst[m][k] = *(const PG8_LAS bf16x8*)(lds + PG8_SA(b, h) + aoff + m * 2048 + k * 1024); } } while (0)
#define PG8_LDB(dst, b, h) do { if constexpr (F8) { _Pragma("unroll") for (int n = 0; n < 2; ++n) dst##8[n] = __builtin_shufflevector(*(const PG8_LAS v4i_t*)(lds + PG8_SB(b, h) + boff + n * 2048), *(const PG8_LAS v4i_t*)(lds + PG8_SB(b, h) + boff + n * 2048 + 1024), 0, 1, 2, 3, 4, 5, 6, 7); } \
    else { _Pragma("unroll") for (int n = 0; n < 2; ++n) _Pragma("unroll") for (int k = 0; k < 2; ++k) dst[n][k] = *(const PG8_LAS bf16x8*)(lds + PG8_SB(b, h) + boff + n * 2048 + k * 1024); } } while (0)
#define PG8_MMA(ai, bj, At, Bt) do { __builtin_amdgcn_s_setprio(1); _Pragma("unroll") for (int m = 0; m < 4; ++m) _Pragma("unroll") for (int n = 0; n < 2; ++n) { \
        if constexpr (F8) asm volatile("v_mfma_scale_f32_16x16x128_f8f6f4 %0, %1, %2, %0, %3, %3 op_sel_hi:[0,0,0]" : "+a"(acc[ai][bj][m][n]) : "v"(Bt##8[n]), "v"(At##8[m]), "v"(sc127)); \
        else { _Pragma("unroll") for (int k = 0; k < 2; ++k) asm volatile("v_mfma_f32_16x16x32_bf16 %0, %1, %2, %0" : "+a"(acc[ai][bj][m][n]) : "v"(Bt[n][k]), "v"(At[m][k])); } } \
        __builtin_amdgcn_s_setprio(0); } while (0)
#define PG8_WAIT_V(n) asm volatile("s_waitcnt vmcnt(" #n ")" ::: "memory")
#define PG8_WAIT_L(n) asm volatile("s_waitcnt lgkmcnt(" #n ")" ::: "memory")
#define PG8_BAR __builtin_amdgcn_s_barrier()
#define PG8_SCHED __builtin_amdgcn_sched_barrier(0)
    Unit cur, nxt; int ui = 0;
    if (!S.next(0, cur)) return;
    f32x4 acc[2][2][4][2];
#pragma unroll
    for (int a = 0; a < 2; ++a)
#pragma unroll
        for (int b = 0; b < 2; ++b)
#pragma unroll
            for (int m = 0; m < 4; ++m)
#pragma unroll
                for (int n = 0; n < 2; ++n) acc[a][b][m][n] = (f32x4){0.f, 0.f, 0.f, 0.f};
    bf16x8 At[4][2], B0[2][2], B1[2][2]; v8i_t At8[4], B08[2], B18[2]; const int sc127 = 0x7f7f7f7f;
    const char* cA = (const char*)g.A + (size_t)cur.pm * tstep; const char* cB = (const char*)g.Bt + (size_t)cur.pn * tstep;
    S.a_ready(cur);
    if constexpr (SP2) {
        PG8_STAGE(PG8_SB(0, 0), cB, voffB); PG8_STAGE(PG8_SB(0, 1), cB + hstep, voffB); PG8_STAGE(PG8_SA(0, 0), cA, voffA); PG8_STAGE(PG8_SA(0, 1), cA + hstep, voffA);
        if (wr == 1) PG8_BAR;
        PG8_WAIT_V(2); PG8_BAR;
        PG8_STAGE(PG8_SB(1, 0), cB + kstep, voffB); PG8_STAGE(PG8_SA(1, 0), cA + kstep, voffA); PG8_STAGE(PG8_SB(1, 1), cB + hstep + kstep, voffB);
        PG8_WAIT_V(6); PG8_BAR;
    } else {
        PG8_STAGE(PG8_SB(0, 0), cB, voffB); PG8_STAGE(PG8_SA(0, 0), cA, voffA); PG8_STAGE(PG8_SB(0, 1), cB + hstep, voffB); PG8_STAGE(PG8_SA(0, 1), cA + hstep, voffA);
        if (wr == 1) PG8_BAR;
        PG8_WAIT_V(4); PG8_BAR;
        PG8_STAGE(PG8_SB(1, 0), cB + kstep, voffB); PG8_STAGE(PG8_SA(1, 0), cA + kstep, voffA); PG8_STAGE(PG8_SB(1, 1), cB + hstep + kstep, voffB);
        PG8_WAIT_V(6); PG8_BAR;
    }
    for (;;) {
        const bool has_next = S.next(ui + 1, nxt);
        const char* nA = has_next ? (const char*)g.A + (size_t)nxt.pm * tstep : cA; const char* nB = has_next ? (const char*)g.Bt + (size_t)nxt.pn * tstep : cB;
#pragma nounroll
        for (int t = 0; t < nt; t += 2) {
            const bool last = (t == nt - 2);
            const char* a1 = cA + (size_t)(t + 1) * kstep;
            const char* a2 = last ? nA : cA + (size_t)(t + 2) * kstep; const char* b2 = last ? nB : cB + (size_t)(t + 2) * kstep;
            const char* a3 = a2 + kstep; const char* b3 = b2 + kstep;
            if (last && has_next) S.a_ready(nxt);
            if constexpr (SP2) {
            PG8_LDB(B0, 0, 0); PG8_LDB(B1, 0, 1); PG8_SCHED; PG8_LDA(At, 0, 0); PG8_STAGE(PG8_SA(1, 1), a1 + hstep, voffA);
            PG8_WAIT_V(8); PG8_WAIT_L(0); PG8_BAR; PG8_MMA(0, 0, At, B0); PG8_MMA(0, 1, At, B1); PG8_BAR; PG8_SCHED;
            PG8_LDA(At, 0, 1); PG8_STAGE(PG8_SB(0, 0), b2, voffB); PG8_STAGE(PG8_SB(0, 1), b2 + hstep, voffB); PG8_STAGE(PG8_SA(0, 0), a2, voffA);
            PG8_WAIT_V(8); PG8_WAIT_L(0); PG8_BAR; PG8_MMA(1, 0, At, B0); PG8_MMA(1, 1, At, B1); PG8_BAR; PG8_SCHED;
            PG8_LDB(B0, 1, 0); PG8_LDB(B1, 1, 1); PG8_SCHED; PG8_LDA(At, 1, 0); PG8_STAGE(PG8_SA(0, 1), a2 + hstep, voffA);
            PG8_WAIT_V(8); PG8_WAIT_L(0); PG8_BAR; PG8_MMA(0, 0, At, B0); PG8_MMA(0, 1, At, B1); PG8_BAR; PG8_SCHED;
            PG8_LDA(At, 1, 1); PG8_STAGE(PG8_SB(1, 0), b3, voffB); PG8_STAGE(PG8_SB(1, 1), b3 + hstep, voffB); PG8_STAGE(PG8_SA(1, 0), a3, voffA);
            PG8_WAIT_V(8); PG8_WAIT_L(0); PG8_BAR; PG8_MMA(1, 0, At, B0); PG8_MMA(1, 1, At, B1); PG8_BAR; PG8_SCHED;
            } else {
            PG8_LDB(B0, 0, 0); PG8_SCHED; PG8_LDA(At, 0, 0); PG8_STAGE(PG8_SA(1, 1), a1 + hstep, voffA);
            PG8_WAIT_L(8); PG8_BAR; PG8_WAIT_L(0); PG8_MMA(0, 0, At, B0); PG8_BAR; PG8_SCHED;
            PG8_LDB(B1, 0, 1); PG8_STAGE(PG8_SB(0, 0), b2, voffB);
            PG8_BAR; PG8_WAIT_L(0); PG8_MMA(0, 1, At, B1); PG8_BAR;
            PG8_LDA(At, 0, 1); PG8_STAGE(PG8_SA(0, 0), a2, voffA);
            PG8_BAR; PG8_WAIT_L(0); PG8_MMA(1, 0, At, B0); PG8_BAR; PG8_SCHED;
            PG8_STAGE(PG8_SB(0, 1), b2 + hstep, voffB);
            PG8_WAIT_V(6); PG8_BAR; PG8_MMA(1, 1, At, B1); PG8_BAR;
            PG8_LDB(B0, 1, 0); PG8_SCHED; PG8_LDA(At, 1, 0); PG8_STAGE(PG8_SA(0, 1), a2 + hstep, voffA);
            PG8_WAIT_L(8); PG8_BAR; PG8_WAIT_L(0); PG8_MMA(0, 0, At, B0); PG8_BAR; PG8_SCHED;
            PG8_LDB(B1, 1, 1); PG8_STAGE(PG8_SB(1, 0), b3, voffB);
            PG8_BAR; PG8_WAIT_L(0); PG8_MMA(0, 1, At, B1); PG8_BAR;
            PG8_LDA(At, 1, 1); PG8_STAGE(PG8_SA(1, 0), a3, voffA);
            PG8_BAR; PG8_WAIT_L(0); PG8_MMA(1, 0, At, B0); PG8_BAR; PG8_SCHED;
            PG8_STAGE(PG8_SB(1, 1), b3 + hstep, voffB);
            PG8_WAIT_V(6); PG8_BAR; PG8_MMA(1, 1, At, B1); PG8_BAR;
            }
        }
        asm volatile("s_nop 15\n\ts_nop 15" ::: "memory");
        if constexpr (ALIGN_EPI) { if (wr == 0) PG8_BAR; }
        if constexpr (!Epi::AFTER_DRAIN) { const int t2_ = otid(); int fr_ = t2_ & 15, fq_ = (t2_ >> 4) & 3, wr_ = wr, wc_ = wc; asm volatile("" : "+s"(wr_), "+s"(wc_)); E(acc, cur, wr_, wc_, fr_, fq_); S.done(cur); }
        if (!has_next) break;
#pragma unroll
        for (int a = 0; a < 2; ++a)
#pragma unroll
            for (int b = 0; b < 2; ++b)
#pragma unroll
                for (int m = 0; m < 4; ++m)
#pragma unroll
                    for (int n = 0; n < 2; ++n) acc[a][b][m][n] = (f32x4){0.f, 0.f, 0.f, 0.f};
        cur = nxt; cA = nA; cB = nB; ++ui;
        if constexpr (ALIGN_EPI) { if (wr == 1) PG8_BAR; }
    }
    PG8_WAIT_V(0);
    if constexpr (!ALIGN_EPI) { if (wr == 0) PG8_BAR; }
    PG8_BAR;
    if constexpr (Epi::AFTER_DRAIN) { E.fused(acc, cur, wr, wc, fr, fq, lds, wid, lane); S.done(cur); }
#undef PG8_SA
#undef PG8_SB
#undef PG8_STAGE
#undef voffA
#undef voffB
#undef PG8_LDA
#undef PG8_LDB
#undef PG8_MMA
#undef PG8_WAIT_V
#undef PG8_WAIT_L
#undef PG8_BAR
#undef PG8_SCHED
}
}
using pg8::Unit;
struct EpiIn {
    static constexpr bool PERM = true, AFTER_DRAIN = false;
    bf16_t *Q, *Kb, *Vb, *XR, *XGb; float *outK, *outV; const float* rope;
    __device__ __forceinline__ void operator()(const f32x4 (&acc)[2][2][4][2], const Unit& u, int wr, int wc, int fr, int fq) const {
        const int pn = u.pn; const bool sample = u.pm >= 32;
        bf16_t* dbase; int dstride;
        if (pn <= 1) { dbase = Q + pn * 256; dstride = 512; }
        else if (pn == 2) { dbase = Kb; dstride = 256; }
        else if (pn == 3) { dbase = Vb; dstride = 256; }
        else if (pn <= 5) { dbase = XR + (pn - 4) * 256; dstride = 512; }
        else { dbase = XGb + (pn - 6) * 256; dstride = 512; }
        const bool dorope = sample && pn <= 2;
        float* fout = (!sample && (pn == 2 || pn == 3)) ? (pn == 2 ? outK : outV) : nullptr;
        const int rbase = u.pm * 256 + wr * 64 + fr;
        const float* tcol = rope + ((wc & 1) * 16 + fq * 4) * 2;
#define EPIIN_LD(it_, d0_, d1_) do { const int row_ = rbase + ((it_) >> 2) * 128 + ((it_) & 3) * 16, pos_ = (row_ - NPR) & 2047; \
            const int trow_ = dorope ? ((wc < 2) ? (pos_ >> 6) : (32 + (pos_ & 63))) : 96; const float* tp_ = tcol + (size_t)trow_ * 64; d0_ = *(const f32x4*)tp_; d1_ = *(const f32x4*)(tp_ + 4); } while (0)
        f32x4 cs[2][2];
        EPIIN_LD(0, cs[0][0], cs[0][1]);
#pragma unroll
        for (int it = 0; it < 8; ++it) {
            const int ai = it >> 2, m = it & 3, row = rbase + ai * 128 + m * 16;
            if (it < 7) EPIIN_LD(it + 1, cs[(it + 1) & 1][0], cs[(it + 1) & 1][1]);
            __builtin_amdgcn_sched_barrier(0);
            const f32x4 cs0 = cs[it & 1][0], cs1 = cs[it & 1][1];
#pragma unroll
            for (int bj = 0; bj < 2; ++bj) {
                const f32x4 v0 = acc[ai][bj][m][0], v1 = acc[ai][bj][m][1];
                const int ct = bj * 128 + wc * 32 + fq * 8;
                f32x4 r0, r1;
                r0.x = v0.x * cs0.x - v0.y * cs0.y; r0.y = v0.x * cs0.y + v0.y * cs0.x;
                r0.z = v0.z * cs0.z - v0.w * cs0.w; r0.w = v0.z * cs0.w + v0.w * cs0.z;
                r1.x = v1.x * cs1.x - v1.y * cs1.y; r1.y = v1.x * cs1.y + v1.y * cs1.x;
                r1.z = v1.z * cs1.z - v1.w * cs1.w; r1.w = v1.z * cs1.w + v1.w * cs1.z;
                u32x4 o; o.x = cvt_pk_bf16(r0.x, r0.y); o.y = cvt_pk_bf16(r0.z, r0.w); o.z = cvt_pk_bf16(r1.x, r1.y); o.w = cvt_pk_bf16(r1.z, r1.w);
                *(u32x4*)(dbase + (size_t)row * dstride + ct) = o;
                if (fout) { float* op = fout + (size_t)row * 256 + ct; *(f32x4*)op = r0; *(f32x4*)(op + 4) = r1; }
            }
        }
#undef EPIIN_LD
    }
};
template <bool XB16> struct EpiOut {
    static constexpr bool PERM = false, AFTER_DRAIN = false;
    const float *xin_p, *xin_s; bf16_t* XA; const float* modl;
    __device__ __forceinline__ void operator()(const f32x4 (&acc)[2][2][4][2], const Unit& u, int wr, int wc, int fr, int fq) const {
        const int rbase = u.pm * 256 + wr * 64 + fr, cbase = u.pn * 256 + wc * 32 + fq * 4;
        const float* gp = modl + (size_t)cond_of(u.pm * 256) * 6144 + 2 * 1024 + cbase;
        const float* xb = (u.pm < 32 ? xin_p + (size_t)rbase * DM : xin_s + (size_t)(rbase - NPR) * DM) + cbase;
        const bf16_t* xh = XA + (size_t)rbase * DM + cbase;
        f32x4 gv[2][2];
#pragma unroll
        for (int bj = 0; bj < 2; ++bj)
#pragma unroll
            for (int n = 0; n < 2; ++n) gv[bj][n] = *(const f32x4*)(gp + bj * 128 + n * 16);
#define EPIOUT_LD(it_, d_) do { const size_t ro_ = (size_t)(((it_) >> 2) * 128 + ((it_) & 3) * 16) * DM; \
            if constexpr (XB16) { const bf16_t* xr_ = xh + ro_; const u32x2 w0_ = *(const u32x2*)(xr_), w1_ = *(const u32x2*)(xr_ + 16), w2_ = *(const u32x2*)(xr_ + 128), w3_ = *(const u32x2*)(xr_ + 144); \
                d_[0] = (f32x4){bflo(w0_.x), bfhi(w0_.x), bflo(w0_.y), bfhi(w0_.y)}; d_[1] = (f32x4){bflo(w1_.x), bfhi(w1_.x), bflo(w1_.y), bfhi(w1_.y)}; \
                d_[2] = (f32x4){bflo(w2_.x), bfhi(w2_.x), bflo(w2_.y), bfhi(w2_.y)}; d_[3] = (f32x4){bflo(w3_.x), bfhi(w3_.x), bflo(w3_.y), bfhi(w3_.y)}; } \
            else { const float* xr_ = xb + ro_; d_[0] = *(const f32x4*)(xr_); d_[1] = *(const f32x4*)(xr_ + 16); d_[2] = *(const f32x4*)(xr_ + 128); d_[3] = *(const f32x4*)(xr_ + 144); } } while (0)
        f32x4 xv[2][4];
        EPIOUT_LD(0, xv[0]);
#pragma unroll
        for (int it = 0; it < 8; ++it) {
            const int ai = it >> 2, m = it & 3, row = rbase + ai * 128 + m * 16;
            if (it < 7) EPIOUT_LD(it + 1, xv[(it + 1) & 1]);
            __builtin_amdgcn_sched_barrier(0);
#pragma unroll
            for (int bj = 0; bj < 2; ++bj)
#pragma unroll
                for (int n = 0; n < 2; ++n) {
                    const f32x4 y = xv[it & 1][bj * 2 + n] * ALPHA_C + gv[bj][n] * acc[ai][bj][m][n];
                    u32x2 o; o.x = cvt_pk_bf16(y.x, y.y); o.y = cvt_pk_bf16(y.z, y.w);
                    *(u32x2*)(XA + (size_t)row * DM + cbase + bj * 128 + n * 16) = o;
                }
        }
#undef EPIOUT_LD
    }
};
__device__ __forceinline__ unsigned pk4_fp8(float a, float b, float c, float d) { unsigned w = 0u; asm volatile("v_cvt_pk_fp8_f32 %0, %1, %2" : "+v"(w) : "v"(a), "v"(b)); asm volatile("v_cvt_pk_fp8_f32 %0, %1, %2 op_sel:[0,0,1]" : "+v"(w) : "v"(c), "v"(d)); return w; }
constexpr float W13_SCALE = 32.f, W2_SCALE = 64.f;
struct EpiUp {
    static constexpr bool PERM = true, AFTER_DRAIN = false;
    unsigned char* Hid;
    __device__ __forceinline__ void operator()(const f32x4 (&acc)[2][2][4][2], const Unit& u, int wr, int wc, int fr, int fq) const {
        const int pnl = u.pn & 15; constexpr float ds = 1.f / W13_SCALE;
#pragma unroll
        for (int ai = 0; ai < 2; ++ai)
#pragma unroll
            for (int m = 0; m < 4; ++m) {
                const int row = u.pm * 256 + ai * 128 + wr * 64 + m * 16 + fr;
                __builtin_amdgcn_sched_barrier(0);
                const f32x4 a0 = acc[ai][0][m][0] * ds, a1 = acc[ai][0][m][1] * ds, b0 = acc[ai][1][m][0] * ds, b1 = acc[ai][1][m][1] * ds;
                u32x2 o;
                o.x = pk4_fp8(siluf_(a0.x) * b0.x, siluf_(a0.y) * b0.y, siluf_(a0.z) * b0.z, siluf_(a0.w) * b0.w);
                o.y = pk4_fp8(siluf_(a1.x) * b1.x, siluf_(a1.y) * b1.y, siluf_(a1.z) * b1.z, siluf_(a1.w) * b1.w);
                *(u32x2*)(Hid + (size_t)row * 2048 + pnl * 128 + wc * 32 + fq * 8) = o;
            }
    }
};
struct EpiDn {
    static constexpr bool PERM = true, AFTER_DRAIN = false;
    bf16_t* Y; const float* gate;
    __device__ __forceinline__ void operator()(const f32x4 (&acc)[2][2][4][2], const Unit& u, int wr, int wc, int fr, int fq) const {
        const int pnl = u.pn & 3, rbase = u.pm * 256 + wr * 64 + fr;
        float gg[8];
#pragma unroll
        for (int it = 0; it < 8; ++it) gg[it] = gate[rbase + (it >> 2) * 128 + (it & 3) * 16] * (1.f / W2_SCALE);
#pragma unroll
        for (int it = 0; it < 8; ++it) {
            const int ai = it >> 2, m = it & 3, row = rbase + ai * 128 + m * 16;
            __builtin_amdgcn_sched_barrier(0);
            const float g = gg[it];
#pragma unroll
            for (int bj = 0; bj < 2; ++bj) {
                const f32x4 v0 = acc[ai][bj][m][0] * g, v1 = acc[ai][bj][m][1] * g;
                u32x4 o; o.x = cvt_pk_bf16(v0.x, v0.y); o.y = cvt_pk_bf16(v0.z, v0.w); o.z = cvt_pk_bf16(v1.x, v1.y); o.w = cvt_pk_bf16(v1.z, v1.w);
                *(u32x4*)(Y + (size_t)row * DM + pnl * 256 + bj * 128 + wc * 32 + fq * 8) = o;
            }
        }
    }
};
struct EpiSgu {
    static constexpr bool PERM = true, AFTER_DRAIN = false;
    bf16_t *U, *V2; float* vstat; const float* bias;
    __device__ __forceinline__ void operator()(const f32x4 (&acc)[2][2][4][2], const Unit& u, int wr, int wc, int fr, int fq) const {
        const int pn = u.pn; const bool isv = pn >= 4;
        bf16_t* dbase = (isv ? V2 : U) + (pn & 3) * 256;
        f32x4 bvv[2][2];
#pragma unroll
        for (int bj = 0; bj < 2; ++bj) { const float* bp = bias + pn * 256 + bj * 128 + wc * 32 + fq * 8; bvv[bj][0] = *(const f32x4*)bp; bvv[bj][1] = *(const f32x4*)(bp + 4); }
#pragma unroll
        for (int ai = 0; ai < 2; ++ai)
#pragma unroll
            for (int m = 0; m < 4; ++m) {
                const int row = u.pm * 256 + ai * 128 + wr * 64 + m * 16 + fr;
                __builtin_amdgcn_sched_barrier(0);
                float s1 = 0.f, s2 = 0.f;
#pragma unroll
                for (int bj = 0; bj < 2; ++bj) {
                    const int ct = bj * 128 + wc * 32 + fq * 8, c = pn * 256 + ct;
                    f32x4 v0 = acc[ai][bj][m][0] + bvv[bj][0], v1 = acc[ai][bj][m][1] + bvv[bj][1];
                    v0.x = geluf_(v0.x); v0.y = geluf_(v0.y); v0.z = geluf_(v0.z); v0.w = geluf_(v0.w);
                    v1.x = geluf_(v1.x); v1.y = geluf_(v1.y); v1.z = geluf_(v1.z); v1.w = geluf_(v1.w);
                    u32x4 o; o.x = cvt_pk_bf16(v0.x, v0.y); o.y = cvt_pk_bf16(v0.z, v0.w); o.z = cvt_pk_bf16(v1.x, v1.y); o.w = cvt_pk_bf16(v1.z, v1.w);
                    *(u32x4*)(dbase + (size_t)row * DM + ct) = o;
                    s1 += (v0.x + v0.y) + (v0.z + v0.w) + (v1.x + v1.y) + (v1.z + v1.w);
                    s2 += (v0.x * v0.x + v0.y * v0.y) + (v0.z * v0.z + v0.w * v0.w) + (v1.x * v1.x + v1.y * v1.y) + (v1.z * v1.z + v1.w * v1.w);
                }
                { const int ln = fq * 16 + fr, i16 = (ln ^ 16) << 2, i32 = (ln ^ 32) << 2;
                  s1 += __builtin_bit_cast(float, __builtin_amdgcn_ds_bpermute(i16, __builtin_bit_cast(int, s1))); s2 += __builtin_bit_cast(float, __builtin_amdgcn_ds_bpermute(i16, __builtin_bit_cast(int, s2)));
                  s1 += __builtin_bit_cast(float, __builtin_amdgcn_ds_bpermute(i32, __builtin_bit_cast(int, s1))); s2 += __builtin_bit_cast(float, __builtin_amdgcn_ds_bpermute(i32, __builtin_bit_cast(int, s2))); }
                if (isv && fq == 0) { f32x2 st; st.x = s1; st.y = s2; *(f32x2*)(vstat + ((size_t)row * 16 + (pn - 4) * 4 + wc) * 2) = st; }
            }
    }
};
__device__ __forceinline__ void tr_item(const float* __restrict__ src, int N, bf16_t* dst, int Kd, int k0, int n0, int drow0, LAS float* scr, int lane) {
    f32x4 v[16];
    const float* s = src + (size_t)(k0 + (lane >> 4)) * N + n0 + (lane & 15) * 4;
#pragma unroll
    for (int i = 0; i < 16; ++i) v[i] = __builtin_nontemporal_load((const f32x4*)(s + (size_t)i * 4 * N));
#pragma unroll
    for (int i = 0; i < 16; ++i) { LAS float* d = scr + (i * 4 + (lane >> 4)) * 65 + (lane & 15) * 4; d[0] = v[i].x; d[1] = v[i].y; d[2] = v[i].z; d[3] = v[i].w; }
    LDS_WAIT(); __builtin_amdgcn_wave_barrier();
    const int c = lane & 7;
#pragma unroll
    for (int j = 0; j < 8; ++j) {
        const int n = (lane >> 3) + 8 * j; const LAS float* r = scr + (8 * c) * 65 + n;
        u32x4 o; o.x = cvt_pk_bf16(r[0], r[65]); o.y = cvt_pk_bf16(r[2 * 65], r[3 * 65]); o.z = cvt_pk_bf16(r[4 * 65], r[5 * 65]); o.w = cvt_pk_bf16(r[6 * 65], r[7 * 65]);
        *(u32x4*)(dst + (size_t)(drow0 + n) * Kd + k0 + 8 * c) = o;
    }
    LDS_WAIT(); __builtin_amdgcn_wave_barrier();
}
__device__ __forceinline__ void tr_item8(const float* __restrict__ src, int N, unsigned char* dst, int Kd, int k0, int n0, int drow0, float sc, LAS float* scr, int lane) {
    f32x4 v[16];
    const float* s = src + (size_t)(k0 + (lane >> 4)) * N + n0 + (lane & 15) * 4;
#pragma unroll
    for (int i = 0; i < 16; ++i) v[i] = *(const f32x4*)(s + (size_t)i * 4 * N);
#pragma unroll
    for (int i = 0; i < 16; ++i) { LAS float* d = scr + (i * 4 + (lane >> 4)) * 65 + (lane & 15) * 4; d[0] = v[i].x * sc; d[1] = v[i].y * sc; d[2] = v[i].z * sc; d[3] = v[i].w * sc; }
    LDS_WAIT(); __builtin_amdgcn_wave_barrier();
    const int c = lane & 3;
#pragma unroll
    for (int j = 0; j < 4; ++j) {
        const int n = (lane >> 2) + 16 * j; const LAS float* r = scr + (16 * c) * 65 + n;
        u32x4 o; o.x = pk4_fp8(r[0], r[65], r[2 * 65], r[3 * 65]); o.y = pk4_fp8(r[4 * 65], r[5 * 65], r[6 * 65], r[7 * 65]);
        o.z = pk4_fp8(r[8 * 65], r[9 * 65], r[10 * 65], r[11 * 65]); o.w = pk4_fp8(r[12 * 65], r[13 * 65], r[14 * 65], r[15 * 65]);
        *(u32x4*)(dst + (size_t)(drow0 + n) * Kd + k0 + 16 * c) = o;
    }
    LDS_WAIT(); __builtin_amdgcn_wave_barrier();
}
__device__ __forceinline__ void cvt_item512(const float* __restrict__ src, bf16_t* dst, int item, int lane) {
    const size_t i = (size_t)item * 512 + lane * 8;
    const f32x4 a = __builtin_nontemporal_load((const f32x4*)(src + i)), b = __builtin_nontemporal_load((const f32x4*)(src + i + 4));
    u32x4 o; o.x = cvt_pk_bf16(a.x, a.y); o.y = cvt_pk_bf16(a.z, a.w); o.z = cvt_pk_bf16(b.x, b.y); o.w = cvt_pk_bf16(b.z, b.w);
    *(u32x4*)(dst + i) = o;
}
struct MoeItem { const float* s; size_t rowstep; unsigned char* dst; int Kd; float sc; };
__device__ __forceinline__ MoeItem moe_item(const Params& p, int r, int lane) {
    MoeItem m; unsigned char* ws = p.ws;
    if (r < 32768) {
        const int w3 = r >= 16384; const int q = w3 ? r - 16384 : r;
        const int mat = q >> 9, rr = q & 511, n0 = (rr & 31) * 64, k0 = (rr >> 5) * 64;
        m.s = p.in[w3 ? I_W3 : I_W1] + (size_t)mat * 1024 * 2048 + (size_t)(k0 + (lane >> 4)) * 2048 + n0 + (lane & 15) * 4; m.rowstep = (size_t)4 * 2048;
        m.dst = ws + WS_BTUP + (size_t)mat * 4096 * 1024 + (size_t)((n0 >> 7) * 256 + (n0 & 127) + w3 * 128) * 1024 + k0; m.Kd = 1024; m.sc = W13_SCALE;
    } else {
        const int q = r - 32768, mat = q >> 9, rr = q & 511, n0 = (rr & 15) * 64, k0 = (rr >> 4) * 64;
        m.s = p.in[I_W2] + (size_t)mat * 2048 * 1024 + (size_t)(k0 + (lane >> 4)) * 1024 + n0 + (lane & 15) * 4; m.rowstep = (size_t)4 * 1024;
        m.dst = ws + WS_BTDN + (size_t)mat * 1024 * 2048 + (size_t)n0 * 2048 + k0; m.Kd = 2048; m.sc = W2_SCALE;
    }
    return m;
}
__device__ __forceinline__ void phase_p0(const Params& p, LAS unsigned char* lds) {
    const int tid = otid(), lane = tid & 63, wave = tid >> 6;
    LAS float* scr = (LAS float*)(lds + wave * 16640);
    unsigned char* ws = p.ws;
    const int gw = blockIdx.x * 8 + wave, NGW = gridDim.x * 8;
    constexpr int N_MOD = 1536, N_ABIN = 512, N_ABOUT = 256, N_SGIN = 512, N_SGOUT = 256, N_GW = 32, N_CVT = 512, N_CK = 512, N_SPW = 256, N_ROPE = 49, N_SP = 16;
    constexpr int TOTAL = N_MOD + N_ABIN + N_ABOUT + N_SGIN + N_SGOUT + N_GW + N_CVT + N_CK + N_SPW + N_ROPE + N_SP;
    for (int it = gw; it < TOTAL; it += NGW) {
        int r = it;
        if (r < N_MOD) {
            const int l = r / 768, rem = r % 768, cgp = rem >> 3, kp = rem & 7, n = cgp * 64 + lane;
            const float* w = p.in[I_MODW] + ((size_t)l * 1024 + 128 * kp) * 6144 + n;
            const float* cc = p.in[I_C]; const float* cx = p.in[I_CCTX];
            const int ka = 128 * kp + lane;
            const float s0a = siluf_(cx[ka]), s0b = siluf_(cx[ka + 64]), s1a = siluf_(cc[ka]), s1b = siluf_(cc[ka + 64]), s2a = siluf_(cc[1024 + ka]), s2b = siluf_(cc[1024 + ka + 64]);
            const float s3a = siluf_(cc[2048 + ka]), s3b = siluf_(cc[2048 + ka + 64]), s4a = siluf_(cc[3072 + ka]), s4b = siluf_(cc[3072 + ka + 64]);
            float a0 = 0.f, a1 = 0.f, a2 = 0.f, a3 = 0.f, a4 = 0.f;
#pragma unroll 8
            for (int k = 0; k < 64; ++k) {
                const float wa = __builtin_nontemporal_load(w + (size_t)k * 6144), wb = __builtin_nontemporal_load(w + (size_t)(k + 64) * 6144);
                a0 += __builtin_bit_cast(float, __builtin_amdgcn_readlane(__builtin_bit_cast(int, s0a), k)) * wa + __builtin_bit_cast(float, __builtin_amdgcn_readlane(__builtin_bit_cast(int, s0b), k)) * wb;
                a1 += __builtin_bit_cast(float, __builtin_amdgcn_readlane(__builtin_bit_cast(int, s1a), k)) * wa + __builtin_bit_cast(float, __builtin_amdgcn_readlane(__builtin_bit_cast(int, s1b), k)) * wb;
                a2 += __builtin_bit_cast(float, __builtin_amdgcn_readlane(__builtin_bit_cast(int, s2a), k)) * wa + __builtin_bit_cast(float, __builtin_amdgcn_readlane(__builtin_bit_cast(int, s2b), k)) * wb;
                a3 += __builtin_bit_cast(float, __builtin_amdgcn_readlane(__builtin_bit_cast(int, s3a), k)) * wa + __builtin_bit_cast(float, __builtin_amdgcn_readlane(__builtin_bit_cast(int, s3b), k)) * wb;
                a4 += __builtin_bit_cast(float, __builtin_amdgcn_readlane(__builtin_bit_cast(int, s4a), k)) * wa + __builtin_bit_cast(float, __builtin_amdgcn_readlane(__builtin_bit_cast(int, s4b), k)) * wb;
            }
            float* mp = (float*)(ws + WS_MODP) + (size_t)(kp * 2 + l) * 30720 + n;
            mp[0] = a0; mp[6144] = a1; mp[2 * 6144] = a2; mp[3 * 6144] = a3; mp[4 * 6144] = a4;
            continue;
        }
        r -= N_MOD;
        if (r < N_ABIN) { tr_item(p.in[I_ABIN], 2048, (bf16_t*)(ws + WS_ABIN), 1024, (r >> 5) * 64, (r & 31) * 64, (r & 31) * 64, scr, lane); continue; } r -= N_ABIN;
        if (r < N_ABOUT) { tr_item(p.in[I_ABOUT], 1024, (bf16_t*)(ws + WS_ABOUT), 1024, (r >> 4) * 64, (r & 15) * 64, (r & 15) * 64, scr, lane); continue; } r -= N_ABOUT;
        if (r < N_SGIN) { tr_item(p.in[I_SGIN], 2048, (bf16_t*)(ws + WS_SGIN), 1024, (r >> 5) * 64, (r & 31) * 64, (r & 31) * 64, scr, lane); continue; } r -= N_SGIN;
        if (r < N_SGOUT) { tr_item(p.in[I_SGOUT], 1024, (bf16_t*)(ws + WS_SGOUT), 1024, (r >> 4) * 64, (r & 15) * 64, (r & 15) * 64, scr, lane); continue; } r -= N_SGOUT;
        if (r < N_GW) {
            const int gate = r >> 4, rest = r & 15, dir = rest >> 3, blk = rest & 7;
            tr_item(p.in[gate ? I_WX : I_WA] + (size_t)(dir * 8 + blk) * 4096, 64, (bf16_t*)(ws + WS_GW) + (size_t)((dir * 2 + gate) * 8 + blk) * 4096, 64, 0, 0, 0, scr, lane);
            continue;
        }
        r -= N_GW;
        if (r < N_CVT) { cvt_item512(p.in[I_CV], (bf16_t*)(ws + WS_CV), r, lane); continue; } r -= N_CVT;
        if (r < N_CK) { cvt_item512(p.in[I_CK], (bf16_t*)(ws + WS_CK), r, lane); continue; } r -= N_CK;
        if (r < N_SPW) { cvt_item512(p.in[I_SPW], (bf16_t*)(ws + WS_SPW), r, lane); continue; } r -= N_SPW;
        if (r >= N_ROPE) { const int i = (r - N_ROPE) * 64 + lane; ((float*)(ws + WS_SP))[i] = log1pf(__expf(-p.in[I_LAM][i])); continue; }
        {
            const int idx = r * 64 + lane, pos = idx >> 5, f = idx & 31, pp = pos < 32 ? pos : pos - 32;
            double fr_ = 1.0; for (int i = 0; i < f; ++i) fr_ *= 0.74989420933245582;
            double ang = (double)pp * fr_;
            const double k = __builtin_rint(ang * 0.15915494309189535);
            double x = ang - k * 6.283185307179586; const double x2 = x * x;
            double sn = x, cs = 1.0, ts = x, tc = 1.0;
#pragma unroll
            for (int i = 1; i <= 14; ++i) { tc *= -x2 / (double)((2 * i - 1) * (2 * i)); cs += tc; ts *= -x2 / (double)((2 * i) * (2 * i + 1)); sn += ts; }
            f32x2 o; o.x = (float)cs; o.y = (float)sn;
            if (pos >= 96) { o.x = 1.f; o.y = 0.f; }
            if (idx < 97 * 32) *(f32x2*)((float*)(ws + WS_ROPE) + (size_t)idx * 2) = o;
        }
    }
    constexpr int NMOE = 49152;
    f32x4 va[16], vb[16];
    MoeItem ca, cb;
#define MOE_LOAD(V, C, IT) do { C = moe_item(p, (IT), lane); _Pragma("unroll") for (int i = 0; i < 16; ++i) V[i] = __builtin_nontemporal_load((const f32x4*)(C.s + (size_t)i * C.rowstep)); } while (0)
#define MOE_PROC(V, C, NXT) do { const float sc = C.sc; \
        _Pragma("unroll") for (int i = 0; i < 16; ++i) { LAS float* d = scr + (i * 4 + (lane >> 4)) * 65 + (lane & 15) * 4; d[0] = V[i].x * sc; d[1] = V[i].y * sc; d[2] = V[i].z * sc; d[3] = V[i].w * sc; } \
        unsigned char* cdst = C.dst; const int cKd = C.Kd; \
        if ((NXT) < NMOE) MOE_LOAD(V, C, (NXT)); \
        LDS_WAIT(); __builtin_amdgcn_wave_barrier(); \
        const int c = lane & 3; \
        _Pragma("unroll") for (int j = 0; j < 4; ++j) { const int n = (lane >> 2) + 16 * j; const LAS float* r = scr + (16 * c) * 65 + n; \
            u32x4 o; o.x = pk4_fp8(r[0], r[65], r[2 * 65], r[3 * 65]); o.y = pk4_fp8(r[4 * 65], r[5 * 65], r[6 * 65], r[7 * 65]); \
            o.z = pk4_fp8(r[8 * 65], r[9 * 65], r[10 * 65], r[11 * 65]); o.w = pk4_fp8(r[12 * 65], r[13 * 65], r[14 * 65], r[15 * 65]); \
            __builtin_nontemporal_store(o, (u32x4*)(cdst + (size_t)n * cKd + 16 * c)); } \
        LDS_WAIT(); __builtin_amdgcn_wave_barrier(); } while (0)
    if (gw < NMOE) MOE_LOAD(va, ca, gw);
    if (gw + NGW < NMOE) MOE_LOAD(vb, cb, gw + NGW);
    for (int it = gw; it < NMOE; it += 2 * NGW) {
        MOE_PROC(va, ca, it + 2 * NGW);
        if (it + NGW < NMOE) MOE_PROC(vb, cb, it + 3 * NGW);
    }
#undef MOE_LOAD
#undef MOE_PROC
}
__device__ __forceinline__ void phase_p0b(const Params& p) {
    const int tid = otid(); unsigned char* ws = p.ws;
    const float* modp = (const float*)(ws + WS_MODP);
    float* mod = (float*)(ws + WS_MOD);
    for (int i = blockIdx.x * 512 + tid; i < 61440; i += gridDim.x * 512) {
        const int l = i / 30720, rem = i % 30720;
        float s = p.in[I_MODB][l * 6144 + rem % 6144];
#pragma unroll
        for (int kp = 0; kp < 8; ++kp) s += modp[(size_t)(kp * 2 + l) * 30720 + rem];
        mod[i] = s;
    }
    bf16_t* H = (bf16_t*)(ws + WS_H);
    const int c4 = (tid & 255) * 4, rs = tid >> 8;
    for (int tile = blockIdx.x; tile < 256; tile += gridDim.x) {
        const int row0 = tile * 64, cond = cond_of(row0);
        f32x4 sh = *(const f32x4*)(p.in[I_MODB] + c4), sc = *(const f32x4*)(p.in[I_MODB] + 1024 + c4);
#pragma unroll
        for (int kp = 0; kp < 8; ++kp) {
            const float* b = modp + (size_t)(kp * 2) * 30720 + cond * 6144 + c4;
            sh += *(const f32x4*)b; sc += *(const f32x4*)(b + 1024);
        }
        sc += 1.f;
        const float* xt = (row0 < NPR ? p.in[I_XP] + (size_t)row0 * DM : p.in[I_XS] + (size_t)(row0 - NPR) * DM) + (size_t)rs * DM + c4;
        for (int it0 = 0; it0 < 32; it0 += 8) {
            f32x4 xv[8];
#pragma unroll
            for (int q = 0; q < 8; ++q) xv[q] = __builtin_nontemporal_load((const f32x4*)(xt + (size_t)(it0 + q) * 2 * DM));
#pragma unroll
            for (int q = 0; q < 8; ++q) {
                const f32x4 h = xv[q] * sc + sh;
                u32x2 o; o.x = cvt_pk_bf16(h.x, h.y); o.y = cvt_pk_bf16(h.z, h.w);
                *(u32x2*)(H + (size_t)(row0 + (it0 + q) * 2 + rs) * DM + c4) = o;
            }
        }
    }
}
__device__ __forceinline__ void attn_tile(const Params& p, LAS unsigned char* lds, int a) {
    const int tid = otid(), lane = tid & 63, wave = tid >> 6, fr = lane & 15, fq = lane >> 4;
    unsigned char* ws = p.ws;
    const bool lat = a >= 256;
    int b, kvh, qb, tokbase;
    if (!lat) { b = a >> 3; kvh = (a >> 2) & 1; qb = a & 3; tokbase = b * 256; }
    else { const int a2 = a - 256; b = a2 >> 6; kvh = (a2 >> 5) & 1; qb = a2 & 31; tokbase = NPR + b * 2048; }
    const int q0 = qb * 64, head = kvh * 2 + (wave >> 2);
    const int qloc = q0 + (wave & 3) * 16 + fr, qrow = tokbase + qloc;
    const bf16_t* Q = (const bf16_t*)(ws + WS_Q); const bf16_t* Kb = (const bf16_t*)(ws + WS_K); const bf16_t* Vb = (const bf16_t*)(ws + WS_V);
    const bf16_t* CK = (const bf16_t*)(ws + WS_CK); const bf16_t* CV = (const bf16_t*)(ws + WS_CV);
    bf16x8 qf[4];
#pragma unroll
    for (int ks = 0; ks < 4; ++ks) qf[ks] = *(const bf16x8*)(Q + (size_t)qrow * 512 + head * 128 + ks * 32 + fq * 8);
    float m = p.in[I_SINK][head] * 1.4426950408889634f, l = 1.f;
    f32x4 o[8];
#pragma unroll
    for (int i = 0; i < 8; ++i) o[i] = (f32x4){0.f, 0.f, 0.f, 0.f};
    int jlo = 0, jhi = 4, ntile = 4;
    if (lat) { jlo = q0 >= 128 ? 0 : (q0 == 64 ? 1 : 2); jhi = q0 <= 1856 ? 4 : (q0 == 1920 ? 3 : 2); ntile = 4 + (jhi - jlo + 1); }
    LAS unsigned char* sK = lds; LAS unsigned char* sV = lds + 17408;
    u32x4 rk[2], rv[2];
#define ATT_SRC(ti, kp_, kbase_, krs_, vbase_, vrs_) do { krs_ = 256; vrs_ = 256; \
        if (!lat) { kp_ = -100000; const size_t o_ = (size_t)(tokbase + 64 * (ti)) * 256 + kvh * 128; kbase_ = Kb + o_; vbase_ = Vb + o_; } \
        else if ((ti) < 4) { kp_ = -100000; const size_t o_ = (size_t)(b * 256 + 64 * (ti)) * 256 + kvh * 128; kbase_ = CK + o_; vbase_ = CV + o_; } \
        else { kp_ = q0 - 128 + 64 * (jlo + (ti) - 4); const size_t o_ = (size_t)(tokbase + kp_) * 256 + kvh * 128; kbase_ = Kb + o_; vbase_ = Vb + o_; } } while (0)
#define ATT_LOAD(ti) do { int kp_; const bf16_t* kb_; const bf16_t* vb_; int krs_, vrs_; ATT_SRC(ti, kp_, kb_, krs_, vb_, vrs_); (void)kp_; \
        _Pragma("unroll") for (int i = 0; i < 2; ++i) { const int idx = tid + 512 * i; \
            rk[i] = *(const u32x4*)(kb_ + (size_t)(idx >> 4) * krs_ + (idx & 15) * 8); \
            rv[i] = *(const u32x4*)(vb_ + (size_t)(idx & 63) * vrs_ + (idx >> 6) * 8); } } while (0)
    ATT_LOAD(0);
    for (int t = 0; t < ntile; ++t) {
        __syncthreads();
#pragma unroll
        for (int i = 0; i < 2; ++i) { const int idx = tid + 512 * i;
            *(LAS u32x4*)(sK + (idx >> 4) * 272 + (idx & 15) * 16) = rk[i];
            { LAS unsigned char* vd = sV + ((idx >> 6) * 8) * 144 + (idx & 63) * 2; const u32x4 w = rv[i];
              *(LAS bf16_t*)(vd) = (bf16_t)w.x; *(LAS bf16_t*)(vd + 144) = (bf16_t)(w.x >> 16); *(LAS bf16_t*)(vd + 2 * 144) = (bf16_t)w.y; *(LAS bf16_t*)(vd + 3 * 144) = (bf16_t)(w.y >> 16);
              *(LAS bf16_t*)(vd + 4 * 144) = (bf16_t)w.z; *(LAS bf16_t*)(vd + 5 * 144) = (bf16_t)(w.z >> 16); *(LAS bf16_t*)(vd + 6 * 144) = (bf16_t)w.w; *(LAS bf16_t*)(vd + 7 * 144) = (bf16_t)(w.w >> 16); } }
        __syncthreads();
        int kp0; { const bf16_t* kb_; const bf16_t* vb_; int krs_, vrs_; ATT_SRC(t, kp0, kb_, krs_, vb_, vrs_); (void)kb_; (void)vb_; (void)krs_; (void)vrs_; }
        if (t + 1 < ntile) ATT_LOAD(t + 1);
        f32x4 s[4];
#pragma unroll
        for (int nt = 0; nt < 4; ++nt) s[nt] = (f32x4){0.f, 0.f, 0.f, 0.f};
#pragma unroll
        for (int ks = 0; ks < 4; ++ks)
#pragma unroll
            for (int nt = 0; nt < 4; ++nt) {
                const bf16x8 kf = *(const LAS bf16x8*)(sK + (16 * nt + fr) * 272 + (32 * ks + 8 * fq) * 2);
                s[nt] = __builtin_amdgcn_mfma_f32_16x16x32_bf16(kf, qf[ks], s[nt], 0, 0, 0);
            }
        float mloc = -3.0e38f;
#pragma unroll
        for (int nt = 0; nt < 4; ++nt)
#pragma unroll
            for (int j = 0; j < 4; ++j) {
                float v = s[nt][j] * (ATTN_SCALE_C * 1.4426950408889634f);
                if (kp0 > -50000) { const int df = qloc - (kp0 + 16 * nt + 4 * fq + j); if (df > 128 || df < -128) v = -1e30f; }
                s[nt][j] = v; mloc = fmaxf(mloc, v);
            }
        mloc = fmaxf(mloc, __shfl_xor(mloc, 16)); mloc = fmaxf(mloc, __shfl_xor(mloc, 32));
        const float mn = fmaxf(m, mloc), alpha = __builtin_amdgcn_exp2f(m - mn);
        float ls = 0.f;
#pragma unroll
        for (int nt = 0; nt < 4; ++nt)
#pragma unroll
            for (int j = 0; j < 4; ++j) { const float e = __builtin_amdgcn_exp2f(s[nt][j] - mn); s[nt][j] = e; ls += e; }
        ls += __shfl_xor(ls, 16); ls += __shfl_xor(ls, 32);
        l = l * alpha + ls; m = mn;
#pragma unroll
        for (int i = 0; i < 8; ++i) o[i] *= alpha;
#pragma unroll
        for (int kk = 0; kk < 2; ++kk) {
            u32x4 pw; pw.x = cvt_pk_bf16(s[2 * kk][0], s[2 * kk][1]); pw.y = cvt_pk_bf16(s[2 * kk][2], s[2 * kk][3]);
            pw.z = cvt_pk_bf16(s[2 * kk + 1][0], s[2 * kk + 1][1]); pw.w = cvt_pk_bf16(s[2 * kk + 1][2], s[2 * kk + 1][3]);
            const bf16x8 pf = __builtin_bit_cast(bf16x8, pw);
#pragma unroll
            for (int dt = 0; dt < 8; ++dt) {
                const LAS unsigned char* vp = sV + (16 * dt + fr) * 144 + (32 * kk + 4 * fq) * 2;
                const u32x2 lo = *(const LAS u32x2*)vp, hi = *(const LAS u32x2*)(vp + 32);
                u32x4 vw; vw.x = lo.x; vw.y = lo.y; vw.z = hi.x; vw.w = hi.y;
                o[dt] = __builtin_amdgcn_mfma_f32_16x16x32_bf16(__builtin_bit_cast(bf16x8, vw), pf, o[dt], 0, 0, 0);
            }
        }
    }
    const float inv = 1.f / l;
    bf16_t* MIX = (bf16_t*)(ws + WS_MIX);
#pragma unroll
    for (int dt = 0; dt < 8; ++dt) {
        u32x2 ov; ov.x = cvt_pk_bf16(o[dt][0] * inv, o[dt][1] * inv); ov.y = cvt_pk_bf16(o[dt][2] * inv, o[dt][3] * inv);
        *(u32x2*)(MIX + (size_t)qrow * DM + head * 128 + 16 * dt + 4 * fq) = ov;
    }
    __syncthreads();
#undef ATT_SRC
#undef ATT_LOAD
}
__device__ __forceinline__ void r1_loads(const Params& p, int r, int tid, unsigned (&xr)[6]) {
    const int c64 = r >> 3, nb = r & 7, tok0 = c64 * 64;
    int s0, len; if (tok0 < NPR) { s0 = tok0 & ~255; len = 256; } else { s0 = NPR + ((tok0 - NPR) & ~2047); len = 2048; }
    const bf16_t* XR = (const bf16_t*)(p.ws + WS_XR);
    const int c = tid & 63, tg = tid >> 6, ch = nb * 64 + c;
    unsigned t[12];
#pragma unroll
    for (int i = 0; i < 11; ++i) { const int tk = tok0 + 8 * tg - 2 + i; t[i] = (tk >= s0 && tk < s0 + len) ? (unsigned)XR[(size_t)tk * 512 + ch] : 0u; }
    t[11] = 0u;
#pragma unroll
    for (int i = 0; i < 6; ++i) xr[i] = t[2 * i] | (t[2 * i + 1] << 16);
}
__device__ __forceinline__ void r1_tile(const Params& p, LAS unsigned char* lds, int r, unsigned (&xraw)[6], int rnext) {
    const int tid = otid(), lane = tid & 63, wave = tid >> 6, fr = lane & 15, fq = lane >> 4;
    unsigned char* ws = p.ws;
    const int c64 = r >> 3, nb = r & 7, tok0 = c64 * 64;
    int s0, len; if (tok0 < NPR) { s0 = tok0 & ~255; len = 256; } else { s0 = NPR + ((tok0 - NPR) & ~2047); len = 2048; }
    LAS float* XC = (LAS float*)lds; LAS unsigned char* XCB = lds + 16640; LAS float* A_ = (LAS float*)(lds + 25856); LAS float* U_ = (LAS float*)(lds + 58624);
    const bf16_t* XR = (const bf16_t*)(ws + WS_XR);
    bf16x8 gA[4][2], gX[4][2]; float gba[4], gbx[4], glm[4];
    {
        const int d = wave & 1; const bf16_t* GW = (const bf16_t*)(ws + WS_GW);
#pragma unroll
        for (int nt = 0; nt < 4; ++nt) {
#pragma unroll
            for (int ks = 0; ks < 2; ++ks) {
                gA[nt][ks] = *(const bf16x8*)(GW + (size_t)(((d * 2 + 0) * 8 + nb) * 64 + 16 * nt + fr) * 64 + 32 * ks + 8 * fq);
                gX[nt][ks] = *(const bf16x8*)(GW + (size_t)(((d * 2 + 1) * 8 + nb) * 64 + 16 * nt + fr) * 64 + 32 * ks + 8 * fq);
            }
            const int chn = d * 512 + nb * 64 + 16 * nt + fr;
            gba[nt] = p.in[I_BA][chn]; gbx[nt] = p.in[I_BX][chn]; glm[nt] = ((const float*)(ws + WS_SP))[chn];
        }
    }
    {
        const int c = tid & 63, tg = tid >> 6, ch = nb * 64 + c;
        const float* cw = p.in[I_CONVW]; const float w0 = cw[ch], w1 = cw[512 + ch], w2 = cw[1024 + ch], w3 = cw[1536 + ch], cb = p.in[I_CONVB][ch];
        float x[11];
#pragma unroll
        for (int i = 0; i < 11; ++i) x[i] = (i & 1) ? bfhi(xraw[i >> 1]) : bflo(xraw[i >> 1]);
#pragma unroll
        for (int k = 0; k < 8; ++k) {
            const float xc = cb + w0 * x[k] + w1 * x[k + 1] + w2 * x[k + 2] + w3 * x[k + 3];
            XC[(8 * tg + k) * 65 + c] = xc;
            *(LAS bf16_t*)(XCB + (8 * tg + k) * 144 + c * 2) = (bf16_t)(cvt_pk_bf16(xc, 0.f) & 0xffffu);
        }
    }
    if (rnext < 2048) r1_loads(p, rnext, tid, xraw);
    __syncthreads();
    {
        const int d = wave & 1, tq = wave >> 1;
        bf16x8 af[2];
#pragma unroll
        for (int ks = 0; ks < 2; ++ks) af[ks] = *(const LAS bf16x8*)(XCB + (16 * tq + fr) * 144 + (32 * ks + 8 * fq) * 2);
#pragma unroll
        for (int nt = 0; nt < 4; ++nt) {
            f32x4 aA = (f32x4){0.f, 0.f, 0.f, 0.f}, aX = (f32x4){0.f, 0.f, 0.f, 0.f};
#pragma unroll
            for (int ks = 0; ks < 2; ++ks) {
                aA = __builtin_amdgcn_mfma_f32_16x16x32_bf16(af[ks], gA[nt][ks], aA, 0, 0, 0);
                aX = __builtin_amdgcn_mfma_f32_16x16x32_bf16(af[ks], gX[nt][ks], aX, 0, 0, 0);
            }
            const int n = 16 * nt + fr, ch = nb * 64 + n;
            const float ba = gba[nt], bx = gbx[nt], sp = glm[nt];
#pragma unroll
            for (int j = 0; j < 4; ++j) {
                const int t = 16 * tq + 4 * fq + j;
                const float rg = sigmoidf_(aA[j] + ba), ig = sigmoidf_(aX[j] + bx), la = -8.f * rg * sp;
                const float av = __expf(la), uv = __builtin_amdgcn_sqrtf(one_minus_exp(2.f * la)) * ig * XC[t * 65 + n];
                A_[(d * 64 + t) * 64 + n] = av; U_[(d * 64 + t) * 64 + n] = uv;
            }
        }
    }
    __syncthreads();
    const int d = tid >> 8, sub = (tid >> 6) & 3, ch = tid & 63;
    {
        float h = 0.f, P = 1.f;
#pragma unroll
        for (int k = 0; k < 16; ++k) {
            const int t = d == 0 ? 16 * sub + k : 16 * sub + 15 - k, idx = (d * 64 + t) * 64 + ch;
            const float a = A_[idx], u = U_[idx]; h = a * h + u; P *= a; U_[idx] = h; A_[idx] = P;
        }
    }
    __syncthreads();
    {
        float chh = 0.f, cP = 1.f;
        if (d == 0) { for (int s = 0; s < sub; ++s) { const int e = (16 * s + 15) * 64 + ch; chh = U_[e] + A_[e] * chh; cP *= A_[e]; } }
        else { for (int s = 3; s > sub; --s) { const int e = (64 + 16 * s) * 64 + ch; chh = U_[e] + A_[e] * chh; cP *= A_[e]; } }
        bf16_t* HL = (bf16_t*)(ws + (d == 0 ? WS_HLF : WS_HLB)); bf16_t* PC = (bf16_t*)(ws + (d == 0 ? WS_PCF : WS_PCB));
#pragma unroll
        for (int k = 0; k < 16; ++k) {
            const int t = 16 * sub + k, idx = (d * 64 + t) * 64 + ch;
            const float hl = U_[idx], pl = A_[idx];
            const size_t g = (size_t)(tok0 + t) * 512 + nb * 64 + ch;
            const unsigned hp = cvt_pk_bf16(hl + pl * chh, pl * cP); HL[g] = (bf16_t)hp; PC[g] = (bf16_t)(hp >> 16);
        }
    }
    __syncthreads();
}
__device__ __forceinline__ void r2_tile(const Params& p, int c64) {
    const int ch = otid(); unsigned char* ws = p.ws;
    const int tok0 = c64 * 64; const bool prompt = tok0 < NPR;
    int s0, len; if (prompt) { s0 = tok0 & ~255; len = 256; } else { s0 = NPR + ((tok0 - NPR) & ~2047); len = 2048; }
    const int n = (tok0 - s0) >> 6, nc = len >> 6;
    const bf16_t* HLF = (const bf16_t*)(ws + WS_HLF); const bf16_t* HLB = (const bf16_t*)(ws + WS_HLB);
    const bf16_t* PCF = (const bf16_t*)(ws + WS_PCF); const bf16_t* PCB = (const bf16_t*)(ws + WS_PCB);
    float cf = 0.f, cb = 0.f;
    if (!prompt) { const int bs = (tok0 - NPR) >> 11; cf = p.in[I_STATE][(bs * 2 + 0) * 512 + ch]; cb = p.in[I_STATE][(bs * 2 + 1) * 512 + ch]; }
    for (int c0 = 0; c0 < n; c0 += 8) {
        float hv[8], pv[8];
#pragma unroll
        for (int i = 0; i < 8; ++i) { const int cc = (c0 + i < n) ? c0 + i : n - 1; const size_t g = (size_t)(s0 + 64 * cc + 63) * 512 + ch; hv[i] = bf2f(HLF[g]); pv[i] = bf2f(PCF[g]); }
#pragma unroll
        for (int i = 0; i < 8; ++i) if (c0 + i < n) cf = hv[i] + pv[i] * cf;
    }
    for (int c0 = nc - 1; c0 > n; c0 -= 8) {
        float hv[8], pv[8];
#pragma unroll
        for (int i = 0; i < 8; ++i) { const int cc = (c0 - i > n) ? c0 - i : n + 1; const size_t g = (size_t)(s0 + 64 * cc) * 512 + ch; hv[i] = bf2f(HLB[g]); pv[i] = bf2f(PCB[g]); }
#pragma unroll
        for (int i = 0; i < 8; ++i) if (c0 - i > n) cb = hv[i] + pv[i] * cb;
    }
    const bf16_t* XGb = (const bf16_t*)(ws + WS_XG); bf16_t* MIX = (bf16_t*)(ws + WS_MIX);
    float* ostate = p.out + (size_t)NTOK * DM + 2 * (size_t)NPR * 256;
#pragma unroll 8
    for (int t = 0; t < 64; ++t) {
        const size_t g = (size_t)(tok0 + t) * 512 + ch;
        const float hf = bf2f(__builtin_nontemporal_load(HLF + g)) + bf2f(__builtin_nontemporal_load(PCF + g)) * cf, hb = bf2f(__builtin_nontemporal_load(HLB + g)) + bf2f(__builtin_nontemporal_load(PCB + g)) * cb;
        const float y = (hf + hb) * geluf_(bf2f(XGb[g]));
        MIX[(size_t)(tok0 + t) * DM + 512 + ch] = (bf16_t)(cvt_pk_bf16(y, 0.f) & 0xffffu);
        if (prompt) {
            if (n == nc - 1 && t == 63) ostate[((tok0 >> 8) * 2 + 0) * 512 + ch] = hf;
            if (n == 0 && t == 0) ostate[((tok0 >> 8) * 2 + 1) * 512 + ch] = hb;
        }
    }
}
__device__ __forceinline__ void spatial_tile(const Params& p, LAS unsigned char* lds, int r) {
    const int tid = otid(), lane = tid & 63, wave = tid >> 6, fr = lane & 15, fq = lane >> 4;
    unsigned char* ws = p.ws;
    const int nchunk = r >> 3, g = r & 7, tok0 = nchunk * 128;
    LAS unsigned char* SA = lds; LAS unsigned char* SB = lds + 34816; LAS float* MU = (LAS float*)(lds + 69632); LAS float* RS = (LAS float*)(lds + 70144);
    if (tid < 128) {
        const float* st = (const float*)(ws + WS_VSTAT) + (size_t)(tok0 + tid) * 32;
        float s1 = 0.f, s2 = 0.f;
#pragma unroll
        for (int i = 0; i < 16; ++i) { s1 += st[2 * i]; s2 += st[2 * i + 1]; }
        const float mu = s1 * (1.f / 1024.f), var = fmaxf(s2 * (1.f / 1024.f) - mu * mu, 0.f);
        MU[tid] = mu; RS[tid] = rsqrtf(var + LN_EPS_C);
    }
    const bf16_t* SPW = (const bf16_t*)(ws + WS_SPW);
#pragma unroll
    for (int i = 0; i < 4; ++i) { const int idx = tid + 512 * i, pr = idx >> 4, c16 = idx & 15;
        *(LAS u32x4*)(SA + pr * 272 + c16 * 16) = *(const u32x4*)(SPW + (size_t)(g * 128 + pr) * 128 + c16 * 8); }
    const bf16_t* V2 = (const bf16_t*)(ws + WS_V2);
    u32x4 rawv[4];
#pragma unroll
    for (int i = 0; i < 4; ++i) { const int idx = tid + 512 * i, q = idx & 127, c8 = idx >> 7; rawv[i] = *(const u32x4*)(V2 + (size_t)(tok0 + q) * DM + g * 128 + c8 * 8); }
    __syncthreads();
#pragma unroll
    for (int i = 0; i < 4; ++i) { const int idx = tid + 512 * i, q = idx & 127, c8 = idx >> 7;
        const u32x4 raw = rawv[i];
        const float* lgp = p.in[I_SGLNG] + g * 128 + c8 * 8; const float* lbp = p.in[I_SGLNB] + g * 128 + c8 * 8;
        const f32x4 lg0 = *(const f32x4*)lgp, lg1 = *(const f32x4*)(lgp + 4), lb0 = *(const f32x4*)lbp, lb1 = *(const f32x4*)(lbp + 4);
        const float mu = MU[q], rs = RS[q];
        const unsigned w0 = cvt_pk_bf16((bflo(raw.x) - mu) * rs * lg0.x + lb0.x, (bfhi(raw.x) - mu) * rs * lg0.y + lb0.y);
        const unsigned w1 = cvt_pk_bf16((bflo(raw.y) - mu) * rs * lg0.z + lb0.z, (bfhi(raw.y) - mu) * rs * lg0.w + lb0.w);
        const unsigned w2 = cvt_pk_bf16((bflo(raw.z) - mu) * rs * lg1.x + lb1.x, (bfhi(raw.z) - mu) * rs * lg1.y + lb1.y);
        const unsigned w3 = cvt_pk_bf16((bflo(raw.w) - mu) * rs * lg1.z + lb1.z, (bfhi(raw.w) - mu) * rs * lg1.w + lb1.w);
        LAS unsigned char* sd = SB + (c8 * 8) * 272 + q * 2;
        *(LAS bf16_t*)(sd) = (bf16_t)w0; *(LAS bf16_t*)(sd + 272) = (bf16_t)(w0 >> 16); *(LAS bf16_t*)(sd + 2 * 272) = (bf16_t)w1; *(LAS bf16_t*)(sd + 3 * 272) = (bf16_t)(w1 >> 16);
        *(LAS bf16_t*)(sd + 4 * 272) = (bf16_t)w2; *(LAS bf16_t*)(sd + 5 * 272) = (bf16_t)(w2 >> 16); *(LAS bf16_t*)(sd + 6 * 272) = (bf16_t)w3; *(LAS bf16_t*)(sd + 7 * 272) = (bf16_t)(w3 >> 16); }
    __syncthreads();
    const int wr = wave >> 1, wc = wave & 1;
    const bf16_t* U = (const bf16_t*)(ws + WS_U); bf16_t* S_ = (bf16_t*)(ws + WS_MIX);
    u32x2 upre[2][4]; float bpre[2];
#pragma unroll
    for (int mt = 0; mt < 2; ++mt) { const int pr = 32 * wr + 16 * mt + fr; bpre[mt] = p.in[I_SPB][g * 128 + pr];
#pragma unroll
        for (int nt = 0; nt < 4; ++nt) upre[mt][nt] = *(const u32x2*)(U + (size_t)(tok0 + pr) * DM + g * 128 + 64 * wc + 16 * nt + 4 * fq); }
    f32x4 acc[2][4];
#pragma unroll
    for (int i = 0; i < 2; ++i)
#pragma unroll
        for (int j = 0; j < 4; ++j) acc[i][j] = (f32x4){0.f, 0.f, 0.f, 0.f};
#pragma unroll
    for (int ks = 0; ks < 4; ++ks) {
        bf16x8 af[2], bf[4];
#pragma unroll
        for (int mt = 0; mt < 2; ++mt) af[mt] = *(const LAS bf16x8*)(SA + (32 * wr + 16 * mt + fr) * 272 + (32 * ks + 8 * fq) * 2);
#pragma unroll
        for (int nt = 0; nt < 4; ++nt) bf[nt] = *(const LAS bf16x8*)(SB + (64 * wc + 16 * nt + fr) * 272 + (32 * ks + 8 * fq) * 2);
#pragma unroll
        for (int mt = 0; mt < 2; ++mt)
#pragma unroll
            for (int nt = 0; nt < 4; ++nt) acc[mt][nt] = __builtin_amdgcn_mfma_f32_16x16x32_bf16(bf[nt], af[mt], acc[mt][nt], 0, 0, 0);
    }
#pragma unroll
    for (int mt = 0; mt < 2; ++mt) {
        const int pr = 32 * wr + 16 * mt + fr; const float bias = bpre[mt];
#pragma unroll
        for (int nt = 0; nt < 4; ++nt) {
            const size_t off = (size_t)(tok0 + pr) * DM + g * 128 + 64 * wc + 16 * nt + 4 * fq;
            const u32x2 uu = upre[mt][nt];
            u32x2 ov; ov.x = cvt_pk_bf16(bflo(uu.x) * (acc[mt][nt][0] + bias), bfhi(uu.x) * (acc[mt][nt][1] + bias));
            ov.y = cvt_pk_bf16(bflo(uu.y) * (acc[mt][nt][2] + bias), bfhi(uu.y) * (acc[mt][nt][3] + bias));
            *(u32x2*)(S_ + off) = ov;
        }
    }
    __syncthreads();
}
__device__ __forceinline__ void phase_lnmix(const Params& p, LAS unsigned char* lds, int l) {
    const int tid = otid(), lane = tid & 63, wave = tid >> 6; unsigned char* ws = p.ws;
    LAS float* RW = (LAS float*)lds; LAS float* XT = (LAS float*)(lds + 65536); LAS float* PS = (LAS float*)(lds + 65536 + 65792);
    const float* rw = p.in[I_ROUTER] + (size_t)l * 16384;
    for (int i = tid; i < 4096; i += 512) *(LAS f32x4*)(RW + i * 4) = *(const f32x4*)(rw + i * 4);
    bf16_t* XA = (bf16_t*)(ws + WS_XA); unsigned char* HMOE = ws + WS_HMOE; float* AFF = (float*)(ws + WS_AFF);
    const float* gam = p.in[I_LNMG] + l * DM; const float* bet = p.in[I_LNMB] + l * DM;
    for (int tile = blockIdx.x; tile < NTOK / 16; tile += gridDim.x) {
        const int row0 = tile * 16;
        const float* modr = (const float*)(ws + WS_MOD) + (size_t)(l * 5 + cond_of(row0)) * 6144;
        f32x4 vv[2][4];
#pragma unroll
        for (int rr = 0; rr < 2; ++rr)
#pragma unroll
            for (int j = 0; j < 4; ++j) { const u32x2 w = *(const u32x2*)(XA + (size_t)(row0 + wave * 2 + rr) * DM + 4 * lane + 256 * j); vv[rr][j] = (f32x4){bflo(w.x), bfhi(w.x), bflo(w.y), bfhi(w.y)}; }
#pragma unroll
        for (int rr = 0; rr < 2; ++rr) {
            const int rl = wave * 2 + rr, row = row0 + rl;
            f32x4 v[4]; float s = 0.f;
#pragma unroll
            for (int j = 0; j < 4; ++j) { v[j] = vv[rr][j]; s += (v[j].x + v[j].y) + (v[j].z + v[j].w); }
            const float mean = wave_sum(s) * (1.f / DM); float s2 = 0.f;
#pragma unroll
            for (int j = 0; j < 4; ++j) { v[j] = v[j] - mean; s2 += (v[j].x * v[j].x + v[j].y * v[j].y) + (v[j].z * v[j].z + v[j].w * v[j].w); }
            const float rstd = rsqrtf(wave_sum(s2) * (1.f / DM) + LN_EPS_C);
#pragma unroll
            for (int j = 0; j < 4; ++j) {
                const int c = 4 * lane + 256 * j;
                const f32x4 x1 = v[j] * rstd * *(const f32x4*)(gam + c) + *(const f32x4*)(bet + c);
                { u32x2 ox; ox.x = cvt_pk_bf16(x1.x, x1.y); ox.y = cvt_pk_bf16(x1.z, x1.w); *(u32x2*)(XA + (size_t)row * DM + c) = ox; }
                const f32x4 hm = x1 * (*(const f32x4*)(modr + 4 * 1024 + c) + 1.f) + *(const f32x4*)(modr + 3 * 1024 + c);
                *(unsigned*)(HMOE + (size_t)row * DM + c) = pk4_fp8(hm.x, hm.y, hm.z, hm.w);
                *(LAS f32x4*)(XT + rl * 1028 + c) = hm;
            }
        }
        __syncthreads();
        {
            f32x4 acc = (f32x4){0.f, 0.f, 0.f, 0.f};
            const int ri = lane & 15, kq = lane >> 4, kb = wave * 128;
#pragma unroll 8
            for (int kk = 0; kk < 32; ++kk) {
                const int k = kb + 4 * kk + kq;
                acc = __builtin_amdgcn_mfma_f32_16x16x4f32(XT[ri * 1028 + k], RW[k * 16 + ri], acc, 0, 0, 0);
            }
#pragma unroll
            for (int r = 0; r < 4; ++r) PS[wave * 256 + (4 * kq + r) * 16 + ri] = acc[r];
        }
        __syncthreads();
        if (tid < 256) {
            float lg = 0.f;
#pragma unroll
            for (int w = 0; w < 8; ++w) lg += PS[w * 256 + tid];
            float mx = lg;
#pragma unroll
            for (int o = 1; o < 16; o <<= 1) mx = fmaxf(mx, __shfl_xor(mx, o));
            const float ex = __expf(lg - mx); float sm = ex;
#pragma unroll
            for (int o = 1; o < 16; o <<= 1) sm += __shfl_xor(sm, o);
            AFF[(size_t)(row0 + (tid >> 4)) * 16 + (tid & 15)] = ex / sm;
        }
        __syncthreads();
    }
}
__device__ __forceinline__ void phase_route(const Params& p, LAS unsigned char* lds) {
    const int tid = otid(), lane = tid & 63, wave = tid >> 6; unsigned char* ws = p.ws;
    LAS unsigned* key = (LAS unsigned*)lds; LAS int* idx = (LAS int*)(lds + 8192);
    const float* AFF = (const float*)(ws + WS_AFF); int* TOKSLOT = (int*)(ws + WS_TOKSLOT); float* SG = (float*)(ws + WS_SLOTGATE);
    const unsigned char* HMOE = ws + WS_HMOE; unsigned char* XG = ws + WS_XGATH;
    for (int tile = blockIdx.x; tile < 576; tile += gridDim.x) {
        int b, e, T, tok0, cap, ls0;
        if (tile < 64) { b = tile >> 4; e = tile & 15; T = 2048; tok0 = NPR + b * 2048; cap = 256; ls0 = 1024 + b * 256; }
        else { const int t2 = tile - 64; b = t2 >> 4; e = t2 & 15; T = 256; tok0 = b * 256; cap = 32; ls0 = b * 32; }
        for (int i = tid; i < T; i += 512) { key[i] = __builtin_bit_cast(unsigned, AFF[(size_t)(tok0 + i) * 16 + e]); idx[i] = i; }
        __syncthreads();
        for (int k = 2; k <= T; k <<= 1)
            for (int j = k >> 1; j > 0; j >>= 1) {
                for (int pp = tid; pp < (T >> 1); pp += 512) {
                    const int i = ((pp & ~(j - 1)) << 1) | (pp & (j - 1)), l = i | j;
                    const bool desc = (i & k) == 0;
                    const unsigned ki = key[i], kl = key[l]; const int ii = idx[i], il = idx[l];
                    const bool inorder = (ki > kl) || (ki == kl && ii < il);
                    if (inorder != desc) { key[i] = kl; key[l] = ki; idx[i] = il; idx[l] = ii; }
                }
                __syncthreads();
            }
        for (int pos = tid; pos < T; pos += 512) {
            const int tok = idx[pos];
            TOKSLOT[(size_t)(tok0 + tok) * 16 + e] = pos < cap ? ls0 + pos : -1;
            if (pos < cap) SG[e * 2048 + ls0 + pos] = __builtin_bit_cast(float, key[pos]);
        }
        for (int pos0 = wave * 4; pos0 < cap; pos0 += 32) {
            u32x4 rowv[4];
#pragma unroll
            for (int q = 0; q < 4; ++q) rowv[q] = ((const u32x4*)(HMOE + (size_t)(tok0 + idx[pos0 + q]) * DM))[lane];
#pragma unroll
            for (int q = 0; q < 4; ++q) ((u32x4*)(XG + (size_t)(e * 2048 + ls0 + pos0 + q) * DM))[lane] = rowv[q];
        }
        __syncthreads();
    }
}
__device__ __forceinline__ void phase_lnffn(const Params& p, int l) {
    const int tid = otid(), lane = tid & 63, wave = tid >> 6; unsigned char* ws = p.ws;
    bf16_t* XA = (bf16_t*)(ws + WS_XA); bf16_t* H = (bf16_t*)(ws + WS_H); const bf16_t* Y = (const bf16_t*)(ws + WS_Y); const int* TOKSLOT = (const int*)(ws + WS_TOKSLOT);
    const float* gam = p.in[I_LNFG] + l * DM; const float* bet = p.in[I_LNFB] + l * DM;
    const int rstride = gridDim.x * 8;
    int slv_n = 0; u32x2 xr_n[4];
    { const int row = blockIdx.x * 8 + wave;
      if (row < NTOK) { slv_n = TOKSLOT[(size_t)row * 16 + (lane & 15)];
#pragma unroll
          for (int j = 0; j < 4; ++j) xr_n[j] = *(const u32x2*)(XA + (size_t)row * DM + 4 * lane + 256 * j); } }
    for (int row = blockIdx.x * 8 + wave; row < NTOK; row += rstride) {
        const int cond = cond_of(row);
        const int slv = slv_n; u32x2 xr_c[4];
#pragma unroll
        for (int j = 0; j < 4; ++j) xr_c[j] = xr_n[j];
        if (row + rstride < NTOK) {
            slv_n = TOKSLOT[(size_t)(row + rstride) * 16 + (lane & 15)];
#pragma unroll
            for (int j = 0; j < 4; ++j) xr_n[j] = *(const u32x2*)(XA + (size_t)(row + rstride) * DM + 4 * lane + 256 * j);
        }
        const float* modr = (const float*)(ws + WS_MOD) + (size_t)(l * 5 + cond) * 6144;
        f32x4 f[4], xres[4];
#pragma unroll
        for (int j = 0; j < 4; ++j) { f[j] = (f32x4){0.f, 0.f, 0.f, 0.f}; { const u32x2 w = xr_c[j]; xres[j] = (f32x4){bflo(w.x), bfhi(w.x), bflo(w.y), bfhi(w.y)}; } }
        {
            unsigned long long m = __builtin_amdgcn_ballot_w64(slv >= 0) & 0xffffull;
            while (m) {
                const int e0 = __builtin_ctzll(m); m &= m - 1;
                const bool two = m != 0; const int e1 = two ? __builtin_ctzll(m) : e0; if (two) m &= m - 1;
                const int s0 = __builtin_amdgcn_readlane(slv, e0), s1 = __builtin_amdgcn_readlane(slv, e1);
                const bf16_t* y0 = Y + (size_t)(e0 * 2048 + s0) * DM; const bf16_t* y1 = Y + (size_t)(e1 * 2048 + s1) * DM;
                u32x2 w0[4], w1[4];
#pragma unroll
                for (int j = 0; j < 4; ++j) { w0[j] = __builtin_nontemporal_load((const u32x2*)(y0 + 4 * lane + 256 * j)); w1[j] = __builtin_nontemporal_load((const u32x2*)(y1 + 4 * lane + 256 * j)); }
                const float k1 = two ? 1.f : 0.f;
#pragma unroll
                for (int j = 0; j < 4; ++j) {
                    f[j].x += bflo(w0[j].x) + k1 * bflo(w1[j].x); f[j].y += bfhi(w0[j].x) + k1 * bfhi(w1[j].x);
                    f[j].z += bflo(w0[j].y) + k1 * bflo(w1[j].y); f[j].w += bfhi(w0[j].y) + k1 * bfhi(w1[j].y);
                }
            }
        }
        f32x4 v[4]; float s = 0.f;
#pragma unroll
        for (int j = 0; j < 4; ++j) { const int c = 4 * lane + 256 * j;
            v[j] = xres[j] * ALPHA_C + *(const f32x4*)(modr + 5 * 1024 + c) * f[j];
            s += (v[j].x + v[j].y) + (v[j].z + v[j].w); }
        const float mean = wave_sum(s) * (1.f / DM); float s2 = 0.f;
#pragma unroll
        for (int j = 0; j < 4; ++j) { v[j] = v[j] - mean; s2 += (v[j].x * v[j].x + v[j].y * v[j].y) + (v[j].z * v[j].z + v[j].w * v[j].w); }
        const float rstd = rsqrtf(wave_sum(s2) * (1.f / DM) + LN_EPS_C);
        const float* modn = (const float*)(ws + WS_MOD) + (size_t)(5 + cond) * 6144;
#pragma unroll
        for (int j = 0; j < 4; ++j) {
            const int c = 4 * lane + 256 * j;
            const f32x4 x2 = v[j] * rstd * *(const f32x4*)(gam + c) + *(const f32x4*)(bet + c);
            if (l == 0) {
                { u32x2 ox; ox.x = cvt_pk_bf16(x2.x, x2.y); ox.y = cvt_pk_bf16(x2.z, x2.w); *(u32x2*)(XA + (size_t)row * DM + c) = ox; }
                const f32x4 h = x2 * (*(const f32x4*)(modn + 1024 + c) + 1.f) + *(const f32x4*)(modn + c);
                u32x2 o; o.x = cvt_pk_bf16(h.x, h.y); o.y = cvt_pk_bf16(h.z, h.w);
                *(u32x2*)(H + (size_t)row * DM + c) = o;
            } else *(f32x4*)(p.out + (size_t)row * DM + c) = x2;
        }
    }
}
#ifndef PHMASK
#define PHMASK 0xFFFFF
#endif
template <int PH> __device__ __forceinline__ void run_phase(const Params& p, LAS unsigned char* lds) {
    unsigned char* ws = p.ws;
    const int G = gridDim.x;
    constexpr int l = PH >= 11 ? 1 : 0;
    constexpr int base = PH >= 13 ? PH - 8 : PH;
    if constexpr (!(((PHMASK) >> (base)) & 1)) return;
    if constexpr (base == 0) phase_p0(p, lds);
    else if constexpr (base == 1) phase_p0b(p);
    else if constexpr (base == 2) {
        pg8::Gemm g; g.A = (const bf16_t*)(ws + WS_H); g.Bt = (const bf16_t*)(ws + WS_ABIN); g.M = NTOK; g.N = 2048; g.K = 1024;
        pg8::StaticOrder S; S.init(NTOK, 2048, G, blockIdx.x);
        EpiIn E; E.Q = (bf16_t*)(ws + WS_Q); E.Kb = (bf16_t*)(ws + WS_K); E.Vb = (bf16_t*)(ws + WS_V); E.XR = (bf16_t*)(ws + WS_XR); E.XGb = (bf16_t*)(ws + WS_XG);
        E.outK = p.out + (size_t)NTOK * DM; E.outV = p.out + (size_t)NTOK * DM + (size_t)NPR * 256; E.rope = (const float*)(ws + WS_ROPE);
        pg8::gemm_phase<EpiIn, pg8::StaticOrder, true, true>(lds, g, S, E);
    } else if constexpr (base == 3) {
        unsigned xraw[6]; bool primed = false;
        for (int t = blockIdx.x; t < 512 + 2048; t += G) {
            if (t < 512) attn_tile(p, lds, t);
            else { if (!primed) { r1_loads(p, t - 512, otid(), xraw); primed = true; } r1_tile(p, lds, t - 512, xraw, t - 512 + G); } }
    } else if constexpr (base == 4) {
        for (int t = blockIdx.x; t < 256; t += G) r2_tile(p, t);
    } else if constexpr (base == 5) {
        pg8::Gemm g; g.A = (const bf16_t*)(ws + WS_MIX); g.Bt = (const bf16_t*)(ws + (l ? WS_SGOUT : WS_ABOUT)); g.M = NTOK; g.N = 1024; g.K = 1024;
        pg8::StaticOrder S; S.init(NTOK, 1024, G, blockIdx.x);
        EpiOut<(l == 1)> E; E.XA = (bf16_t*)(ws + WS_XA); E.modl = (const float*)(ws + WS_MOD) + (size_t)l * 5 * 6144;
        E.xin_p = p.in[I_XP]; E.xin_s = p.in[I_XS];
        pg8::gemm_phase<EpiOut<(l == 1)>, pg8::StaticOrder, true, true>(lds, g, S, E);
    } else if constexpr (base == 6) phase_lnmix(p, lds, l);
    else if constexpr (base == 7) phase_route(p, lds);
    else if constexpr (base == 8) {
        pg8::Gemm g; g.A = (const bf16_t*)(ws + WS_XGATH); g.Bt = (const bf16_t*)(ws + WS_BTUP + (size_t)l * 16 * 4096 * 1024); g.M = 32768; g.N = 65536; g.K = 512;
        pg8::GroupOrder<2048, 128, 16> S; S.G = G; S.c = blockIdx.x;
        EpiUp E; E.Hid = ws + WS_HID;
        pg8::gemm_phase<EpiUp, pg8::GroupOrder<2048, 128, 16>, true, true, true>(lds, g, S, E);
    } else if constexpr (base == 9) {
        pg8::Gemm g; g.A = (const bf16_t*)(ws + WS_HID); g.Bt = (const bf16_t*)(ws + WS_BTDN + (size_t)l * 16 * 1024 * 2048); g.M = 32768; g.N = 16384; g.K = 1024;
        pg8::GroupOrder<512, 32, 4> S; S.G = G; S.c = blockIdx.x;
        EpiDn E; E.Y = (bf16_t*)(ws + WS_Y); E.gate = (const float*)(ws + WS_SLOTGATE);
        pg8::gemm_phase<EpiDn, pg8::GroupOrder<512, 32, 4>, true, true, true>(lds, g, S, E);
    } else if constexpr (base == 10) phase_lnffn(p, l);
    else if constexpr (base == 11) {
        pg8::Gemm g; g.A = (const bf16_t*)(ws + WS_H); g.Bt = (const bf16_t*)(ws + WS_SGIN); g.M = NTOK; g.N = 2048; g.K = 1024;
        pg8::StaticOrder S; S.init(NTOK, 2048, G, blockIdx.x);
        EpiSgu E; E.U = (bf16_t*)(ws + WS_U); E.V2 = (bf16_t*)(ws + WS_V2); E.vstat = (float*)(ws + WS_VSTAT); E.bias = p.in[I_SGINB];
        pg8::gemm_phase<EpiSgu, pg8::StaticOrder, true, true>(lds, g, S, E);
    } else if constexpr (base == 12) {
        for (int t = blockIdx.x; t < 1024; t += G) spatial_tile(p, lds, t);
    }
}
__global__ void __launch_bounds__(512, 2) fwd_kernel(Params p) {
    extern __shared__ __attribute__((aligned(16))) unsigned char smem[];
    LAS unsigned char* lds = (LAS unsigned char*)smem;
    volatile LAS unsigned* xst = (volatile LAS unsigned*)(lds + LDS_BYTES - 16);
    if (threadIdx.x == 0) { xst[0] = 0u; xst[1] = 0u; }
    __syncthreads();
    XcdBarrier xb = xcd_barrier_post((unsigned*)(p.ws + WS_BAR), xst);
#ifndef DUPMASK
#define DUPMASK 0
#endif
#define PHASE(k) if (p.ph_lo <= (k) && (k) < p.ph_hi) { run_phase<k>(p, lds); if constexpr (((DUPMASK) >> (k)) & 1) { xcd_barrier(xb); run_phase<k>(p, lds); } \
        if ((k) + 1 < p.ph_hi) { if ((k) == 0 && p.ph_hi > NPHASE) cg::this_grid().sync(); else xcd_barrier(xb); } }
    PHASE(0) PHASE(1) PHASE(2) PHASE(3) PHASE(4) PHASE(5) PHASE(6) PHASE(7) PHASE(8) PHASE(9)
    PHASE(10) PHASE(11) PHASE(12) PHASE(13) PHASE(14) PHASE(15) PHASE(16) PHASE(17) PHASE(18)
#undef PHASE
}

extern "C" void kernel_launch(void* const* d_in, const int* in_sizes, int n_in, void* d_out, int out_size, void* d_ws, size_t ws_size, hipStream_t stream) {
    static int grid = 0;
    if (grid == 0) {
        if (n_in != 34 || ws_size < WS_END) { fprintf(stderr, "kernel_launch: expected 34 inputs and >= %zu bytes of workspace; got %d, %zu\n", (size_t)WS_END, n_in, ws_size); grid = -1; return; }
        int dev = 0, cus = 0, per_cu = 0;
        hipGetDevice(&dev);
        hipDeviceGetAttribute(&cus, hipDeviceAttributeMultiprocessorCount, dev);
        if (hipFuncSetAttribute((const void*)fwd_kernel, hipFuncAttributeMaxDynamicSharedMemorySize, LDS_BYTES) != hipSuccess) { fprintf(stderr, "kernel_launch: hipFuncSetAttribute failed\n"); grid = -1; return; }
        hipOccupancyMaxActiveBlocksPerMultiprocessor(&per_cu, (const void*)fwd_kernel, 512, LDS_BYTES);
        if (per_cu < 1) { fprintf(stderr, "kernel_launch: occupancy query says %d blocks per CU\n", per_cu); per_cu = 1; }
        (void)hipGetLastError();
        grid = cus;
        if (grid % 8 != 0 || grid <= 0) grid = 256;
    }
    if (grid < 0) return;
    if (hipMemsetAsync((unsigned char*)d_ws + WS_BAR, 0, 16384, stream) != hipSuccess) { fprintf(stderr, "kernel_launch: memset of the barrier words failed\n"); return; }
    Params p{};
    for (int i = 0; i < 34; ++i) p.in[i] = (const float*)d_in[i];
    p.out = (float*)d_out; p.ws = (unsigned char*)d_ws;
#if N_SPLIT
    for (int ph = 0; ph < NPHASE; ++ph) { p.ph_lo = ph; p.ph_hi = ph + 1; hipLaunchKernelGGL(fwd_kernel, dim3(grid), dim3(512), LDS_BYTES, stream, p); }
#else
    p.ph_lo = 0; p.ph_hi = NPHASE;
    void* args[] = {&p};
    hipError_t e = hipLaunchCooperativeKernel((const void*)fwd_kernel, dim3(grid), dim3(512), args, LDS_BYTES, stream);
    if (e != hipSuccess) fprintf(stderr, "cooperative launch failed: %s (grid %d)\n", hipGetErrorString(e), grid);
#endif
}
```
